# Optimizing an MI355X kernel written in HIP

```python
import jax, jax.numpy as jnp
from jax import lax
import numpy as np

D_MODEL = 1024
BATCH = 8
SEQ = 2048
DEPTH = 4

GLA_HEADS = 4
GLA_DK = D_MODEL // 2
GLA_DV = D_MODEL
GLA_HEAD_DK = GLA_DK // GLA_HEADS
GLA_HEAD_DV = GLA_DV // GLA_HEADS
GLA_RANK = 16
GLA_GATE_TAU = 16.0
GLA_CHUNK = 64
LRU_WIDTH = D_MODEL
LRU_BLOCKS = 4
LRU_BLOCK = LRU_WIDTH // LRU_BLOCKS
CONV_WIDTH = 4
LRU_C = 8.0
SB_HEAD_DIM = 128
SB_HEADS = D_MODEL // SB_HEAD_DIM
SB_DIM = SB_HEADS * SB_HEAD_DIM
SB_QBLOCK = 128
N_BRANCHES = 3
D_FF = 4 * D_MODEL
EPS = 1e-6
IN_SIZES = (GLA_DK, GLA_DK, GLA_DV, GLA_DV, GLA_RANK, LRU_WIDTH, LRU_WIDTH, SB_DIM, SB_DIM, SB_DIM, N_BRANCHES * D_MODEL)
IN_COLS = 2 * GLA_DK + 2 * GLA_DV + GLA_RANK + 2 * LRU_WIDTH + 3 * SB_DIM + N_BRANCHES * D_MODEL

kernel_name = "hybrid_gla_rglru_stickbreaking_block"


def rms_norm(x, g):
    x32 = x.astype(jnp.float32)
    y = x32 * lax.rsqrt(jnp.mean(x32 * x32, axis=-1, keepdims=True) + EPS)
    return (y * g.astype(jnp.float32)).astype(x.dtype)


def split_heads(t, n_heads):
    b, s, _ = t.shape
    return t.reshape(b, s, n_heads, -1).transpose(0, 2, 1, 3)


def merge_heads(t):
    b, h, s, d = t.shape
    return t.transpose(0, 2, 1, 3).reshape(b, s, h * d)


def gla_mixer(q, k, v, g_out, a_down, w_up, b_alpha, norm_g):
    f32 = jnp.float32
    b, s, _ = q.shape
    n = s // GLA_CHUNK
    log_alpha = jax.nn.log_sigmoid((a_down @ w_up + b_alpha).astype(f32)) / GLA_GATE_TAU

    def chunks(t):
        return split_heads(t, GLA_HEADS).reshape(b, GLA_HEADS, n, GLA_CHUNK, -1)

    qc = chunks(q.astype(f32)) * (GLA_HEAD_DK ** -0.5)
    kc = chunks(k.astype(f32))
    vc = chunks(v.astype(f32))
    cum = jnp.cumsum(chunks(log_alpha), axis=3)
    last = cum[:, :, :, -1:, :]
    q_dec = qc * jnp.exp(cum)
    k_inv = kc * jnp.exp(-cum)
    k_end = kc * jnp.exp(last - cum)
    pos = jnp.arange(GLA_CHUNK)
    causal = pos[:, None] >= pos[None, :]
    scores = jnp.where(causal, jnp.einsum('bhnti,bhnsi->bhnts', q_dec, k_inv), 0.0)
    o_intra = jnp.einsum('bhnts,bhnsj->bhntj', scores, vc)
    kv_chunk = jnp.einsum('bhnsi,bhnsj->nbhij', k_end, vc)
    decay = jnp.exp(last[:, :, :, 0, :]).transpose(2, 0, 1, 3)

    def step(state, inp):
        d, kv = inp
        return d[..., None] * state + kv, state

    init = jnp.zeros((b, GLA_HEADS, GLA_HEAD_DK, GLA_HEAD_DV), f32)
    _, s_prev = lax.scan(step, init, (decay, kv_chunk))
    o_inter = jnp.einsum('bhnti,nbhij->bhntj', q_dec, s_prev)
    o = (o_intra + o_inter).reshape(b, GLA_HEADS, s, GLA_HEAD_DV)
    o = o * lax.rsqrt(jnp.mean(o * o, axis=-1, keepdims=True) + EPS) * norm_g.astype(f32)
    o = merge_heads(o) * jax.nn.silu(g_out.astype(f32))
    return o.astype(q.dtype)


def rglru_mixer(x_in, gate_in, conv_w, conv_b, w_a, b_a, w_x, b_x, lam):
    f32 = jnp.float32
    xc = lax.conv_general_dilated(
        x_in, conv_w[:, None, :], window_strides=(1,), padding=[(CONV_WIDTH - 1, 0)],
        dimension_numbers=('NWC', 'WIO', 'NWC'), feature_group_count=LRU_WIDTH) + conv_b
    b, s, _ = xc.shape
    xb = xc.reshape(b, s, LRU_BLOCKS, LRU_BLOCK)
    r = jax.nn.sigmoid((jnp.einsum('bthi,hij->bthj', xb, w_a).reshape(b, s, LRU_WIDTH) + b_a).astype(f32))
    i = jax.nn.sigmoid((jnp.einsum('bthi,hij->bthj', xb, w_x).reshape(b, s, LRU_WIDTH) + b_x).astype(f32))
    log_a = -LRU_C * r * jax.nn.softplus(-lam.astype(f32))
    a = jnp.exp(log_a)
    u = jnp.sqrt(-jnp.expm1(2.0 * log_a)) * i * xc.astype(f32)

    def combine(left, right):
        a1, b1 = left
        a2, b2 = right
        return a1 * a2, a2 * b1 + b2

    _, h = lax.associative_scan(combine, (a, u), axis=1)
    y = h * jax.nn.gelu(gate_in.astype(f32))
    return y.astype(x_in.dtype)


def stick_breaking_mixer(q, k, v, q_g, k_g):
    f32 = jnp.float32
    b, s, _ = q.shape

    def qk_norm(t, g):
        t = split_heads(t.astype(f32), SB_HEADS)
        return t * lax.rsqrt(jnp.mean(t * t, axis=-1, keepdims=True) + EPS) * g.astype(f32)

    qh = qk_norm(q, q_g) * (SB_HEAD_DIM ** -0.5)
    kh = qk_norm(k, k_g)
    vh = split_heads(v.astype(f32), SB_HEADS)
    outs = []
    for blk in range(s // SB_QBLOCK):
        q0 = blk * SB_QBLOCK
        q1 = q0 + SB_QBLOCK
        z = jnp.einsum('bhqd,bhkd->bhqk', qh[:, :, q0:q1], kh[:, :, :q1])
        valid = jnp.arange(q1)[None, :] < jnp.arange(q0, q1)[:, None]
        log_keep = jnp.where(valid, jax.nn.log_sigmoid(-z), 0.0)
        after = lax.cumsum(log_keep, axis=3, reverse=True) - log_keep
        w = jnp.where(valid, jnp.exp(jax.nn.log_sigmoid(z) + after), 0.0)
        outs.append(jnp.einsum('bhqk,bhkd->bhqd', w, vh[:, :, :q1]))
    o = jnp.concatenate(outs, axis=2)
    return merge_heads(o).astype(v.dtype)


def hybrid_layer(x, norm_mix_g, w_in, gla_w_up, gla_b_alpha, gla_norm_g,
                 lru_conv_w, lru_conv_b, lru_w_a, lru_b_a, lru_w_x, lru_b_x, lru_lambda,
                 sb_q_norm_g, sb_k_norm_g, w_branch_a, w_branch_b, w_branch_c, b_gate,
                 w_out, norm_mlp_g, w_mlp_up, w_mlp_down):
    b, s, _ = x.shape
    xn = rms_norm(x, norm_mix_g)
    proj = xn @ w_in
    offsets = [int(o) for o in np.cumsum(IN_SIZES)[:-1]]
    gq, gk, gv, gg, gdown, lx, lgate, sq, sk, sv, gate_logits = jnp.split(proj, offsets, axis=-1)
    o_a = gla_mixer(gq, gk, gv, gg, gdown, gla_w_up, gla_b_alpha, gla_norm_g)
    o_b = rglru_mixer(lx, lgate, lru_conv_w, lru_conv_b, lru_w_a, lru_b_a, lru_w_x, lru_b_x, lru_lambda)
    o_c = stick_breaking_mixer(sq, sk, sv, sb_q_norm_g, sb_k_norm_g)
    gates = jax.nn.sigmoid((gate_logits + b_gate).astype(jnp.float32)).astype(x.dtype)
    gates = gates.reshape(b, s, N_BRANCHES, D_MODEL)
    merged = (gates[:, :, 0] * (o_a @ w_branch_a)
              + gates[:, :, 1] * (o_b @ w_branch_b)
              + gates[:, :, 2] * (o_c @ w_branch_c))
    x = x + merged @ w_out
    h = rms_norm(x, norm_mlp_g)
    x = x + jnp.square(jax.nn.relu(h @ w_mlp_up)) @ w_mlp_down
    return x


def setup_inputs(seed: int = 0) -> dict:
    key = jax.random.key(seed)
    ks = jax.random.split(key, 23)
    f32 = jnp.float32

    def dense(k, shape, fan_in, scale=1.0):
        return jax.random.normal(k, shape, f32) * (scale * fan_in ** -0.5)

    def gain(k, shape):
        return 1.0 + 0.02 * jax.random.normal(k, shape, f32)

    def bias(k, shape, scale=0.02):
        return scale * jax.random.normal(k, shape, f32)

    a0 = jax.random.uniform(ks[12], (DEPTH, LRU_WIDTH), f32, minval=0.9, maxval=0.999)
    return {
        'x': jax.random.normal(ks[0], (BATCH, SEQ, D_MODEL), f32),
        'norm_mix_g': gain(ks[1], (DEPTH, D_MODEL)),
        'w_in': dense(ks[2], (DEPTH, D_MODEL, IN_COLS), D_MODEL),
        'gla_w_up': dense(ks[3], (DEPTH, GLA_RANK, GLA_DK), GLA_RANK),
        'gla_b_alpha': bias(ks[4], (DEPTH, GLA_DK), 0.1),
        'gla_norm_g': gain(ks[5], (DEPTH, GLA_HEAD_DV)),
        'lru_conv_w': dense(ks[6], (DEPTH, CONV_WIDTH, LRU_WIDTH), CONV_WIDTH),
        'lru_conv_b': bias(ks[7], (DEPTH, LRU_WIDTH)),
        'lru_w_a': dense(ks[8], (DEPTH, LRU_BLOCKS, LRU_BLOCK, LRU_BLOCK), LRU_BLOCK),
        'lru_b_a': bias(ks[9], (DEPTH, LRU_WIDTH)),
        'lru_w_x': dense(ks[10], (DEPTH, LRU_BLOCKS, LRU_BLOCK, LRU_BLOCK), LRU_BLOCK),
        'lru_b_x': bias(ks[11], (DEPTH, LRU_WIDTH)),
        'lru_lambda': jnp.log(a0) - jnp.log1p(-a0),
        'sb_q_norm_g': gain(ks[13], (DEPTH, SB_HEAD_DIM)),
        'sb_k_norm_g': gain(ks[14], (DEPTH, SB_HEAD_DIM)),
        'w_branch_a': dense(ks[15], (DEPTH, GLA_DV, D_MODEL), GLA_DV),
        'w_branch_b': dense(ks[16], (DEPTH, LRU_WIDTH, D_MODEL), LRU_WIDTH),
        'w_branch_c': dense(ks[17], (DEPTH, SB_DIM, D_MODEL), SB_DIM),
        'b_gate': bias(ks[18], (DEPTH, N_BRANCHES * D_MODEL)),
        'w_out': dense(ks[19], (DEPTH, D_MODEL, D_MODEL), D_MODEL, 0.5),
        'norm_mlp_g': gain(ks[20], (DEPTH, D_MODEL)),
        'w_mlp_up': dense(ks[21], (DEPTH, D_MODEL, D_FF), D_MODEL),
        'w_mlp_down': dense(ks[22], (DEPTH, D_FF, D_MODEL), D_FF, 0.5),
    }


def reference(x, norm_mix_g, w_in, gla_w_up, gla_b_alpha, gla_norm_g,
              lru_conv_w, lru_conv_b, lru_w_a, lru_b_a, lru_w_x, lru_b_x, lru_lambda,
              sb_q_norm_g, sb_k_norm_g, w_branch_a, w_branch_b, w_branch_c, b_gate,
              w_out, norm_mlp_g, w_mlp_up, w_mlp_down):
    for l in range(DEPTH):
        x = hybrid_layer(x, norm_mix_g[l], w_in[l], gla_w_up[l], gla_b_alpha[l], gla_norm_g[l],
                         lru_conv_w[l], lru_conv_b[l], lru_w_a[l], lru_b_a[l], lru_w_x[l], lru_b_x[l],
                         lru_lambda[l], sb_q_norm_g[l], sb_k_norm_g[l], w_branch_a[l], w_branch_b[l],
                         w_branch_c[l], b_gate[l], w_out[l], norm_mlp_g[l], w_mlp_up[l], w_mlp_down[l])
    return x
```

```cpp
#include <hip/hip_runtime.h>
#include <cstdio>

#ifndef MK_ONE_LAUNCH
#define MK_ONE_LAUNCH 1
#endif

#define LAS __attribute__((address_space(3)))
#define GAS __attribute__((address_space(1)))
typedef unsigned short bf16;
typedef unsigned v4u __attribute__((ext_vector_type(4)));
typedef unsigned v2u __attribute__((ext_vector_type(2)));
typedef float f32x4 __attribute__((ext_vector_type(4)));
typedef float f32x2 __attribute__((ext_vector_type(2)));
typedef short bf16x8 __attribute__((ext_vector_type(8)));

constexpr int D = 1024, BATCH = 8, T = 2048, M = BATCH * T, DEPTH = 4, FF = 4096;
constexpr int SRC_COLS = 11280;
constexpr int PN = 11264;
constexpr int OFF_GQ = 0, OFF_GK = 512, OFF_GV = 1024, OFF_GG = 2048, OFF_LX = 3072, OFF_LG = 4096, OFF_SQ = 5120, OFF_SK = 6144, OFF_SV = 7168, OFF_GATE = 8192;
constexpr int SRC_GDOWN = 3072;
constexpr float EPS = 1e-6f;
constexpr int NP = 11;
constexpr int NPH = 1 + DEPTH * NP;

constexpr size_t MiB = 1u << 20;
constexpr size_t WS_CTL = 0, CTL_ZERO_BYTES = 64 * 1024;
constexpr size_t WS_DECAY = 1 * MiB;
constexpr size_t WS_SSQ = 2 * MiB;
constexpr size_t WS_SPL = 512 * 1024;
constexpr size_t WS_W = 4 * MiB;
constexpr size_t WL_IN = 0, WL_BR = 22 * MiB, WL_OUT = 28 * MiB, WL_UP = 30 * MiB, WL_DN = 38 * MiB, WL_G = 46 * MiB, WL_STRIDE = 47 * MiB;
constexpr size_t WS_XN = 192 * MiB;
constexpr size_t WS_XC = 224 * MiB;
constexpr size_t WS_U = 256 * MiB;
constexpr size_t WS_KE = 288 * MiB;
constexpr size_t WS_PROJ = 304 * MiB;
constexpr size_t WS_END = WS_PROJ + (size_t)M * PN * 2;
static_assert(WS_W + DEPTH * WL_STRIDE <= WS_XN, "ws map");
constexpr int CW_BAR = 1024;

constexpr int RING_BYTES = 131072;
constexpr int MISC_OFF = RING_BYTES + 320;
constexpr int LDS_BYTES = 147456;

__device__ __forceinline__ float bf2f(unsigned b) { return __uint_as_float(b << 16); }
__device__ __forceinline__ unsigned f2bf(float f) { unsigned u = __float_as_uint(f); return (u + 0x7fffu + ((u >> 16) & 1u)) >> 16; }
__device__ __forceinline__ unsigned pk2(float lo, float hi) { return f2bf(lo) | (f2bf(hi) << 16); }
__device__ __forceinline__ float blo(unsigned w) { return __uint_as_float(w << 16); }
__device__ __forceinline__ float bhi(unsigned w) { return __uint_as_float(w & 0xffff0000u); }
__device__ __forceinline__ float shx(float v, int o, int lane) { return __int_as_float(__builtin_amdgcn_ds_bpermute((lane ^ o) << 2, __float_as_int(v))); }
__device__ __forceinline__ float wave_sum(float v, int lane) {
#pragma unroll
    for (int o = 1; o < 64; o <<= 1) v += shx(v, o, lane);
    return v;
}
__device__ __forceinline__ float sigmoidf_(float x) { return 1.f / (1.f + __expf(-x)); }
__device__ __forceinline__ float logsigmoidf_(float x) { return fminf(x, 0.f) - log1pf(__expf(-fabsf(x))); }
#define LDS_WAIT() asm volatile("s_waitcnt lgkmcnt(0)" ::: "memory")
__device__ __forceinline__ int opaque_tid() { int t = threadIdx.x; asm volatile("" : "+v"(t)); return t; }

#define XB_TMO      128
#define XB_XCNT(j)  (256  + 64 * (j))
#define XB_XSUB(j)  (1280 + 64 * (j))
#define XB_XGEN(j)  (2304 + 64 * (j))
#define XB_TOP      3328
#define XB_TOPGEN   3392
#define XCD_BAR_WORDS 3456
#define XB_SPIN_CAP (1u << 18)
__device__ __forceinline__ unsigned xb_ld(unsigned* p)              { return __hip_atomic_load(p, __ATOMIC_RELAXED, __HIP_MEMORY_SCOPE_AGENT); }
__device__ __forceinline__ unsigned xb_add(unsigned* p, unsigned v) { return __hip_atomic_fetch_add(p, v, __ATOMIC_RELAXED, __HIP_MEMORY_SCOPE_AGENT); }
__device__ __forceinline__ unsigned xb_xcc_id() { return (unsigned)__builtin_amdgcn_s_getreg((3 << 11) | 20) & 0xFu; }
#define XB_SPIN(cond, bar) do { unsigned _sp = 0; while (cond) { __builtin_amdgcn_s_sleep(1); \
    if ((++_sp & 255u) == 0u) { if (xb_ld(&(bar)[XB_TMO])) break; if (_sp > XB_SPIN_CAP) { atomicAdd(&(bar)[XB_TMO], 1u); break; } } } } while (0)
struct XcdBarrier { unsigned* bar; unsigned x; volatile LAS unsigned* st; };
__device__ __forceinline__ XcdBarrier xcd_barrier_post(unsigned* bar, volatile LAS unsigned* st) {
    XcdBarrier b; b.bar = bar; b.x = xb_xcc_id(); b.st = st;
    if (threadIdx.x == 0) (void)xb_add(&bar[XB_XCNT(b.x)], 1u);
    return b;
}
__device__ __forceinline__ void xcd_barrier_complete(unsigned* bar, unsigned x, unsigned& nloc, unsigned& nx) {
    const unsigned G = gridDim.x * gridDim.y * gridDim.z;
    unsigned sum, cnt, mine, sp = 0u;
    for (;;) {
        sum = 0u; cnt = 0u; mine = 0u;
#pragma unroll
        for (unsigned j = 0; j < 16; ++j) { const unsigned c = xb_ld(&bar[XB_XCNT(j)]); sum += c; cnt += (c > 0u) ? 1u : 0u; mine = (j == x) ? c : mine; }
        if (sum == G) break;
        __builtin_amdgcn_s_sleep(1);
        if ((++sp & 255u) == 0u) { if (xb_ld(&bar[XB_TMO])) break; if (sp > XB_SPIN_CAP) { atomicAdd(&bar[XB_TMO], 1u); break; } }
    }
    nloc = mine > 0u ? mine : 1u; nx = cnt > 0u ? cnt : 1u;
}
__device__ __forceinline__ void xcd_barrier(const XcdBarrier& b) {
    asm volatile("s_waitcnt vmcnt(0)" ::: "memory");
    __syncthreads();
    if (threadIdx.x == 0) {
        unsigned* bar = b.bar; asm volatile("" : "+s"(bar));
        __builtin_amdgcn_s_waitcnt(0);
        unsigned nloc = b.st[0], nx = b.st[1];
        if (nloc == 0u) { xcd_barrier_complete(bar, b.x, nloc, nx); b.st[0] = nloc; b.st[1] = nx; }
        const unsigned old = xb_add(&bar[XB_XSUB(b.x)], 1u);
        const unsigned gen = old / nloc;
        if (old + 1u == (gen + 1u) * nloc) {
            __builtin_amdgcn_fence(__ATOMIC_RELEASE, "agent");
            asm volatile("s_waitcnt vmcnt(0)" ::: "memory");
            const unsigned og = xb_add(&bar[XB_TOP], 1u);
            const unsigned tg = og / nx;
            if (og + 1u == (tg + 1u) * nx) xb_add(&bar[XB_TOPGEN], 1u);
            else XB_SPIN(xb_ld(&bar[XB_TOPGEN]) == tg, bar);
            __builtin_amdgcn_fence(__ATOMIC_ACQUIRE, "agent");
            xb_add(&bar[XB_XGEN(b.x)], 1u);
            asm volatile("s_waitcnt vmcnt(0)" ::: "memory");
        } else {
            XB_SPIN(xb_ld(&bar[XB_XGEN(b.x)]) == gen, bar);
            __builtin_amdgcn_fence(__ATOMIC_ACQUIRE, "agent");
            asm volatile("s_waitcnt vmcnt(0)" ::: "memory");
        }
    }
    __syncthreads();
}

namespace pg8 {
constexpr int BM = 256, BK = 64, HALF = 128, HTB = HALF * BK * 2, STAGE_BYTES = 8 * HTB, NXCD = 8, WGM = 8;
__host__ __device__ __forceinline__ int lds_byte(int r, int c) { const int st = (r >> 4) * 2 + (c >> 5), rr = r & 15, cc = c & 31, ob = rr * 64 + cc * 2; return st * 1024 + (ob ^ (((ob >> 9) & 1) << 5)); }
__host__ __device__ __forceinline__ void stage_rc(int b, int& R, int& C) { const int st = b / 1024, sb = b % 1024, swz = sb ^ (((sb >> 9) & 1) << 5); R = (st >> 1) * 16 + swz / 64; C = (st & 1) * 32 + (swz % 64) / 2; }
__host__ __device__ __forceinline__ int perm32(int rho) { const int n = rho >> 4, i = rho & 15; return 8 * (i >> 2) + 4 * n + (i & 3); }
struct Unit { int pm, pn, aux; };
struct Gemm { int lda, ldb, K; };
__device__ __forceinline__ unsigned cvt_pk_bf16(float lo, float hi) { unsigned r; asm volatile("v_cvt_pk_bf16_f32 %0, %1, %2" : "=v"(r) : "v"(lo), "v"(hi)); return r; }

struct SchedStd {
    const char* A; const char* B; size_t tstepA, tstepB; int nM, nN, nwg, G, c;
    __device__ __forceinline__ void init(const void* A_, const void* B_, int lda, int ldb, int Mr, int Nc, int G_, int c_) { A = (const char*)A_; B = (const char*)B_; tstepA = (size_t)BM * lda * 2; tstepB = (size_t)BM * ldb * 2; nM = Mr / BM; nN = Nc / BM; nwg = nM * nN; G = G_; c = c_; }
    __device__ __forceinline__ bool next(int i, Unit& u) const {
        const long L = (long)i * G + c; if (L >= nwg) return false;
        int wgid = (int)L; { const int q = nwg / NXCD, r = nwg % NXCD, xcd = wgid % NXCD, off = wgid / NXCD; wgid = (xcd < r ? xcd * (q + 1) : r * (q + 1) + (xcd - r) * q) + off; }
        const int nig = WGM * nN, gid = wgid / nig, fm = gid * WGM, gsz = (nM - fm) < WGM ? (nM - fm) : WGM;
        u.pm = fm + ((wgid % nig) % gsz); u.pn = (wgid % nig) / gsz; u.aux = 0; return true;
    }
    __device__ __forceinline__ const char* abase(const Unit& u) const { return A + (size_t)u.pm * tstepA; }
    __device__ __forceinline__ const char* bbase(const Unit& u) const { return B + (size_t)u.pn * tstepB; }
};

template <class Epi, class Sched, bool ALIGN_EPI, bool SP2>
__device__ __forceinline__ void gemm_phase(LAS unsigned char* lds, const Gemm g, const Sched& S, const Epi& E) {
    const int tid = opaque_tid(), wid = __builtin_amdgcn_readfirstlane(tid >> 6), lane = tid & 63, wr = wid >> 2, wc = wid & 3, fr = lane & 15, fq = lane >> 4;
    const int K = g.K, nt = K / BK;
    unsigned voffA[2], voffB[2];
#pragma unroll
    for (int i = 0; i < 2; ++i) { int R, C; stage_rc(tid * 16 + i * 8192, R, C); const int Rb = Epi::PERM ? ((R & ~31) + perm32(R & 31)) : R;
        voffA[i] = (unsigned)(R * g.lda + C) * 2u; voffB[i] = (unsigned)(Rb * g.ldb + C) * 2u; }
    const size_t kstep = (size_t)(BK * 2);
    const size_t hstepA = (size_t)HALF * g.lda * 2, hstepB = (size_t)HALF * g.ldb * 2;
    const unsigned ldsw = (unsigned)wid * 1024u;
    const int aoff = lds_byte(wr * 64 + fr, fq * 8), boff = lds_byte(wc * 32 + fr, fq * 8);
#define PG8_SA(b, h) (((b) * 2 + (h)) * HTB)
#define PG8_SB(b, h) ((4 + (b) * 2 + (h)) * HTB)
#define PG8_STAGE(bufoff, gbase, voff) do { _Pragma("unroll") for (int _i = 0; _i < 2; ++_i) \
        __builtin_amdgcn_global_load_lds((const unsigned*)((const char*)(gbase) + (voff)[_i]), (LAS unsigned*)(lds + (bufoff) + ldsw + _i * 8192), 16, 0, 0); } while (0)
#define PG8_LDA(dst, b, h) do { _Pragma("unroll") for (int m = 0; m < 4; ++m) _Pragma("unroll") for (int k = 0; k < 2; ++k) dst[m][k] = *(const LAS bf16x8*)(lds + PG8_SA(b, h) + aoff + m * 2048 + k * 1024); } while (0)
#define PG8_LDB(dst, b, h) do { _Pragma("unroll") for (int n = 0; n < 2; ++n) _Pragma("unroll") for (int k = 0; k < 2; ++k) dst[n][k] = *(const LAS bf16x8*)(lds + PG8_SB(b, h) + boff + n * 2048 + k * 1024); } while (0)
#define PG8_MMA(ai, bj, At, Bt) do { __builtin_amdgcn_s_setprio(1); _Pragma("unroll") for (int m = 0; m < 4; ++m) _Pragma("unroll") for (int n = 0; n < 2; ++n) _Pragma("unroll") for (int k = 0; k < 2; ++k) \
        acc[ai][bj][m][n] = __builtin_amdgcn_mfma_f32_16x16x32_bf16(Bt[n][k], At[m][k], acc[ai][bj][m][n], 0, 0, 0); __builtin_amdgcn_s_setprio(0); } while (0)
#define PG8_WAIT_V(n) asm volatile("s_waitcnt vmcnt(" #n ")" ::: "memory")
#define PG8_WAIT_L(n) asm volatile("s_waitcnt lgkmcnt(" #n ")" ::: "memory")
#define PG8_BAR __builtin_amdgcn_s_barrier()
#define PG8_SCHED __builtin_amdgcn_sched_barrier(0)
    Unit cur, nxt; int ui = 0;
    if (!S.next(0, cur)) return;
    f32x4 acc[2][2][4][2];
#pragma unroll
    for (int a = 0; a < 2; ++a)
#pragma unroll
        for (int b = 0; b < 2; ++b)
#pragma unroll
            for (int m = 0; m < 4; ++m)
#pragma unroll
                for (int n = 0; n < 2; ++n) acc[a][b][m][n] = (f32x4){0.f, 0.f, 0.f, 0.f};
    bf16x8 At[4][2], B0[2][2], B1[2][2];
    const char* cA = S.abase(cur); const char* cB = S.bbase(cur);
    if constexpr (SP2) {
        PG8_STAGE(PG8_SB(0, 0), cB, voffB); PG8_STAGE(PG8_SB(0, 1), cB + hstepB, voffB); PG8_STAGE(PG8_SA(0, 0), cA, voffA); PG8_STAGE(PG8_SA(0, 1), cA + hstepA, voffA);
        if (wr == 1) PG8_BAR;
        PG8_WAIT_V(2); PG8_BAR;
        PG8_STAGE(PG8_SB(1, 0), cB + kstep, voffB); PG8_STAGE(PG8_SA(1, 0), cA + kstep, voffA); PG8_STAGE(PG8_SB(1, 1), cB + hstepB + kstep, voffB);
        PG8_WAIT_V(6); PG8_BAR;
    } else {
        PG8_STAGE(PG8_SB(0, 0), cB, voffB); PG8_STAGE(PG8_SA(0, 0), cA, voffA); PG8_STAGE(PG8_SB(0, 1), cB + hstepB, voffB); PG8_STAGE(PG8_SA(0, 1), cA + hstepA, voffA);
        if (wr == 1) PG8_BAR;
        PG8_WAIT_V(4); PG8_BAR;
        PG8_STAGE(PG8_SB(1, 0), cB + kstep, voffB); PG8_STAGE(PG8_SA(1, 0), cA + kstep, voffA); PG8_STAGE(PG8_SB(1, 1), cB + hstepB + kstep, voffB);
        PG8_WAIT_V(6); PG8_BAR;
    }
    for (;;) {
        const bool has_next = S.next(ui + 1, nxt);
        const char* nA = has_next ? S.abase(nxt) : cA; const char* nB = has_next ? S.bbase(nxt) : cB;
#pragma nounroll
        for (int t = 0; t < nt; t += 2) {
            const bool last = (t == nt - 2);
            const char* a1 = cA + (size_t)(t + 1) * kstep;
            const char* a2 = last ? nA : cA + (size_t)(t + 2) * kstep; const char* b2 = last ? nB : cB + (size_t)(t + 2) * kstep;
            const char* a3 = a2 + kstep; const char* b3 = b2 + kstep;
            if constexpr (SP2) {
            PG8_LDB(B0, 0, 0); PG8_LDB(B1, 0, 1); PG8_SCHED; PG8_LDA(At, 0, 0); PG8_STAGE(PG8_SA(1, 1), a1 + hstepA, voffA);
            PG8_WAIT_V(8); PG8_WAIT_L(0); PG8_BAR; PG8_MMA(0, 0, At, B0); PG8_MMA(0, 1, At, B1); PG8_BAR; PG8_SCHED;
            PG8_LDA(At, 0, 1); PG8_STAGE(PG8_SB(0, 0), b2, voffB); PG8_STAGE(PG8_SB(0, 1), b2 + hstepB, voffB); PG8_STAGE(PG8_SA(0, 0), a2, voffA);
            PG8_WAIT_V(8); PG8_WAIT_L(0); PG8_BAR; PG8_MMA(1, 0, At, B0); PG8_MMA(1, 1, At, B1); PG8_BAR; PG8_SCHED;
            PG8_LDB(B0, 1, 0); PG8_LDB(B1, 1, 1); PG8_SCHED; PG8_LDA(At, 1, 0); PG8_STAGE(PG8_SA(0, 1), a2 + hstepA, voffA);
            PG8_WAIT_V(8); PG8_WAIT_L(0); PG8_BAR; PG8_MMA(0, 0, At, B0); PG8_MMA(0, 1, At, B1); PG8_BAR; PG8_SCHED;
            PG8_LDA(At, 1, 1); PG8_STAGE(PG8_SB(1, 0), b3, voffB); PG8_STAGE(PG8_SB(1, 1), b3 + hstepB, voffB); PG8_STAGE(PG8_SA(1, 0), a3, voffA);
            PG8_WAIT_V(8); PG8_WAIT_L(0); PG8_BAR; PG8_MMA(1, 0, At, B0); PG8_MMA(1, 1, At, B1); PG8_BAR; PG8_SCHED;
            } else {
            PG8_LDB(B0, 0, 0); PG8_SCHED; PG8_LDA(At, 0, 0); PG8_STAGE(PG8_SA(1, 1), a1 + hstepA, voffA);
            PG8_WAIT_L(8); PG8_BAR; PG8_WAIT_L(0); PG8_MMA(0, 0, At, B0); PG8_BAR; PG8_SCHED;
            PG8_LDB(B1, 0, 1); PG8_STAGE(PG8_SB(0, 0), b2, voffB);
            PG8_BAR; PG8_WAIT_L(0); PG8_MMA(0, 1, At, B1); PG8_BAR;
            PG8_LDA(At, 0, 1); PG8_STAGE(PG8_SA(0, 0), a2, voffA);
            PG8_BAR; PG8_WAIT_L(0); PG8_MMA(1, 0, At, B0); PG8_BAR; PG8_SCHED;
            PG8_STAGE(PG8_SB(0, 1), b2 + hstepB, voffB);
            PG8_WAIT_V(6); PG8_BAR; PG8_MMA(1, 1, At, B1); PG8_BAR;
            PG8_LDB(B0, 1, 0); PG8_SCHED; PG8_LDA(At, 1, 0); PG8_STAGE(PG8_SA(0, 1), a2 + hstepA, voffA);
            PG8_WAIT_L(8); PG8_BAR; PG8_WAIT_L(0); PG8_MMA(0, 0, At, B0); PG8_BAR; PG8_SCHED;
            PG8_LDB(B1, 1, 1); PG8_STAGE(PG8_SB(1, 0), b3, voffB);
            PG8_BAR; PG8_WAIT_L(0); PG8_MMA(0, 1, At, B1); PG8_BAR;
            PG8_LDA(At, 1, 1); PG8_STAGE(PG8_SA(1, 0), a3, voffA);
            PG8_BAR; PG8_WAIT_L(0); PG8_MMA(1, 0, At, B0); PG8_BAR; PG8_SCHED;
            PG8_STAGE(PG8_SB(1, 1), b3 + hstepB, voffB);
            PG8_WAIT_V(6); PG8_BAR; PG8_MMA(1, 1, At, B1); PG8_BAR;
            }
        }
        if constexpr (ALIGN_EPI) { if (wr == 0) PG8_BAR; }
        const bool zero = E(acc, cur, wr, wc, fr, fq);
        if (!has_next) break;
        if (zero) {
#pragma unroll
        for (int a = 0; a < 2; ++a)
#pragma unroll
            for (int b = 0; b < 2; ++b)
#pragma unroll
                for (int m = 0; m < 4; ++m)
#pragma unroll
                    for (int n = 0; n < 2; ++n) acc[a][b][m][n] = (f32x4){0.f, 0.f, 0.f, 0.f};
        }
        cur = nxt; cA = nA; cB = nB; ++ui;
        if constexpr (ALIGN_EPI) { if (wr == 1) PG8_BAR; }
    }
    PG8_WAIT_V(0);
    if constexpr (!ALIGN_EPI) { if (wr == 0) PG8_BAR; }
    PG8_BAR;
#undef PG8_SA
#undef PG8_SB
#undef PG8_STAGE
#undef PG8_LDA
#undef PG8_LDB
#undef PG8_MMA
#undef PG8_WAIT_V
#undef PG8_WAIT_L
#undef PG8_BAR
#undef PG8_SCHED
}

template <int ACT> struct EpiBf16 {
    static constexpr bool PERM = true;
    bf16* O; int ldc;
    __device__ __forceinline__ bool operator()(f32x4 (&acc)[2][2][4][2], const Unit& u, int wr, int wc, int fr, int fq) const {
        const int row0 = u.pm * BM + wr * 64 + fr, col0 = u.pn * BM + wc * 32 + 8 * fq;
#pragma unroll
        for (int ai = 0; ai < 2; ++ai)
#pragma unroll
            for (int m = 0; m < 4; ++m) { bf16* rowp = O + (size_t)(row0 + ai * HALF + m * 16) * ldc + col0;
#pragma unroll
                for (int bj = 0; bj < 2; ++bj) { f32x4 v0 = acc[ai][bj][m][0], v1 = acc[ai][bj][m][1];
                    if (ACT == 1) {
#pragma unroll
                        for (int j = 0; j < 4; ++j) { const float a = fmaxf(v0[j], 0.f), b = fmaxf(v1[j], 0.f); v0[j] = a * a; v1[j] = b * b; } }
                    v4u w; w.x = cvt_pk_bf16(v0[0], v0[1]); w.y = cvt_pk_bf16(v0[2], v0[3]); w.z = cvt_pk_bf16(v1[0], v1[1]); w.w = cvt_pk_bf16(v1[2], v1[3]);
                    *(v4u*)(rowp + bj * HALF) = w; } }
        return true;
    }
};
struct EpiResF32 {
    static constexpr bool PERM = false;
    const float* base; float* out; int ldc;
    __device__ __forceinline__ bool operator()(f32x4 (&acc)[2][2][4][2], const Unit& u, int wr, int wc, int fr, int fq) const {
        const int row0 = u.pm * BM + wr * 64 + fr, col0 = u.pn * BM + wc * 32 + 4 * fq;
#pragma unroll
        for (int ai = 0; ai < 2; ++ai)
#pragma unroll
            for (int m = 0; m < 4; ++m) { const size_t off = (size_t)(row0 + ai * HALF + m * 16) * ldc + col0;
#pragma unroll
                for (int bj = 0; bj < 2; ++bj)
#pragma unroll
                    for (int n = 0; n < 2; ++n) { const f32x4 bs = *(const f32x4*)(base + off + bj * HALF + n * 16); *(f32x4*)(out + off + bj * HALF + n * 16) = bs + acc[ai][bj][m][n]; } }
        return true;
    }
};
}

struct Args { const float* in[23]; float* out; unsigned char* ws; int ph_lo, ph_hi; };

struct Frame {
    LAS unsigned char* lds; unsigned char* ldsg;
    int tid, lane, wave, G, bid;
    float* out; unsigned char* ws;
    bf16 *XN, *XC, *U, *KE, *PROJ; float *DECAY, *SSQ;
};

__device__ __forceinline__ void transpose_item(const float* W, int ldw, int nblk, bf16* WT, int K, int row_off, LAS float* scr, int item, int lane) {
    const int kb = item / nblk, nb = item % nblk, k0 = 64 * kb, n0 = 32 * nb;
#pragma unroll 8
    for (int i = 0; i < 32; ++i) { const int kk = 2 * i + (lane >> 5); scr[kk * 33 + (lane & 31)] = W[(size_t)(k0 + kk) * ldw + n0 + (lane & 31)]; }
    LDS_WAIT(); asm volatile("" ::: "memory");
    const int c = lane & 7;
#pragma unroll
    for (int j = 0; j < 4; ++j) { const int n = (lane >> 3) + 8 * j; const LAS float* s = scr + (8 * c) * 33 + n;
        v4u o; o.x = pk2(s[0 * 33], s[1 * 33]); o.y = pk2(s[2 * 33], s[3 * 33]); o.z = pk2(s[4 * 33], s[5 * 33]); o.w = pk2(s[6 * 33], s[7 * 33]);
        *(v4u*)(WT + (size_t)(row_off + n0 + n) * K + k0 + 8 * c) = o; }
    LDS_WAIT(); asm volatile("" ::: "memory");
}
__device__ __forceinline__ void phase_convert(Frame& F, const Args& A) {
    F.tid = opaque_tid(); F.lane = F.tid & 63;
    LAS float* scr = (LAS float*)(F.lds + F.wave * 16384);
    const int gw = F.bid * 8 + F.wave, NGW = F.G * 8;
    constexpr int PER_L = 1536 + 4096 + 1536 + 512 + 2048 + 2048 + 256;
    for (int it = gw; it < DEPTH * PER_L; it += NGW) {
        const int l = it / PER_L; int r = it % PER_L;
        unsigned char* wl = F.ws + WS_W + (size_t)l * WL_STRIDE;
        const float* win = A.in[2] + (size_t)l * D * SRC_COLS;
        if (r < 1536) { transpose_item(win, SRC_COLS, 96, (bf16*)(wl + WL_IN), D, 0, scr, r, F.lane); continue; } r -= 1536;
        if (r < 4096) { transpose_item(win + 3088, SRC_COLS, 256, (bf16*)(wl + WL_IN), D, 3072, scr, r, F.lane); continue; } r -= 4096;
        if (r < 1536) { const int br = r / 512; const float* wb = br == 0 ? A.in[15] : (br == 1 ? A.in[16] : A.in[17]); transpose_item(wb + (size_t)l * D * D, D, 32, (bf16*)(wl + WL_BR), D, br * 1024, scr, r % 512, F.lane); continue; } r -= 1536;
        if (r < 512) { transpose_item(A.in[19] + (size_t)l * D * D, D, 32, (bf16*)(wl + WL_OUT), D, 0, scr, r, F.lane); continue; } r -= 512;
        if (r < 2048) { transpose_item(A.in[21] + (size_t)l * D * FF, FF, 128, (bf16*)(wl + WL_UP), D, 0, scr, r, F.lane); continue; } r -= 2048;
        if (r < 2048) { transpose_item(A.in[22] + (size_t)l * D * FF, D, 32, (bf16*)(wl + WL_DN), FF, 0, scr, r, F.lane); continue; } r -= 2048;
        { const int mtx = r / 32, rr = r % 32, blk = mtx >> 1, gate = mtx & 1, n0 = (rr % 8) * 32;
          const int row_off = (blk * 2 + (n0 >> 7)) * 256 + gate * 128 + (n0 & 127) - n0;
          const float* w = (gate ? A.in[10] : A.in[8]) + (size_t)l * 262144 + (size_t)blk * 65536;
          transpose_item(w, 256, 8, (bf16*)(wl + WL_G), 256, row_off, scr, rr, F.lane); }
    }
}

__device__ __forceinline__ void phase_rmsnorm(Frame& F, const float* x, const float* g, bf16* out) {
    F.tid = opaque_tid(); F.lane = F.tid & 63;
    const int gw = F.bid * 8 + F.wave, NGW = F.G * 8;
    f32x4 gv[4];
#pragma unroll
    for (int j = 0; j < 4; ++j) gv[j] = *((const f32x4*)g + F.lane + 64 * j);
    for (int m = gw; m < M; m += NGW) {
        const f32x4* xr = (const f32x4*)(x + (size_t)m * D) + F.lane;
        f32x4 v[4]; float s = 0.f;
#pragma unroll
        for (int j = 0; j < 4; ++j) { v[j] = xr[64 * j]; s += (v[j].x * v[j].x + v[j].y * v[j].y) + (v[j].z * v[j].z + v[j].w * v[j].w); }
        const float rs = 1.0f / sqrtf(wave_sum(s, F.lane) * (1.f / D) + EPS);
        v2u* o8 = (v2u*)(out + (size_t)m * D) + F.lane;
#pragma unroll
        for (int j = 0; j < 4; ++j) { v2u w; w.x = pk2(v[j].x * rs * gv[j].x, v[j].y * rs * gv[j].y); w.y = pk2(v[j].z * rs * gv[j].z, v[j].w * rs * gv[j].w); o8[64 * j] = w; }
    }
}

__device__ __forceinline__ void phase_prep(Frame& F, const Args& A, int l) {
    F.tid = opaque_tid(); F.lane = F.tid & 63;
    const int gt = F.bid * 512 + F.tid, NGT = F.G * 512;
    {
        const float* cw = A.in[6] + (size_t)l * 4 * D; const float* cb = A.in[7] + (size_t)l * D;
        for (int idx = gt; idx < M * 128; idx += NGT) {
            const int m = idx >> 7, c0 = (idx & 127) * 8, t = m & (T - 1);
            float acc[8];
#pragma unroll
            for (int j = 0; j < 8; ++j) acc[j] = cb[c0 + j];
#pragma unroll
            for (int jj = 0; jj < 4; ++jj) {
                if (t - 3 + jj >= 0) {
                    const v4u xv = *(const v4u*)(F.PROJ + (size_t)(m - 3 + jj) * PN + OFF_LX + c0);
                    const float* w = cw + jj * D + c0;
                    acc[0] += w[0] * blo(xv.x); acc[1] += w[1] * bhi(xv.x); acc[2] += w[2] * blo(xv.y); acc[3] += w[3] * bhi(xv.y);
                    acc[4] += w[4] * blo(xv.z); acc[5] += w[5] * bhi(xv.z); acc[6] += w[6] * blo(xv.w); acc[7] += w[7] * bhi(xv.w);
                }
            }
            v4u o; o.x = pk2(acc[0], acc[1]); o.y = pk2(acc[2], acc[3]); o.z = pk2(acc[4], acc[5]); o.w = pk2(acc[6], acc[7]);
            *(v4u*)(F.XC + (size_t)m * D + c0) = o;
        }
    }
    if (F.bid == 0) { const float* lam = A.in[12] + (size_t)l * D; float* spl = (float*)(F.ws + WS_SPL);
        for (int c = F.tid; c < D; c += 512) { const float nl = -lam[c]; spl[c] = fmaxf(nl, 0.f) + log1pf(__expf(-fabsf(nl))); } }
    {
        const float* qg = A.in[13] + (size_t)l * 128; const float* kg = A.in[14] + (size_t)l * 128;
        const int sub = F.lane >> 4, l16 = F.lane & 15;
        const int gw = F.bid * 8 + F.wave, NGW = F.G * 8;
        for (int it4 = gw; it4 < M * 16 / 4; it4 += NGW) {
            const int item = it4 * 4 + sub, m = item >> 4, hh = item & 15;
            const int col = (hh < 8 ? OFF_SQ + hh * 128 : OFF_SK + (hh - 8) * 128) + l16 * 8;
            const float* g = (hh < 8 ? qg : kg) + l16 * 8;
            const float sc = hh < 8 ? 0.08838834764831845f : 1.0f;
            bf16* p = F.PROJ + (size_t)m * PN + col;
            const v4u xv = *(const v4u*)p;
            float v[8] = {blo(xv.x), bhi(xv.x), blo(xv.y), bhi(xv.y), blo(xv.z), bhi(xv.z), blo(xv.w), bhi(xv.w)};
            float s = 0.f;
#pragma unroll
            for (int j = 0; j < 8; ++j) s += v[j] * v[j];
            s += shx(s, 1, F.lane); s += shx(s, 2, F.lane); s += shx(s, 4, F.lane); s += shx(s, 8, F.lane);
            const float rs = sc / sqrtf(s * (1.f / 128.f) + EPS);
            v4u o; o.x = pk2(v[0] * rs * g[0], v[1] * rs * g[1]); o.y = pk2(v[2] * rs * g[2], v[3] * rs * g[3]); o.z = pk2(v[4] * rs * g[4], v[5] * rs * g[5]); o.w = pk2(v[6] * rs * g[6], v[7] * rs * g[7]);
            *(v4u*)p = o;
        }
    }
    {
        LAS float* ad = (LAS float*)F.lds;
        const float* win = A.in[2] + (size_t)l * D * SRC_COLS;
        const float* wup = A.in[3] + (size_t)l * 16 * 512; const float* bal = A.in[4] + (size_t)l * 512;
        for (int ch = F.bid; ch < M / 64; ch += F.G) {
            const int m0 = ch * 64;
            __syncthreads();
            { const int r = F.tid >> 3, jp = F.tid & 7;
              const bf16* xr = F.XN + (size_t)(m0 + r) * D; const float* wd = win + SRC_GDOWN + 2 * jp;
              float s0 = 0.f, s1 = 0.f;
              for (int k = 0; k < D; ++k) { const float xv = bf2f(xr[k]); s0 += xv * wd[(size_t)k * SRC_COLS]; s1 += xv * wd[(size_t)k * SRC_COLS + 1]; }
              ad[r * 16 + 2 * jp] = s0; ad[r * 16 + 2 * jp + 1] = s1; }
            __syncthreads();
            const int c = F.tid;
            float wu[16];
#pragma unroll
            for (int j = 0; j < 16; ++j) wu[j] = wup[j * 512 + c];
            const float ba = bal[c];
            float tot = 0.f;
            for (int t = 0; t < 64; ++t) { float lg = ba;
#pragma unroll
                for (int j = 0; j < 16; ++j) lg += ad[t * 16 + j] * wu[j];
                tot += logsigmoidf_(lg) * (1.f / 16.f); }
            float cum = 0.f;
            for (int t = 0; t < 64; ++t) { float lg = ba;
#pragma unroll
                for (int j = 0; j < 16; ++j) lg += ad[t * 16 + j] * wu[j];
                cum += logsigmoidf_(lg) * (1.f / 16.f);
                bf16* pq = F.PROJ + (size_t)(m0 + t) * PN + OFF_GQ + c; bf16* pk = F.PROJ + (size_t)(m0 + t) * PN + OFF_GK + c;
                const float q = bf2f(*pq), k = bf2f(*pk);
                *pq = (bf16)f2bf(q * 0.08838834764831845f * __expf(cum));
                *pk = (bf16)f2bf(k * __expf(-cum));
                F.KE[(size_t)(m0 + t) * 512 + c] = (bf16)f2bf(k * __expf(tot - cum)); }
            F.DECAY[(size_t)ch * 512 + c] = __expf(tot);
        }
    }
}

struct SchedLru {
    const char* A; const char* B; int G, c;
    __device__ __forceinline__ bool next(int i, pg8::Unit& u) const { const int L = i * G + c; if (L >= 512) return false; u.pm = L >> 3; u.pn = L & 7; u.aux = 0; return true; }
    __device__ __forceinline__ const char* abase(const pg8::Unit& u) const { return A + (size_t)u.pm * 256 * D * 2 + (size_t)(u.pn >> 1) * 256 * 2; }
    __device__ __forceinline__ const char* bbase(const pg8::Unit& u) const { return B + (size_t)u.pn * 256 * 256 * 2; }
};
struct EpiLru {
    static constexpr bool PERM = true;
    const bf16* XC; bf16* OMA; int ld_oma; bf16* U; const float* ba; const float* bx; const float* lam;
    __device__ __forceinline__ bool operator()(f32x4 (&acc)[2][2][4][2], const pg8::Unit& u, int wr, int wc, int fr, int fq) const {
        const int row0 = u.pm * 256 + wr * 64 + fr, chb = (u.pn >> 1) * 256 + (u.pn & 1) * 128 + wc * 32 + 8 * fq;
#pragma unroll
        for (int n = 0; n < 2; ++n) {
            const int ch0 = chb + 4 * n;
            const f32x4 b_a = *(const f32x4*)(ba + ch0), b_x = *(const f32x4*)(bx + ch0), sp = *(const f32x4*)(lam + ch0) * (-8.0f * 1.4426950408889634f);
#pragma unroll
            for (int ai = 0; ai < 2; ++ai)
#pragma unroll
                for (int m = 0; m < 4; ++m) { const int row = row0 + ai * 128 + m * 16;
                    const v2u xv = *(const v2u*)(XC + (size_t)row * D + ch0);
                    const float xc[4] = {blo(xv.x), bhi(xv.x), blo(xv.y), bhi(xv.y)};
                    float oa[4], uu[4];
#pragma unroll
                    for (int j = 0; j < 4; ++j) { const float pa = acc[ai][0][m][n][j] + b_a[j], px = acc[ai][1][m][n][j] + b_x[j];
                        const float r = __builtin_amdgcn_rcpf(1.0f + __builtin_amdgcn_exp2f(-1.4426950408889634f * pa)), ig = __builtin_amdgcn_rcpf(1.0f + __builtin_amdgcn_exp2f(-1.4426950408889634f * px));
                        const float a = __builtin_amdgcn_exp2f(r * sp[j]); const float om = 1.0f - a;
                        oa[j] = om; uu[j] = __builtin_amdgcn_sqrtf(om * (1.0f + a)) * ig * xc[j]; }
                    v2u w1; w1.x = pk2(oa[0], oa[1]); w1.y = pk2(oa[2], oa[3]);
                    v2u w2; w2.x = pk2(uu[0], uu[1]); w2.y = pk2(uu[2], uu[3]);
                    *(v2u*)(OMA + (size_t)row * ld_oma + ch0) = w1; *(v2u*)(U + (size_t)row * D + ch0) = w2;
                    asm volatile("" ::: "memory"); }
        }
        return true;
    }
};

struct SchedBranch {
    const char* P; const char* B; int G, c;
    __device__ __forceinline__ bool next(int i, pg8::Unit& u) const { const int tile = (i / 3) * G + c; if (tile >= 256) return false; u.pm = tile >> 2; u.pn = tile & 3; u.aux = i % 3; return true; }
    __device__ __forceinline__ const char* abase(const pg8::Unit& u) const { const int off = u.aux == 0 ? OFF_GG : (u.aux == 1 ? OFF_LG : OFF_SQ); return P + ((size_t)u.pm * 256 * PN + off) * 2; }
    __device__ __forceinline__ const char* bbase(const pg8::Unit& u) const { return B + (size_t)(u.aux * 1024 + u.pn * 256) * D * 2; }
};
struct EpiBranch {
    static constexpr bool PERM = true;
    const bf16* PROJ; const float* bg; bf16* O;
    __device__ __forceinline__ bool operator()(f32x4 (&acc)[2][2][4][2], const pg8::Unit& u, int wr, int wc, int fr, int fq) const {
        const int row0 = u.pm * 256 + wr * 64 + fr, col0 = u.pn * 256 + wc * 32 + 8 * fq, br = u.aux;
#pragma unroll
        for (int bj = 0; bj < 2; ++bj) {
            const int c = col0 + bj * 128;
            float b0[8], b1[8];
#pragma unroll
            for (int j = 0; j < 8; ++j) { b0[j] = bg[br * 1024 + c + j]; b1[j] = br < 2 ? bg[(br + 1) * 1024 + c + j] : 0.f; }
#pragma unroll
            for (int ai = 0; ai < 2; ++ai)
#pragma unroll
                for (int m = 0; m < 4; ++m) { const int row = row0 + ai * 128 + m * 16;
                    const bf16* gp = PROJ + (size_t)row * PN + OFF_GATE + br * 1024 + c;
                    const v4u l0 = *(const v4u*)gp;
                    const float x0[8] = {blo(l0.x), bhi(l0.x), blo(l0.y), bhi(l0.y), blo(l0.z), bhi(l0.z), blo(l0.w), bhi(l0.w)};
                    float f[8];
                    if (br < 2) { const v4u l1 = *(const v4u*)(gp + 1024);
                        const float x1[8] = {blo(l1.x), bhi(l1.x), blo(l1.y), bhi(l1.y), blo(l1.z), bhi(l1.z), blo(l1.w), bhi(l1.w)};
#pragma unroll
                        for (int j = 0; j < 8; ++j) f[j] = (1.0f + __expf(-(x1[j] + b1[j]))) / (1.0f + __expf(-(x0[j] + b0[j])));
                    } else {
#pragma unroll
                        for (int j = 0; j < 8; ++j) f[j] = 1.0f / (1.0f + __expf(-(x0[j] + b0[j])));
                    }
#pragma unroll
                    for (int j = 0; j < 8; ++j) acc[ai][bj][m][j >> 2][j & 3] *= f[j];
                    if (br == 2) { const f32x4 v0 = acc[ai][bj][m][0], v1 = acc[ai][bj][m][1];
                        v4u w; w.x = pg8::cvt_pk_bf16(v0[0], v0[1]); w.y = pg8::cvt_pk_bf16(v0[2], v0[3]); w.z = pg8::cvt_pk_bf16(v1[0], v1[1]); w.w = pg8::cvt_pk_bf16(v1[2], v1[3]);
                        *(v4u*)(O + (size_t)row * D + c) = w; } }
        }
        return br == 2;
    }
};

__device__ __forceinline__ void gla_main_item(Frame& F, int item) {
    F.tid = opaque_tid(); F.lane = F.tid & 63;
    const int b = item >> 5, h = (item >> 3) & 3, sl = item & 7, tid = F.tid;
    LAS bf16* qd = (LAS bf16*)F.lds;
    LAS bf16* ki = qd + 64 * 128; LAS bf16* ke = ki + 64 * 128;
    LAS float* vv = (LAS float*)(F.lds + 49152);
    LAS float* sc = vv + 64 * 32;
    LAS float* S = sc + 64 * 64;
    __syncthreads();
    for (int i = tid; i < 128 * 32; i += 512) S[i] = 0.f;
    const int vcol = OFF_GV + h * 256 + sl * 32;
    for (int n = 0; n < 32; ++n) {
        const int m0 = b * T + n * 64;
        __syncthreads();
        for (int cidx = tid; cidx < 1024; cidx += 512) { const int r = cidx >> 4, c8 = (cidx & 15) * 8;
            *(LAS v4u*)(qd + r * 128 + c8) = *(const v4u*)(F.PROJ + (size_t)(m0 + r) * PN + OFF_GQ + h * 128 + c8);
            *(LAS v4u*)(ki + r * 128 + c8) = *(const v4u*)(F.PROJ + (size_t)(m0 + r) * PN + OFF_GK + h * 128 + c8);
            *(LAS v4u*)(ke + r * 128 + c8) = *(const v4u*)(F.KE + (size_t)(m0 + r) * 512 + h * 128 + c8); }
        if (tid < 256) { const int r = tid >> 2, c8 = (tid & 3) * 8; const v4u x = *(const v4u*)(F.PROJ + (size_t)(m0 + r) * PN + vcol + c8);
            LAS float* d = vv + r * 32 + c8; d[0] = blo(x.x); d[1] = bhi(x.x); d[2] = blo(x.y); d[3] = bhi(x.y); d[4] = blo(x.z); d[5] = bhi(x.z); d[6] = blo(x.w); d[7] = bhi(x.w); }
        __syncthreads();
        { const int t = tid >> 3, s0 = (tid & 7) * 8;
          float a[8] = {0, 0, 0, 0, 0, 0, 0, 0};
          for (int i = 0; i < 128; ++i) { const float q = bf2f(qd[t * 128 + i]);
#pragma unroll
              for (int j = 0; j < 8; ++j) a[j] += q * bf2f(ki[(s0 + j) * 128 + i]); }
#pragma unroll
          for (int j = 0; j < 8; ++j) sc[t * 64 + s0 + j] = (s0 + j <= t) ? a[j] : 0.f; }
        __syncthreads();
        { const int t = tid >> 3, j0 = (tid & 7) * 4;
          float o[4] = {0, 0, 0, 0};
          for (int s = 0; s < 64; ++s) { const float w = sc[t * 64 + s];
#pragma unroll
              for (int j = 0; j < 4; ++j) o[j] += w * vv[s * 32 + j0 + j]; }
          for (int i = 0; i < 128; ++i) { const float q = bf2f(qd[t * 128 + i]);
#pragma unroll
              for (int j = 0; j < 4; ++j) o[j] += q * S[i * 32 + j0 + j]; }
          float ss = o[0] * o[0] + o[1] * o[1] + o[2] * o[2] + o[3] * o[3];
          ss += shx(ss, 1, F.lane); ss += shx(ss, 2, F.lane); ss += shx(ss, 4, F.lane);
          if ((tid & 7) == 0) F.SSQ[(size_t)(m0 + t) * 32 + h * 8 + sl] = ss;
          v2u w; w.x = pk2(o[0], o[1]); w.y = pk2(o[2], o[3]);
          *(v2u*)(F.PROJ + (size_t)(m0 + t) * PN + vcol + j0) = w; }
        __syncthreads();
        { const int i = tid >> 2, j0 = (tid & 3) * 8;
          const float dec = F.DECAY[(size_t)(b * 32 + n) * 512 + h * 128 + i];
          float a[8];
#pragma unroll
          for (int j = 0; j < 8; ++j) a[j] = dec * S[i * 32 + j0 + j];
          for (int s = 0; s < 64; ++s) { const float kx = bf2f(ke[s * 128 + i]);
#pragma unroll
              for (int j = 0; j < 8; ++j) a[j] += kx * vv[s * 32 + j0 + j]; }
#pragma unroll
          for (int j = 0; j < 8; ++j) S[i * 32 + j0 + j] = a[j]; }
    }
}
__device__ __forceinline__ void phase_gla_fix(Frame& F, const Args& A, int l) {
    F.tid = opaque_tid(); F.lane = F.tid & 63;
    const int gt = F.bid * 512 + F.tid, NGT = F.G * 512;
    const float* ng = A.in[5] + (size_t)l * 256;
    for (int idx = gt; idx < M * 128; idx += NGT) {
        const int m = idx >> 7, c0 = (idx & 127) * 8, h = c0 >> 8;
        const float* sp = F.SSQ + (size_t)m * 32 + h * 8;
        const float ss = ((sp[0] + sp[1]) + (sp[2] + sp[3])) + ((sp[4] + sp[5]) + (sp[6] + sp[7]));
        const float rs = 1.0f / sqrtf(ss * (1.f / 256.f) + EPS);
        const v4u ov = *(const v4u*)(F.PROJ + (size_t)m * PN + OFF_GV + c0);
        bf16* gp = F.PROJ + (size_t)m * PN + OFF_GG + c0;
        const v4u gv = *(const v4u*)gp;
        const float o[8] = {blo(ov.x), bhi(ov.x), blo(ov.y), bhi(ov.y), blo(ov.z), bhi(ov.z), blo(ov.w), bhi(ov.w)};
        const float g[8] = {blo(gv.x), bhi(gv.x), blo(gv.y), bhi(gv.y), blo(gv.z), bhi(gv.z), blo(gv.w), bhi(gv.w)};
        float r[8];
#pragma unroll
        for (int j = 0; j < 8; ++j) r[j] = o[j] * rs * ng[(c0 & 255) + j] * (g[j] * sigmoidf_(g[j]));
        v4u w; w.x = pk2(r[0], r[1]); w.y = pk2(r[2], r[3]); w.z = pk2(r[4], r[5]); w.w = pk2(r[6], r[7]);
        *(v4u*)gp = w;
    }
}

__device__ __forceinline__ float gelu_tanh(float x) { const float y = 0.7978845608028654f * (x + 0.044715f * x * x * x); const float e = __expf(2.0f * y); const float th = 1.0f - 2.0f / (e + 1.0f); return 0.5f * x * (1.0f + th); }
__device__ __forceinline__ void lru_scan_item(Frame& F, int item) {
    F.tid = opaque_tid(); F.lane = F.tid & 63;
    const int b = item >> 5, cg = item & 31, tid = F.tid, seg = tid >> 3, quad = tid & 7, ch = cg * 32 + quad * 4;
    LAS float* segP = (LAS float*)F.lds;
    LAS float* segH = segP + 64 * 32; LAS float* carry = segH + 64 * 32;
    const int m0 = b * T + seg * 32;
    float h[4] = {0, 0, 0, 0}, P[4] = {1, 1, 1, 1};
    for (int i = 0; i < 32; ++i) {
        const v2u ov = *(const v2u*)(F.PROJ + (size_t)(m0 + i) * PN + OFF_LX + ch); const v2u uv = *(const v2u*)(F.U + (size_t)(m0 + i) * D + ch);
        const float a[4] = {1.f - blo(ov.x), 1.f - bhi(ov.x), 1.f - blo(ov.y), 1.f - bhi(ov.y)}; const float u[4] = {blo(uv.x), bhi(uv.x), blo(uv.y), bhi(uv.y)};
#pragma unroll
        for (int j = 0; j < 4; ++j) { h[j] = a[j] * h[j] + u[j]; P[j] *= a[j]; }
    }
    __syncthreads();
#pragma unroll
    for (int j = 0; j < 4; ++j) { segP[seg * 32 + quad * 4 + j] = P[j]; segH[seg * 32 + quad * 4 + j] = h[j]; }
    __syncthreads();
    if (tid < 32) { float c = 0.f; for (int s = 0; s < 64; ++s) { carry[s * 32 + tid] = c; c = segP[s * 32 + tid] * c + segH[s * 32 + tid]; } }
    __syncthreads();
#pragma unroll
    for (int j = 0; j < 4; ++j) h[j] = carry[seg * 32 + quad * 4 + j];
    for (int i = 0; i < 32; ++i) {
        const v2u ov = *(const v2u*)(F.PROJ + (size_t)(m0 + i) * PN + OFF_LX + ch); const v2u uv = *(const v2u*)(F.U + (size_t)(m0 + i) * D + ch);
        bf16* gp = F.PROJ + (size_t)(m0 + i) * PN + OFF_LG + ch; const v2u gv = *(const v2u*)gp;
        const float a[4] = {1.f - blo(ov.x), 1.f - bhi(ov.x), 1.f - blo(ov.y), 1.f - bhi(ov.y)}; const float u[4] = {blo(uv.x), bhi(uv.x), blo(uv.y), bhi(uv.y)};
        const float g[4] = {blo(gv.x), bhi(gv.x), blo(gv.y), bhi(gv.y)};
        float y[4];
#pragma unroll
        for (int j = 0; j < 4; ++j) { h[j] = a[j] * h[j] + u[j]; y[j] = h[j] * gelu_tanh(g[j]); }
        v2u w; w.x = pk2(y[0], y[1]); w.y = pk2(y[2], y[3]); *(v2u*)gp = w;
    }
    __syncthreads();
}

__device__ __forceinline__ void sb_attn_item(Frame& F, int item) {
    F.tid = opaque_tid(); F.lane = F.tid & 63;
    const int b = item >> 7, h = (item >> 4) & 7, qb = item & 15, tid = F.tid, qi = tid & 127, dq = tid >> 7;
    const int t = qb * 128 + qi; const size_t mrow = (size_t)(b * T + t);
    LAS float* Ks = (LAS float*)F.lds;
    LAS float* Vs = Ks + 64 * 128;
    v4u q[16]; float o[32];
    { const bf16* qp = F.PROJ + mrow * PN + OFF_SQ + h * 128;
#pragma unroll
      for (int i = 0; i < 16; ++i) q[i] = *(const v4u*)(qp + 8 * i); }
#pragma unroll
    for (int j = 0; j < 32; ++j) o[j] = 0.f;
    float Pr = 1.0f;
    for (int kt = qb * 2 + 1; kt >= 0; --kt) {
        __syncthreads();
        for (int cidx = tid; cidx < 1024; cidx += 512) { const int r = cidx >> 4, c8 = (cidx & 15) * 8; const size_t krow = (size_t)(b * T + kt * 64 + r);
            const v4u kx = *(const v4u*)(F.PROJ + krow * PN + OFF_SK + h * 128 + c8); const v4u vx = *(const v4u*)(F.PROJ + krow * PN + OFF_SV + h * 128 + c8);
            LAS float* kd = Ks + r * 128 + c8; LAS float* vd = Vs + r * 128 + c8;
            kd[0] = blo(kx.x); kd[1] = bhi(kx.x); kd[2] = blo(kx.y); kd[3] = bhi(kx.y); kd[4] = blo(kx.z); kd[5] = bhi(kx.z); kd[6] = blo(kx.w); kd[7] = bhi(kx.w);
            vd[0] = blo(vx.x); vd[1] = bhi(vx.x); vd[2] = blo(vx.y); vd[3] = bhi(vx.y); vd[4] = blo(vx.z); vd[5] = bhi(vx.z); vd[6] = blo(vx.w); vd[7] = bhi(vx.w); }
        __syncthreads();
        for (int s = 63; s >= 0; --s) {
            const int key = kt * 64 + s;
            if (key < t) {
                float z = 0.f;
#pragma unroll
                for (int i = 0; i < 16; ++i) { const f32x4 k0 = *(const LAS f32x4*)(Ks + s * 128 + 8 * i), k1 = *(const LAS f32x4*)(Ks + s * 128 + 8 * i + 4);
                    z += blo(q[i].x) * k0.x + bhi(q[i].x) * k0.y + blo(q[i].y) * k0.z + bhi(q[i].y) * k0.w + blo(q[i].z) * k1.x + bhi(q[i].z) * k1.y + blo(q[i].w) * k1.z + bhi(q[i].w) * k1.w; }
                const float e = __expf(fminf(z, 80.f)); const float r = 1.0f / (1.0f + e); const float w = e * r * Pr; Pr *= r;
#pragma unroll
                for (int j = 0; j < 32; j += 4) { const f32x4 vv = *(const LAS f32x4*)(Vs + s * 128 + dq * 32 + j); o[j] += w * vv.x; o[j + 1] += w * vv.y; o[j + 2] += w * vv.z; o[j + 3] += w * vv.w; }
            }
        }
    }
    __syncthreads();
    { bf16* op = F.PROJ + mrow * PN + OFF_SQ + h * 128 + dq * 32;
#pragma unroll
      for (int i = 0; i < 4; ++i) { v4u w; w.x = pk2(o[8 * i], o[8 * i + 1]); w.y = pk2(o[8 * i + 2], o[8 * i + 3]); w.z = pk2(o[8 * i + 4], o[8 * i + 5]); w.w = pk2(o[8 * i + 6], o[8 * i + 7]); *(v4u*)(op + 8 * i) = w; } }
}

__device__ __forceinline__ Frame make_frame(const Args& args, LAS unsigned char* lds, unsigned char* ldsg) {
    Frame F; unsigned char* ws = args.ws; float* out = args.out;
    asm volatile("" : "+s"(ws), "+s"(out));
    F.lds = lds; F.ldsg = ldsg; F.tid = opaque_tid(); F.lane = F.tid & 63; F.wave = __builtin_amdgcn_readfirstlane(F.tid >> 6);
    F.G = gridDim.x; F.bid = blockIdx.x; F.out = out; F.ws = ws;
    F.XN = (bf16*)(ws + WS_XN); F.XC = (bf16*)(ws + WS_XC); F.U = (bf16*)(ws + WS_U); F.KE = (bf16*)(ws + WS_KE); F.PROJ = (bf16*)(ws + WS_PROJ);
    F.DECAY = (float*)(ws + WS_DECAY); F.SSQ = (float*)(ws + WS_SSQ);
    return F;
}
__global__ void __launch_bounds__(512, 2) trunk_fwd(Args args) {
    extern __shared__ __attribute__((aligned(16))) unsigned char lds_raw[];
    LAS unsigned char* const lds = (LAS unsigned char*)lds_raw;
    volatile LAS unsigned* MISC = (volatile LAS unsigned*)(lds + MISC_OFF);
    if (threadIdx.x < 32) MISC[threadIdx.x] = 0u;
    __syncthreads();
    const int lo = args.ph_lo, hi = args.ph_hi;
    XcdBarrier bar; bar.bar = (unsigned*)(args.ws + WS_CTL) + CW_BAR; bar.x = 0; bar.st = MISC + 8;
    if (hi - lo > 1) bar = xcd_barrier_post((unsigned*)(args.ws + WS_CTL) + CW_BAR, MISC + 8);
#ifndef PH_MASK
#define PH_MASK 0xfff
#endif
#define IN(k) (lo <= (k) && (k) < hi)
#define EN(k) ((PH_MASK >> (k)) & 1)
#define SEAM(k) do { if (IN(k) && IN((k) + 1)) xcd_barrier(bar); } while (0)
#define FRAME() Frame F = make_frame(args, lds, lds_raw)
#define WL(F) ((F).ws + WS_W + (size_t)l * WL_STRIDE)

    if (IN(0)) { FRAME(); phase_convert(F, args); }
    SEAM(0);
    for (int l = 0; l < DEPTH; ++l) {
        const int p0 = 1 + l * NP;
        if (EN(0) && IN(p0 + 0)) { FRAME(); phase_rmsnorm(F, (l == 0) ? args.in[0] : (const float*)F.out, args.in[1] + (size_t)l * D, F.XN); }
        SEAM(p0 + 0);
        if (EN(1) && IN(p0 + 1)) { FRAME();
            pg8::Gemm g{D, D, D}; pg8::SchedStd S; S.init(F.XN, WL(F) + WL_IN, D, D, M, PN, F.G, F.bid);
            pg8::EpiBf16<0> E{F.PROJ, PN};
            pg8::gemm_phase<pg8::EpiBf16<0>, pg8::SchedStd, true, true>(F.lds, g, S, E);
        }
        SEAM(p0 + 1);
        if (EN(2) && IN(p0 + 2)) { FRAME(); phase_prep(F, args, l); }
        SEAM(p0 + 2);
        if (EN(3) && IN(p0 + 3)) { FRAME();
            pg8::Gemm g{D, 256, 256}; SchedLru S{(const char*)F.XC, (const char*)(WL(F) + WL_G), F.G, F.bid};
            EpiLru E{F.XC, F.PROJ + OFF_LX, PN, F.U, args.in[9] + (size_t)l * D, args.in[11] + (size_t)l * D, (const float*)(F.ws + WS_SPL)};
            pg8::gemm_phase<EpiLru, SchedLru, true, true>(F.lds, g, S, E);
        }
        SEAM(p0 + 3);
        if (EN(4) && IN(p0 + 4)) {
            { FRAME(); for (int it = F.bid; it < 256; it += F.G) gla_main_item(F, it); }
            __syncthreads();
            { FRAME(); for (int it = F.bid; it < 256; it += F.G) lru_scan_item(F, it); }
            __syncthreads();
            { FRAME(); for (int it = F.bid; it < 1024; it += F.G) sb_attn_item(F, it); }
        }
        SEAM(p0 + 4);
        if (EN(5) && IN(p0 + 5)) { FRAME(); phase_gla_fix(F, args, l); }
        SEAM(p0 + 5);
        if (EN(6) && IN(p0 + 6)) { FRAME();
            pg8::Gemm g{PN, D, D}; SchedBranch S{(const char*)F.PROJ, (const char*)(WL(F) + WL_BR), F.G, F.bid};
            EpiBranch E{F.PROJ, args.in[18] + (size_t)l * 3072, F.U};
            pg8::gemm_phase<EpiBranch, SchedBranch, true, true>(F.lds, g, S, E);
        }
        SEAM(p0 + 6);
        if (EN(7) && IN(p0 + 7)) { FRAME();
            pg8::Gemm g{D, D, D}; pg8::SchedStd S; S.init(F.U, WL(F) + WL_OUT, D, D, M, D, F.G, F.bid);
            pg8::EpiResF32 E{(l == 0) ? args.in[0] : (const float*)F.out, F.out, D};
            pg8::gemm_phase<pg8::EpiResF32, pg8::SchedStd, false, true>(F.lds, g, S, E);
        }
        SEAM(p0 + 7);
        if (EN(8) && IN(p0 + 8)) { FRAME(); phase_rmsnorm(F, F.out, args.in[20] + (size_t)l * D, F.XN); }
        SEAM(p0 + 8);
        if (EN(9) && IN(p0 + 9)) { FRAME();
            pg8::Gemm g{D, D, D}; pg8::SchedStd S; S.init(F.XN, WL(F) + WL_UP, D, D, M, FF, F.G, F.bid);
            pg8::EpiBf16<1> E{F.PROJ, FF};
            pg8::gemm_phase<pg8::EpiBf16<1>, pg8::SchedStd, true, true>(F.lds, g, S, E);
        }
        SEAM(p0 + 9);
        if (EN(10) && IN(p0 + 10)) { FRAME();
            pg8::Gemm g{FF, FF, FF}; pg8::SchedStd S; S.init(F.PROJ, WL(F) + WL_DN, FF, FF, M, D, F.G, F.bid);
            pg8::EpiResF32 E{F.out, F.out, D};
            pg8::gemm_phase<pg8::EpiResF32, pg8::SchedStd, false, true>(F.lds, g, S, E);
        }
        SEAM(p0 + 10);
    }
#undef IN
#undef SEAM
}

extern "C" void kernel_launch(void* const* d_in, const int* in_sizes, int n_in, void* d_out, int out_size, void* d_ws, size_t ws_size, hipStream_t stream) {
    static int grid = 0;
    if (grid == 0) {
        if (n_in != 23 || out_size != M * D || ws_size < WS_END) { fprintf(stderr, "kernel_launch: unexpected shapes / workspace (n_in %d, out %d, ws %zu, need %zu)\n", n_in, out_size, ws_size, (size_t)WS_END); grid = -1; return; }
        int dev = 0, cus = 0, per_cu = 0;
        if (hipGetDevice(&dev) != hipSuccess || hipDeviceGetAttribute(&cus, hipDeviceAttributeMultiprocessorCount, dev) != hipSuccess) { grid = -1; return; }
        if (hipFuncSetAttribute((const void*)trunk_fwd, hipFuncAttributeMaxDynamicSharedMemorySize, LDS_BYTES) != hipSuccess) { grid = -1; return; }
        if (hipOccupancyMaxActiveBlocksPerMultiprocessor(&per_cu, (const void*)trunk_fwd, 512, LDS_BYTES) != hipSuccess || per_cu < 1) fprintf(stderr, "kernel_launch: occupancy query says %d\n", per_cu);
        (void)hipGetLastError();
        grid = cus;
    }
    if (grid < 0) return;
    (void)hipMemsetAsync((char*)d_ws + WS_CTL, 0, CTL_ZERO_BYTES, stream);
    Args a{};
    for (int i = 0; i < 23; ++i) a.in[i] = (const float*)d_in[i];
    a.out = (float*)d_out; a.ws = (unsigned char*)d_ws;
#if MK_ONE_LAUNCH
    a.ph_lo = 0; a.ph_hi = NPH;
    hipLaunchKernelGGL(trunk_fwd, dim3(grid), dim3(512), LDS_BYTES, stream, a);
#else
    for (int p = 0; p < NPH; ++p) { a.ph_lo = p; a.ph_hi = p + 1; hipLaunchKernelGGL(trunk_fwd, dim3(grid), dim3(512), LDS_BYTES, stream, a); }
#endif
}
```

```cpp
#include <hip/hip_runtime.h>
#include <cstdio>

#ifndef MK_ONE_LAUNCH
#define MK_ONE_LAUNCH 1
#endif

#define LAS __attribute__((address_space(3)))
#define GAS __attribute__((address_space(1)))
typedef unsigned short bf16;
typedef unsigned v4u __attribute__((ext_vector_type(4)));
typedef unsigned v2u __attribute__((ext_vector_type(2)));
typedef float f32x4 __attribute__((ext_vector_type(4)));
typedef float f32x2 __attribute__((ext_vector_type(2)));
typedef short bf16x8 __attribute__((ext_vector_type(8)));

constexpr int D = 1024, BATCH = 8, T = 2048, M = BATCH * T, DEPTH = 4, FF = 4096;
constexpr int SRC_COLS = 11280;
constexpr int PN = 11264;
constexpr int OFF_GQ = 0, OFF_GK = 512, OFF_GV = 1024, OFF_GG = 2048, OFF_LX = 3072, OFF_LG = 4096, OFF_SQ = 5120, OFF_SK = 6144, OFF_SV = 7168, OFF_GATE = 8192;
constexpr int SRC_GDOWN = 3072;
constexpr float EPS = 1e-6f;
constexpr int NP = 11;
constexpr int NPH = 1 + DEPTH * NP;

constexpr size_t MiB = 1u << 20;
constexpr size_t WS_CTL = 0, CTL_ZERO_BYTES = 64 * 1024;
constexpr size_t WS_DECAY = 1 * MiB;
constexpr size_t WS_WDT = 1536 * 1024;
constexpr size_t WS_SSQ = 2 * MiB;
constexpr size_t WS_SPL = 512 * 1024;
constexpr size_t WS_W = 4 * MiB;
constexpr size_t WL_IN = 0, WL_BR = 22 * MiB, WL_OUT = 28 * MiB, WL_UP = 30 * MiB, WL_DN = 38 * MiB, WL_G = 46 * MiB, WL_STRIDE = 47 * MiB;
constexpr size_t WS_XN = 192 * MiB;
constexpr size_t WS_XC = 224 * MiB;
constexpr size_t WS_U = 256 * MiB;
constexpr size_t WS_KE = 288 * MiB;
constexpr size_t WS_VT = 304 * MiB;
constexpr size_t WS_PROJ = 336 * MiB;
constexpr size_t WS_END = WS_PROJ + (size_t)M * PN * 2;
static_assert(WS_W + DEPTH * WL_STRIDE <= WS_XN, "ws map");
constexpr int CW_BAR = 1024;

constexpr int RING_BYTES = 131072;
constexpr int MISC_OFF = 147456 - 256;
constexpr int LDS_BYTES = 147456;

__device__ __forceinline__ float bf2f(unsigned b) { return __uint_as_float(b << 16); }
__device__ __forceinline__ unsigned f2bf(float f) { unsigned u = __float_as_uint(f); return (u + 0x7fffu + ((u >> 16) & 1u)) >> 16; }
__device__ __forceinline__ unsigned pk2(float lo, float hi) { return f2bf(lo) | (f2bf(hi) << 16); }
__device__ __forceinline__ float blo(unsigned w) { return __uint_as_float(w << 16); }
__device__ __forceinline__ float bhi(unsigned w) { return __uint_as_float(w & 0xffff0000u); }
__device__ __forceinline__ float shx(float v, int o, int lane) { return __int_as_float(__builtin_amdgcn_ds_bpermute((lane ^ o) << 2, __float_as_int(v))); }
__device__ __forceinline__ float wave_sum(float v, int lane) {
#pragma unroll
    for (int o = 1; o < 64; o <<= 1) v += shx(v, o, lane);
    return v;
}
__device__ __forceinline__ float sigmoidf_(float x) { return 1.f / (1.f + __expf(-x)); }
__device__ __forceinline__ float logsigmoidf_(float x) { return fminf(x, 0.f) - log1pf(__expf(-fabsf(x))); }
#define LDS_WAIT() asm volatile("s_waitcnt lgkmcnt(0)" ::: "memory")
__device__ __forceinline__ int opaque_tid() { int t = threadIdx.x; asm volatile("" : "+v"(t)); return t; }

#define XB_TMO      128
#define XB_XCNT(j)  (256  + 64 * (j))
#define XB_XSUB(j)  (1280 + 64 * (j))
#define XB_XGEN(j)  (2304 + 64 * (j))
#define XB_TOP      3328
#define XB_TOPGEN   3392
#define XCD_BAR_WORDS 3456
#define XB_SPIN_CAP (1u << 18)
__device__ __forceinline__ unsigned xb_ld(unsigned* p)              { return __hip_atomic_load(p, __ATOMIC_RELAXED, __HIP_MEMORY_SCOPE_AGENT); }
__device__ __forceinline__ unsigned xb_add(unsigned* p, unsigned v) { return __hip_atomic_fetch_add(p, v, __ATOMIC_RELAXED, __HIP_MEMORY_SCOPE_AGENT); }
__device__ __forceinline__ unsigned xb_xcc_id() { return (unsigned)__builtin_amdgcn_s_getreg((3 << 11) | 20) & 0xFu; }
#define XB_SPIN(cond, bar) do { unsigned _sp = 0; while (cond) { __builtin_amdgcn_s_sleep(1); \
    if ((++_sp & 255u) == 0u) { if (xb_ld(&(bar)[XB_TMO])) break; if (_sp > XB_SPIN_CAP) { atomicAdd(&(bar)[XB_TMO], 1u); break; } } } } while (0)
struct XcdBarrier { unsigned* bar; unsigned x; volatile LAS unsigned* st; };
__device__ __forceinline__ XcdBarrier xcd_barrier_post(unsigned* bar, volatile LAS unsigned* st) {
    XcdBarrier b; b.bar = bar; b.x = xb_xcc_id(); b.st = st;
    if (threadIdx.x == 0) (void)xb_add(&bar[XB_XCNT(b.x)], 1u);
    return b;
}
__device__ __forceinline__ void xcd_barrier_complete(unsigned* bar, unsigned x, unsigned& nloc, unsigned& nx) {
    const unsigned G = gridDim.x * gridDim.y * gridDim.z;
    unsigned sum, cnt, mine, sp = 0u;
    for (;;) {
        sum = 0u; cnt = 0u; mine = 0u;
#pragma unroll
        for (unsigned j = 0; j < 16; ++j) { const unsigned c = xb_ld(&bar[XB_XCNT(j)]); sum += c; cnt += (c > 0u) ? 1u : 0u; mine = (j == x) ? c : mine; }
        if (sum == G) break;
        __builtin_amdgcn_s_sleep(1);
        if ((++sp & 255u) == 0u) { if (xb_ld(&bar[XB_TMO])) break; if (sp > XB_SPIN_CAP) { atomicAdd(&bar[XB_TMO], 1u); break; } }
    }
    nloc = mine > 0u ? mine : 1u; nx = cnt > 0u ? cnt : 1u;
}
__device__ __forceinline__ void xcd_barrier(const XcdBarrier& b) {
    asm volatile("s_waitcnt vmcnt(0)" ::: "memory");
    __syncthreads();
    if (threadIdx.x == 0) {
        unsigned* bar = b.bar; asm volatile("" : "+s"(bar));
        __builtin_amdgcn_s_waitcnt(0);
        unsigned nloc = b.st[0], nx = b.st[1];
        if (nloc == 0u) { xcd_barrier_complete(bar, b.x, nloc, nx); b.st[0] = nloc; b.st[1] = nx; }
        const unsigned old = xb_add(&bar[XB_XSUB(b.x)], 1u);
        const unsigned gen = old / nloc;
        if (old + 1u == (gen + 1u) * nloc) {
            __builtin_amdgcn_fence(__ATOMIC_RELEASE, "agent");
            asm volatile("s_waitcnt vmcnt(0)" ::: "memory");
            const unsigned og = xb_add(&bar[XB_TOP], 1u);
            const unsigned tg = og / nx;
            if (og + 1u == (tg + 1u) * nx) xb_add(&bar[XB_TOPGEN], 1u);
            else XB_SPIN(xb_ld(&bar[XB_TOPGEN]) == tg, bar);
            __builtin_amdgcn_fence(__ATOMIC_ACQUIRE, "agent");
            xb_add(&bar[XB_XGEN(b.x)], 1u);
            asm volatile("s_waitcnt vmcnt(0)" ::: "memory");
        } else {
            XB_SPIN(xb_ld(&bar[XB_XGEN(b.x)]) == gen, bar);
            __builtin_amdgcn_fence(__ATOMIC_ACQUIRE, "agent");
            asm volatile("s_waitcnt vmcnt(0)" ::: "memory");
        }
    }
    __syncthreads();
}

namespace pg8 {
constexpr int BM = 256, BK = 64, HALF = 128, HTB = HALF * BK * 2, STAGE_BYTES = 8 * HTB, NXCD = 8, WGM = 8;
__host__ __device__ __forceinline__ int lds_byte(int r, int c) { const int st = (r >> 4) * 2 + (c >> 5), rr = r & 15, cc = c & 31, ob = rr * 64 + cc * 2; return st * 1024 + (ob ^ (((ob >> 9) & 1) << 5)); }
__host__ __device__ __forceinline__ void stage_rc(int b, int& R, int& C) { const int st = b / 1024, sb = b % 1024, swz = sb ^ (((sb >> 9) & 1) << 5); R = (st >> 1) * 16 + swz / 64; C = (st & 1) * 32 + (swz % 64) / 2; }
__host__ __device__ __forceinline__ int perm32(int rho) { const int n = rho >> 4, i = rho & 15; return 8 * (i >> 2) + 4 * n + (i & 3); }
struct Unit { int pm, pn, aux; };
struct Gemm { int lda, ldb, K; };
__device__ __forceinline__ unsigned cvt_pk_bf16(float lo, float hi) { unsigned r; asm volatile("v_cvt_pk_bf16_f32 %0, %1, %2" : "=v"(r) : "v"(lo), "v"(hi)); return r; }

struct SchedStd {
    const char* A; const char* B; size_t tstepA, tstepB; int nM, nN, nwg, G, c;
    __device__ __forceinline__ void init(const void* A_, const void* B_, int lda, int ldb, int Mr, int Nc, int G_, int c_) { A = (const char*)A_; B = (const char*)B_; tstepA = (size_t)BM * lda * 2; tstepB = (size_t)BM * ldb * 2; nM = Mr / BM; nN = Nc / BM; nwg = nM * nN; G = G_; c = c_; }
    __device__ __forceinline__ bool next(int i, Unit& u) const {
        const long L = (long)i * G + c; if (L >= nwg) return false;
        int wgid = (int)L; { const int q = nwg / NXCD, r = nwg % NXCD, xcd = wgid % NXCD, off = wgid / NXCD; wgid = (xcd < r ? xcd * (q + 1) : r * (q + 1) + (xcd - r) * q) + off; }
        const int nig = WGM * nN, gid = wgid / nig, fm = gid * WGM, gsz = (nM - fm) < WGM ? (nM - fm) : WGM;
        u.pm = fm + ((wgid % nig) % gsz); u.pn = (wgid % nig) / gsz; u.aux = 0; return true;
    }
    __device__ __forceinline__ const char* abase(const Unit& u) const { return A + (size_t)u.pm * tstepA; }
    __device__ __forceinline__ const char* bbase(const Unit& u) const { return B + (size_t)u.pn * tstepB; }
};

template <class Epi, class Sched, bool ALIGN_EPI, bool SP2>
__device__ __forceinline__ void gemm_phase(LAS unsigned char* lds, const Gemm g, const Sched& S, const Epi& E) {
    const int tid = opaque_tid(), wid = __builtin_amdgcn_readfirstlane(tid >> 6), lane = tid & 63, wr = wid >> 2, wc = wid & 3, fr = lane & 15, fq = lane >> 4;
    const int K = g.K, nt = K / BK;
    unsigned voffA[2], voffB[2];
#pragma unroll
    for (int i = 0; i < 2; ++i) { int R, C; stage_rc(tid * 16 + i * 8192, R, C); const int Rb = Epi::PERM ? ((R & ~31) + perm32(R & 31)) : R;
        voffA[i] = (unsigned)(R * g.lda + C) * 2u; voffB[i] = (unsigned)(Rb * g.ldb + C) * 2u; }
    const size_t kstep = (size_t)(BK * 2);
    const size_t hstepA = (size_t)HALF * g.lda * 2, hstepB = (size_t)HALF * g.ldb * 2;
    const unsigned ldsw = (unsigned)wid * 1024u;
    const int aoff = lds_byte(wr * 64 + fr, fq * 8), boff = lds_byte(wc * 32 + fr, fq * 8);
#define PG8_SA(b, h) (((b) * 2 + (h)) * HTB)
#define PG8_SB(b, h) ((4 + (b) * 2 + (h)) * HTB)
#define PG8_STAGE(bufoff, gbase, voff) do { _Pragma("unroll") for (int _i = 0; _i < 2; ++_i) \
        __builtin_amdgcn_global_load_lds((const unsigned*)((const char*)(gbase) + (voff)[_i]), (LAS unsigned*)(lds + (bufoff) + ldsw + _i * 8192), 16, 0, 0); } while (0)
#define PG8_LDA(dst, b, h) do { _Pragma("unroll") for (int m = 0; m < 4; ++m) _Pragma("unroll") for (int k = 0; k < 2; ++k) dst[m][k] = *(const LAS bf16x8*)(lds + PG8_SA(b, h) + aoff + m * 2048 + k * 1024); } while (0)
#define PG8_LDB(dst, b, h) do { _Pragma("unroll") for (int n = 0; n < 2; ++n) _Pragma("unroll") for (int k = 0; k < 2; ++k) dst[n][k] = *(const LAS bf16x8*)(lds + PG8_SB(b, h) + boff + n * 2048 + k * 1024); } while (0)
#define PG8_MMA(ai, bj, At, Bt) do { __builtin_amdgcn_s_setprio(1); _Pragma("unroll") for (int m = 0; m < 4; ++m) _Pragma("unroll") for (int n = 0; n < 2; ++n) _Pragma("unroll") for (int k = 0; k < 2; ++k) \
        acc[ai][bj][m][n] = __builtin_amdgcn_mfma_f32_16x16x32_bf16(Bt[n][k], At[m][k], acc[ai][bj][m][n], 0, 0, 0); __builtin_amdgcn_s_setprio(0); } while (0)
#define PG8_WAIT_V(n) asm volatile("s_waitcnt vmcnt(" #n ")" ::: "memory")
#define PG8_WAIT_L(n) asm volatile("s_waitcnt lgkmcnt(" #n ")" ::: "memory")
#define PG8_BAR __builtin_amdgcn_s_barrier()
#define PG8_SCHED __builtin_amdgcn_sched_barrier(0)
    Unit cur, nxt; int ui = 0;
    if (!S.next(0, cur)) return;
    f32x4 acc[2][2][4][2];
#pragma unroll
    for (int a = 0; a < 2; ++a)
#pragma unroll
        for (int b = 0; b < 2; ++b)
#pragma unroll
            for (int m = 0; m < 4; ++m)
#pragma unroll
                for (int n = 0; n < 2; ++n) acc[a][b][m][n] = (f32x4){0.f, 0.f, 0.f, 0.f};
    bf16x8 At[4][2], B0[2][2], B1[2][2];
    const char* cA = S.abase(cur); const char* cB = S.bbase(cur);
    if constexpr (SP2) {
        PG8_STAGE(PG8_SB(0, 0), cB, voffB); PG8_STAGE(PG8_SB(0, 1), cB + hstepB, voffB); PG8_STAGE(PG8_SA(0, 0), cA, voffA); PG8_STAGE(PG8_SA(0, 1), cA + hstepA, voffA);
        if (wr == 1) PG8_BAR;
        PG8_WAIT_V(2); PG8_BAR;
        PG8_STAGE(PG8_SB(1, 0), cB + kstep, voffB); PG8_STAGE(PG8_SA(1, 0), cA + kstep, voffA); PG8_STAGE(PG8_SB(1, 1), cB + hstepB + kstep, voffB);
        PG8_WAIT_V(6); PG8_BAR;
    } else {
        PG8_STAGE(PG8_SB(0, 0), cB, voffB); PG8_STAGE(PG8_SA(0, 0), cA, voffA); PG8_STAGE(PG8_SB(0, 1), cB + hstepB, voffB); PG8_STAGE(PG8_SA(0, 1), cA + hstepA, voffA);
        if (wr == 1) PG8_BAR;
        PG8_WAIT_V(4); PG8_BAR;
        PG8_STAGE(PG8_SB(1, 0), cB + kstep, voffB); PG8_STAGE(PG8_SA(1, 0), cA + kstep, voffA); PG8_STAGE(PG8_SB(1, 1), cB + hstepB + kstep, voffB);
        PG8_WAIT_V(6); PG8_BAR;
    }
    for (;;) {
        const bool has_next = S.next(ui + 1, nxt);
        const char* nA = has_next ? S.abase(nxt) : cA; const char* nB = has_next ? S.bbase(nxt) : cB;
#pragma nounroll
        for (int t = 0; t < nt; t += 2) {
            const bool last = (t == nt - 2);
            const char* a1 = cA + (size_t)(t + 1) * kstep;
            const char* a2 = last ? nA : cA + (size_t)(t + 2) * kstep; const char* b2 = last ? nB : cB + (size_t)(t + 2) * kstep;
            const char* a3 = a2 + kstep; const char* b3 = b2 + kstep;
            if constexpr (SP2) {
            PG8_LDB(B0, 0, 0); PG8_LDB(B1, 0, 1); PG8_SCHED; PG8_LDA(At, 0, 0); PG8_STAGE(PG8_SA(1, 1), a1 + hstepA, voffA);
            PG8_WAIT_V(8); PG8_WAIT_L(0); PG8_BAR; PG8_MMA(0, 0, At, B0); PG8_MMA(0, 1, At, B1); PG8_BAR; PG8_SCHED;
            PG8_LDA(At, 0, 1); PG8_STAGE(PG8_SB(0, 0), b2, voffB); PG8_STAGE(PG8_SB(0, 1), b2 + hstepB, voffB); PG8_STAGE(PG8_SA(0, 0), a2, voffA);
            PG8_WAIT_V(8); PG8_WAIT_L(0); PG8_BAR; PG8_MMA(1, 0, At, B0); PG8_MMA(1, 1, At, B1); PG8_BAR; PG8_SCHED;
            PG8_LDB(B0, 1, 0); PG8_LDB(B1, 1, 1); PG8_SCHED; PG8_LDA(At, 1, 0); PG8_STAGE(PG8_SA(0, 1), a2 + hstepA, voffA);
            PG8_WAIT_V(8); PG8_WAIT_L(0); PG8_BAR; PG8_MMA(0, 0, At, B0); PG8_MMA(0, 1, At, B1); PG8_BAR; PG8_SCHED;
            PG8_LDA(At, 1, 1); PG8_STAGE(PG8_SB(1, 0), b3, voffB); PG8_STAGE(PG8_SB(1, 1), b3 + hstepB, voffB); PG8_STAGE(PG8_SA(1, 0), a3, voffA);
            PG8_WAIT_V(8); PG8_WAIT_L(0); PG8_BAR; PG8_MMA(1, 0, At, B0); PG8_MMA(1, 1, At, B1); PG8_BAR; PG8_SCHED;
            } else {
            PG8_LDB(B0, 0, 0); PG8_SCHED; PG8_LDA(At, 0, 0); PG8_STAGE(PG8_SA(1, 1), a1 + hstepA, voffA);
            PG8_WAIT_L(8); PG8_BAR; PG8_WAIT_L(0); PG8_MMA(0, 0, At, B0); PG8_BAR; PG8_SCHED;
            PG8_LDB(B1, 0, 1); PG8_STAGE(PG8_SB(0, 0), b2, voffB);
            PG8_BAR; PG8_WAIT_L(0); PG8_MMA(0, 1, At, B1); PG8_BAR;
            PG8_LDA(At, 0, 1); PG8_STAGE(PG8_SA(0, 0), a2, voffA);
            PG8_BAR; PG8_WAIT_L(0); PG8_MMA(1, 0, At, B0); PG8_BAR; PG8_SCHED;
            PG8_STAGE(PG8_SB(0, 1), b2 + hstepB, voffB);
            PG8_WAIT_V(6); PG8_BAR; PG8_MMA(1, 1, At, B1); PG8_BAR;
            PG8_LDB(B0, 1, 0); PG8_SCHED; PG8_LDA(At, 1, 0); PG8_STAGE(PG8_SA(0, 1), a2 + hstepA, voffA);
            PG8_WAIT_L(8); PG8_BAR; PG8_WAIT_L(0); PG8_MMA(0, 0, At, B0); PG8_BAR; PG8_SCHED;
            PG8_LDB(B1, 1, 1); PG8_STAGE(PG8_SB(1, 0), b3, voffB);
            PG8_BAR; PG8_WAIT_L(0); PG8_MMA(0, 1, At, B1); PG8_BAR;
            PG8_LDA(At, 1, 1); PG8_STAGE(PG8_SA(1, 0), a3, voffA);
            PG8_BAR; PG8_WAIT_L(0); PG8_MMA(1, 0, At, B0); PG8_BAR; PG8_SCHED;
            PG8_STAGE(PG8_SB(1, 1), b3 + hstepB, voffB);
            PG8_WAIT_V(6); PG8_BAR; PG8_MMA(1, 1, At, B1); PG8_BAR;
            }
        }
        if constexpr (ALIGN_EPI) { if (wr == 0) PG8_BAR; }
        const bool zero = E(acc, cur, wr, wc, fr, fq);
        if (!has_next) break;
        if (zero) {
#pragma unroll
        for (int a = 0; a < 2; ++a)
#pragma unroll
            for (int b = 0; b < 2; ++b)
#pragma unroll
                for (int m = 0; m < 4; ++m)
#pragma unroll
                    for (int n = 0; n < 2; ++n) acc[a][b][m][n] = (f32x4){0.f, 0.f, 0.f, 0.f};
        }
        cur = nxt; cA = nA; cB = nB; ++ui;
        if constexpr (ALIGN_EPI) { if (wr == 1) PG8_BAR; }
    }
    PG8_WAIT_V(0);
    if constexpr (!ALIGN_EPI) { if (wr == 0) PG8_BAR; }
    PG8_BAR;
#undef PG8_SA
#undef PG8_SB
#undef PG8_STAGE
#undef PG8_LDA
#undef PG8_LDB
#undef PG8_MMA
#undef PG8_WAIT_V
#undef PG8_WAIT_L
#undef PG8_BAR
#undef PG8_SCHED
}

template <int ACT> struct EpiBf16 {
    static constexpr bool PERM = true;
    bf16* O; int ldc;
    __device__ __forceinline__ bool operator()(f32x4 (&acc)[2][2][4][2], const Unit& u, int wr, int wc, int fr, int fq) const {
        const int row0 = u.pm * BM + wr * 64 + fr, col0 = u.pn * BM + wc * 32 + 8 * fq;
#pragma unroll
        for (int ai = 0; ai < 2; ++ai)
#pragma unroll
            for (int m = 0; m < 4; ++m) { bf16* rowp = O + (size_t)(row0 + ai * HALF + m * 16) * ldc + col0;
#pragma unroll
                for (int bj = 0; bj < 2; ++bj) { f32x4 v0 = acc[ai][bj][m][0], v1 = acc[ai][bj][m][1];
                    if (ACT == 1) {
#pragma unroll
                        for (int j = 0; j < 4; ++j) { const float a = fmaxf(v0[j], 0.f), b = fmaxf(v1[j], 0.f); v0[j] = a * a; v1[j] = b * b; } }
                    v4u w; w.x = cvt_pk_bf16(v0[0], v0[1]); w.y = cvt_pk_bf16(v0[2], v0[3]); w.z = cvt_pk_bf16(v1[0], v1[1]); w.w = cvt_pk_bf16(v1[2], v1[3]);
                    *(v4u*)(rowp + bj * HALF) = w; } }
        return true;
    }
};
struct EpiResF32 {
    static constexpr bool PERM = false;
    const float* base; float* out; int ldc; bool dry;
    __device__ __forceinline__ bool operator()(f32x4 (&acc)[2][2][4][2], const Unit& u, int wr, int wc, int fr, int fq) const {
        const int row0 = u.pm * BM + wr * 64 + fr, col0 = u.pn * BM + wc * 32 + 4 * fq;
#pragma unroll
        for (int ai = 0; ai < 2; ++ai)
#pragma unroll
            for (int m = 0; m < 4; ++m) { const size_t off = (size_t)(row0 + ai * HALF + m * 16) * ldc + col0;
#pragma unroll
                for (int bj = 0; bj < 2; ++bj)
#pragma unroll
                    for (int n = 0; n < 2; ++n) { const f32x4 bs = *(const f32x4*)(base + off + bj * HALF + n * 16); if (!dry) *(f32x4*)(out + off + bj * HALF + n * 16) = bs + acc[ai][bj][m][n]; } }
        return true;
    }
};
}

struct Args { const float* in[23]; float* out; unsigned char* ws; int ph_lo, ph_hi; };

struct Frame {
    LAS unsigned char* lds; unsigned char* ldsg;
    int tid, lane, wave, G, bid; bool dry;
    float* out; unsigned char* ws;
    bf16 *XN, *XC, *U, *KE, *VT, *PROJ; float *DECAY, *SSQ;
};

__device__ __forceinline__ void transpose_item(const float* W, int ldw, int nblk, bf16* WT, int K, int row_off, LAS float* scr, int item, int lane) {
    const int kb = item / nblk, nb = item % nblk, k0 = 64 * kb, n0 = 32 * nb;
#pragma unroll 8
    for (int i = 0; i < 32; ++i) { const int kk = 2 * i + (lane >> 5); scr[kk * 33 + (lane & 31)] = W[(size_t)(k0 + kk) * ldw + n0 + (lane & 31)]; }
    LDS_WAIT(); asm volatile("" ::: "memory");
    const int c = lane & 7;
#pragma unroll
    for (int j = 0; j < 4; ++j) { const int n = (lane >> 3) + 8 * j; const LAS float* s = scr + (8 * c) * 33 + n;
        v4u o; o.x = pk2(s[0 * 33], s[1 * 33]); o.y = pk2(s[2 * 33], s[3 * 33]); o.z = pk2(s[4 * 33], s[5 * 33]); o.w = pk2(s[6 * 33], s[7 * 33]);
        *(v4u*)(WT + (size_t)(row_off + n0 + n) * K + k0 + 8 * c) = o; }
    LDS_WAIT(); asm volatile("" ::: "memory");
}
__device__ __forceinline__ void phase_convert(Frame& F, const Args& A) {
    F.tid = opaque_tid(); F.lane = F.tid & 63;
    { bf16* wdt = (bf16*)(F.ws + WS_WDT);
      for (int idx = F.bid * 512 + F.tid; idx < DEPTH * 16 * D; idx += F.G * 512) { const int l = idx >> 14, n = (idx >> 10) & 15, k = idx & 1023;
          wdt[idx] = (bf16)f2bf(A.in[2][((size_t)l * D + k) * SRC_COLS + SRC_GDOWN + n]); } }
    LAS float* scr = (LAS float*)(F.lds + F.wave * 16384);
    const int gw = F.bid * 8 + F.wave, NGW = F.G * 8;
    constexpr int PER_L = 1536 + 4096 + 1536 + 512 + 2048 + 2048 + 256;
    for (int it = gw; it < DEPTH * PER_L; it += NGW) {
        const int l = it / PER_L; int r = it % PER_L;
        unsigned char* wl = F.ws + WS_W + (size_t)l * WL_STRIDE;
        const float* win = A.in[2] + (size_t)l * D * SRC_COLS;
        if (r < 1536) { transpose_item(win, SRC_COLS, 96, (bf16*)(wl + WL_IN), D, 0, scr, r, F.lane); continue; } r -= 1536;
        if (r < 4096) { transpose_item(win + 3088, SRC_COLS, 256, (bf16*)(wl + WL_IN), D, 3072, scr, r, F.lane); continue; } r -= 4096;
        if (r < 1536) { const int br = r / 512; const float* wb = br == 0 ? A.in[15] : (br == 1 ? A.in[16] : A.in[17]); transpose_item(wb + (size_t)l * D * D, D, 32, (bf16*)(wl + WL_BR), D, br * 1024, scr, r % 512, F.lane); continue; } r -= 1536;
        if (r < 512) { transpose_item(A.in[19] + (size_t)l * D * D, D, 32, (bf16*)(wl + WL_OUT), D, 0, scr, r, F.lane); continue; } r -= 512;
        if (r < 2048) { transpose_item(A.in[21] + (size_t)l * D * FF, FF, 128, (bf16*)(wl + WL_UP), D, 0, scr, r, F.lane); continue; } r -= 2048;
        if (r < 2048) { transpose_item(A.in[22] + (size_t)l * D * FF, D, 32, (bf16*)(wl + WL_DN), FF, 0, scr, r, F.lane); continue; } r -= 2048;
        { const int mtx = r / 32, rr = r % 32, blk = mtx >> 1, gate = mtx & 1, n0 = (rr % 8) * 32;
          const int row_off = (blk * 2 + (n0 >> 7)) * 256 + gate * 128 + (n0 & 127) - n0;
          const float* w = (gate ? A.in[10] : A.in[8]) + (size_t)l * 262144 + (size_t)blk * 65536;
          transpose_item(w, 256, 8, (bf16*)(wl + WL_G), 256, row_off, scr, rr, F.lane); }
    }
}

__device__ __forceinline__ void phase_rmsnorm(Frame& F, const float* x, const float* g, bf16* out) {
    F.tid = opaque_tid(); F.lane = F.tid & 63;
    const int gw = F.bid * 8 + F.wave, NGW = F.G * 8;
    f32x4 gv[4];
#pragma unroll
    for (int j = 0; j < 4; ++j) gv[j] = *((const f32x4*)g + F.lane + 64 * j);
    for (int m = gw; m < M; m += NGW) {
        const f32x4* xr = (const f32x4*)(x + (size_t)m * D) + F.lane;
        f32x4 v[4]; float s = 0.f;
#pragma unroll
        for (int j = 0; j < 4; ++j) { v[j] = xr[64 * j]; s += (v[j].x * v[j].x + v[j].y * v[j].y) + (v[j].z * v[j].z + v[j].w * v[j].w); }
        const float rs = 1.0f / sqrtf(wave_sum(s, F.lane) * (1.f / D) + EPS);
        v2u* o8 = (v2u*)(out + (size_t)m * D) + F.lane;
#pragma unroll
        for (int j = 0; j < 4; ++j) { v2u w; w.x = pk2(v[j].x * rs * gv[j].x, v[j].y * rs * gv[j].y); w.y = pk2(v[j].z * rs * gv[j].z, v[j].w * rs * gv[j].w); o8[64 * j] = w; }
    }
}

__device__ __forceinline__ void phase_prep(Frame& F, const Args& A, int l) {
    F.tid = opaque_tid(); F.lane = F.tid & 63;
    const int gt = F.bid * 512 + F.tid, NGT = F.G * 512;
    {
        const float* cw = A.in[6] + (size_t)l * 4 * D; const float* cb = A.in[7] + (size_t)l * D;
        for (int idx = gt; idx < M * 128; idx += NGT) {
            const int m = idx >> 7, c0 = (idx & 127) * 8, t = m & (T - 1);
            float acc[8];
#pragma unroll
            for (int j = 0; j < 8; ++j) acc[j] = cb[c0 + j];
#pragma unroll
            for (int jj = 0; jj < 4; ++jj) {
                if (t - 3 + jj >= 0) {
                    const v4u xv = *(const v4u*)(F.PROJ + (size_t)(m - 3 + jj) * PN + OFF_LX + c0);
                    const float* w = cw + jj * D + c0;
                    acc[0] += w[0] * blo(xv.x); acc[1] += w[1] * bhi(xv.x); acc[2] += w[2] * blo(xv.y); acc[3] += w[3] * bhi(xv.y);
                    acc[4] += w[4] * blo(xv.z); acc[5] += w[5] * bhi(xv.z); acc[6] += w[6] * blo(xv.w); acc[7] += w[7] * bhi(xv.w);
                }
            }
            v4u o; o.x = pk2(acc[0], acc[1]); o.y = pk2(acc[2], acc[3]); o.z = pk2(acc[4], acc[5]); o.w = pk2(acc[6], acc[7]);
            *(v4u*)(F.XC + (size_t)m * D + c0) = o;
        }
    }
    if (F.bid == 0) { const float* lam = A.in[12] + (size_t)l * D; float* spl = (float*)(F.ws + WS_SPL);
        for (int c = F.tid; c < D; c += 512) { const float nl = -lam[c]; spl[c] = fmaxf(nl, 0.f) + log1pf(__expf(-fabsf(nl))); } }
    {
        const float* qg = A.in[13] + (size_t)l * 128; const float* kg = A.in[14] + (size_t)l * 128;
        const int sub = F.lane >> 4, l16 = F.lane & 15;
        const int gw = F.bid * 8 + F.wave, NGW = F.G * 8;
        for (int it4 = gw; it4 < M * 16 / 4; it4 += NGW) {
            const int item = it4 * 4 + sub, m = item >> 4, hh = item & 15;
            const int col = (hh < 8 ? OFF_SQ + hh * 128 : OFF_SK + (hh - 8) * 128) + l16 * 8;
            const float* g = (hh < 8 ? qg : kg) + l16 * 8;
            const float sc = hh < 8 ? 0.08838834764831845f * 1.4426950408889634f : 1.0f;
            bf16* p = F.PROJ + (size_t)m * PN + col;
            const v4u xv = *(const v4u*)p;
            float v[8] = {blo(xv.x), bhi(xv.x), blo(xv.y), bhi(xv.y), blo(xv.z), bhi(xv.z), blo(xv.w), bhi(xv.w)};
            float s = 0.f;
#pragma unroll
            for (int j = 0; j < 8; ++j) s += v[j] * v[j];
            s += shx(s, 1, F.lane); s += shx(s, 2, F.lane); s += shx(s, 4, F.lane); s += shx(s, 8, F.lane);
            const float rs = sc / sqrtf(s * (1.f / 128.f) + EPS);
            v4u o; o.x = pk2(v[0] * rs * g[0], v[1] * rs * g[1]); o.y = pk2(v[2] * rs * g[2], v[3] * rs * g[3]); o.z = pk2(v[4] * rs * g[4], v[5] * rs * g[5]); o.w = pk2(v[6] * rs * g[6], v[7] * rs * g[7]);
            if (!F.dry) *(v4u*)p = o;
        }
    }
    {
        LAS float* adp = (LAS float*)F.lds;
        LAS float* ad = adp + 2048;
        const bf16* wdt = (const bf16*)(F.ws + WS_WDT) + (size_t)l * 16 * D;
        const float* wup = A.in[3] + (size_t)l * 16 * 512; const float* bal = A.in[4] + (size_t)l * 512;
        for (int ch = F.bid; ch < M / 64; ch += F.G) {
            const int m0 = ch * 64;
            __syncthreads();
            { const int rg = F.wave & 3, kh = F.wave >> 2, l15 = F.lane & 15, q4 = F.lane >> 4;
              const bf16* ap = F.XN + (size_t)(m0 + 16 * rg + l15) * D + 512 * kh + 8 * q4; const bf16* bp = wdt + (size_t)l15 * D + 512 * kh + 8 * q4;
              f32x4 acc = {0.f, 0.f, 0.f, 0.f};
#pragma unroll 4
              for (int ks = 0; ks < 16; ++ks) acc = __builtin_amdgcn_mfma_f32_16x16x32_bf16(*reinterpret_cast<const bf16x8*>(ap + 32 * ks), *reinterpret_cast<const bf16x8*>(bp + 32 * ks), acc, 0, 0, 0);
#pragma unroll
              for (int r = 0; r < 4; ++r) adp[kh * 1024 + (16 * rg + 4 * q4 + r) * 16 + l15] = acc[r]; }
            __syncthreads();
            ad[F.tid] = adp[F.tid] + adp[1024 + F.tid]; ad[512 + F.tid] = adp[512 + F.tid] + adp[1536 + F.tid];
            __syncthreads();
            const int c = F.tid;
            float wu[16];
#pragma unroll
            for (int j = 0; j < 16; ++j) wu[j] = wup[j * 512 + c];
            const float ba = bal[c];
            float cum = 0.f;
            for (int t8 = 0; t8 < 64; t8 += 8) { float kv[8]; bf16 qin[8], kin[8];
#pragma unroll
              for (int tt = 0; tt < 8; ++tt) { qin[tt] = F.PROJ[(size_t)(m0 + t8 + tt) * PN + OFF_GQ + c]; kin[tt] = F.PROJ[(size_t)(m0 + t8 + tt) * PN + OFF_GK + c]; }
#pragma unroll
              for (int tt = 0; tt < 8; ++tt) { const int t = t8 + tt; float lg = ba;
#pragma unroll
                for (int j4 = 0; j4 < 4; ++j4) { const f32x4 a4 = *reinterpret_cast<const LAS f32x4*>(ad + t * 16 + 4 * j4); lg += a4.x * wu[4 * j4] + a4.y * wu[4 * j4 + 1] + a4.z * wu[4 * j4 + 2] + a4.w * wu[4 * j4 + 3]; }
                const float ax = fabsf(lg) * 1.4426950408889634f; const float l2 = __builtin_amdgcn_logf(1.0f + __builtin_amdgcn_exp2f(-ax));
                cum += (fminf(lg, 0.f) * 1.4426950408889634f - l2) * (1.f / 16.f);
                const float e = __builtin_amdgcn_exp2f(cum), ei = __builtin_amdgcn_rcpf(e);
                bf16* pq = F.PROJ + (size_t)(m0 + t) * PN + OFF_GQ + c; bf16* pk = F.PROJ + (size_t)(m0 + t) * PN + OFF_GK + c;
                const float q = bf2f(qin[tt]), k = bf2f(kin[tt]);
                kv[tt] = k * ei; if (!F.dry) { *pq = (bf16)f2bf(q * 0.08838834764831845f * e); *pk = (bf16)f2bf(kv[tt]); } }
              }
            F.DECAY[(size_t)ch * 512 + c] = __builtin_amdgcn_exp2f(cum);
        }
    }
}

struct SchedProj {
    pg8::SchedStd base;
    __device__ __forceinline__ bool next(int i, pg8::Unit& u) const { if (!base.next(i, u)) return false; u.aux = 0; return true; }
    __device__ __forceinline__ const char* abase(const pg8::Unit& u) const { return u.aux ? base.B + (size_t)u.pn * base.tstepB : base.A + (size_t)u.pm * base.tstepA; }
    __device__ __forceinline__ const char* bbase(const pg8::Unit& u) const { return u.aux ? base.A + (size_t)u.pm * base.tstepA : base.B + (size_t)u.pn * base.tstepB; }
};
struct EpiProj {
    static constexpr bool PERM = true;
    bf16* O; bf16* VT;
    __device__ __forceinline__ bool operator()(f32x4 (&acc)[2][2][4][2], const pg8::Unit& u, int wr, int wc, int fr, int fq) const {
        bf16* base = u.aux ? VT : O; const size_t ldc = u.aux ? (size_t)M : (size_t)PN;
        const int row0 = (u.aux ? (u.pn - 4) : u.pm) * 256 + wr * 64 + fr, col0 = (u.aux ? u.pm : u.pn) * 256 + wc * 32 + 8 * fq;
#pragma unroll
        for (int ai = 0; ai < 2; ++ai)
#pragma unroll
            for (int m = 0; m < 4; ++m) { bf16* rowp = base + (size_t)(row0 + ai * 128 + m * 16) * ldc + col0;
#pragma unroll
                for (int bj = 0; bj < 2; ++bj) { const f32x4 v0 = acc[ai][bj][m][0], v1 = acc[ai][bj][m][1];
                    v4u w; w.x = pg8::cvt_pk_bf16(v0[0], v0[1]); w.y = pg8::cvt_pk_bf16(v0[2], v0[3]); w.z = pg8::cvt_pk_bf16(v1[0], v1[1]); w.w = pg8::cvt_pk_bf16(v1[2], v1[3]);
                    *(v4u*)(rowp + bj * 128) = w; } }
        return true;
    }
};

struct SchedLru {
    const char* A; const char* B; int G, c;
    __device__ __forceinline__ bool next(int i, pg8::Unit& u) const { const int L = i * G + c; if (L >= 512) return false; u.pm = L >> 3; u.pn = L & 7; u.aux = 0; return true; }
    __device__ __forceinline__ const char* abase(const pg8::Unit& u) const { return A + (size_t)u.pm * 256 * D * 2 + (size_t)(u.pn >> 1) * 256 * 2; }
    __device__ __forceinline__ const char* bbase(const pg8::Unit& u) const { return B + (size_t)u.pn * 256 * 256 * 2; }
};
struct EpiLru {
    static constexpr bool PERM = true;
    const bf16* XC; bf16* OMA; int ld_oma; bf16* U; const float* ba; const float* bx; const float* lam;
    __device__ __forceinline__ bool operator()(f32x4 (&acc)[2][2][4][2], const pg8::Unit& u, int wr, int wc, int fr, int fq) const {
        const int row0 = u.pm * 256 + wr * 64 + fr, chb = (u.pn >> 1) * 256 + (u.pn & 1) * 128 + wc * 32 + 8 * fq;
#pragma unroll
        for (int n = 0; n < 2; ++n) {
            const int ch0 = chb + 4 * n;
            const f32x4 b_a = *(const f32x4*)(ba + ch0), b_x = *(const f32x4*)(bx + ch0), sp = *(const f32x4*)(lam + ch0) * (-8.0f * 1.4426950408889634f);
#pragma unroll
            for (int ai = 0; ai < 2; ++ai)
#pragma unroll
                for (int m = 0; m < 4; ++m) { const int row = row0 + ai * 128 + m * 16;
                    const v2u xv = *(const v2u*)(XC + (size_t)row * D + ch0);
                    const float xc[4] = {blo(xv.x), bhi(xv.x), blo(xv.y), bhi(xv.y)};
                    float oa[4], uu[4];
#pragma unroll
                    for (int j = 0; j < 4; ++j) { const float pa = acc[ai][0][m][n][j] + b_a[j], px = acc[ai][1][m][n][j] + b_x[j];
                        const float r = __builtin_amdgcn_rcpf(1.0f + __builtin_amdgcn_exp2f(-1.4426950408889634f * pa)), ig = __builtin_amdgcn_rcpf(1.0f + __builtin_amdgcn_exp2f(-1.4426950408889634f * px));
                        const float a = __builtin_amdgcn_exp2f(r * sp[j]); const float om = 1.0f - a;
                        oa[j] = om; uu[j] = __builtin_amdgcn_sqrtf(om * (1.0f + a)) * ig * xc[j]; }
                    v2u w1; w1.x = pk2(oa[0], oa[1]); w1.y = pk2(oa[2], oa[3]);
                    v2u w2; w2.x = pk2(uu[0], uu[1]); w2.y = pk2(uu[2], uu[3]);
                    *(v2u*)(OMA + (size_t)row * ld_oma + ch0) = w1; *(v2u*)(U + (size_t)row * D + ch0) = w2;
                    asm volatile("" ::: "memory"); }
        }
        return true;
    }
};

struct SchedBranch {
    const char* P; const char* B; int G, c;
    __device__ __forceinline__ bool next(int i, pg8::Unit& u) const { const int tile = (i / 3) * G + c; if (tile >= 256) return false; u.pm = tile >> 2; u.pn = tile & 3; u.aux = i % 3; return true; }
    __device__ __forceinline__ const char* abase(const pg8::Unit& u) const { const int off = u.aux == 0 ? OFF_GG : (u.aux == 1 ? OFF_LG : OFF_SQ); return P + ((size_t)u.pm * 256 * PN + off) * 2; }
    __device__ __forceinline__ const char* bbase(const pg8::Unit& u) const { return B + (size_t)(u.aux * 1024 + u.pn * 256) * D * 2; }
};
struct EpiBranch {
    static constexpr bool PERM = true;
    const bf16* PROJ; const float* bg; bf16* O;
    __device__ __forceinline__ bool operator()(f32x4 (&acc)[2][2][4][2], const pg8::Unit& u, int wr, int wc, int fr, int fq) const {
        const int row0 = u.pm * 256 + wr * 64 + fr, col0 = u.pn * 256 + wc * 32 + 8 * fq, br = u.aux;
#pragma unroll
        for (int bj = 0; bj < 2; ++bj) {
            const int c = col0 + bj * 128;
            float b0[8], b1[8];
#pragma unroll
            for (int j = 0; j < 8; ++j) { b0[j] = bg[br * 1024 + c + j]; b1[j] = br < 2 ? bg[(br + 1) * 1024 + c + j] : 0.f; }
#pragma unroll
            for (int ai = 0; ai < 2; ++ai)
#pragma unroll
                for (int m = 0; m < 4; ++m) { const int row = row0 + ai * 128 + m * 16;
                    const bf16* gp = PROJ + (size_t)row * PN + OFF_GATE + br * 1024 + c;
                    const v4u l0 = *(const v4u*)gp;
                    const float x0[8] = {blo(l0.x), bhi(l0.x), blo(l0.y), bhi(l0.y), blo(l0.z), bhi(l0.z), blo(l0.w), bhi(l0.w)};
                    float f[8];
                    if (br < 2) { const v4u l1 = *(const v4u*)(gp + 1024);
                        const float x1[8] = {blo(l1.x), bhi(l1.x), blo(l1.y), bhi(l1.y), blo(l1.z), bhi(l1.z), blo(l1.w), bhi(l1.w)};
#pragma unroll
                        for (int j = 0; j < 8; ++j) f[j] = (1.0f + __expf(-(x1[j] + b1[j]))) / (1.0f + __expf(-(x0[j] + b0[j])));
                    } else {
#pragma unroll
                        for (int j = 0; j < 8; ++j) f[j] = 1.0f / (1.0f + __expf(-(x0[j] + b0[j])));
                    }
#pragma unroll
                    for (int j = 0; j < 8; ++j) acc[ai][bj][m][j >> 2][j & 3] *= f[j];
                    if (br == 2) { const f32x4 v0 = acc[ai][bj][m][0], v1 = acc[ai][bj][m][1];
                        v4u w; w.x = pg8::cvt_pk_bf16(v0[0], v0[1]); w.y = pg8::cvt_pk_bf16(v0[2], v0[3]); w.z = pg8::cvt_pk_bf16(v1[0], v1[1]); w.w = pg8::cvt_pk_bf16(v1[2], v1[3]);
                        *(v4u*)(O + (size_t)row * D + c) = w; } }
        }
        return br == 2;
    }
};

namespace gla {
typedef float f32x16 __attribute__((ext_vector_type(16)));
typedef short s16x4 __attribute__((ext_vector_type(4)));
constexpr int BUF = 65536, T_QD = 0, T_KI = 16384, T_V = 32768, X_SSQ = 131072, X_DW = 131072 + 2048;
__device__ __forceinline__ int crow(int r, int hi) { return (r & 3) + 8 * (r >> 2) + 4 * hi; }
__device__ __forceinline__ unsigned cvtpk(float lo, float hi) { unsigned r; asm volatile("v_cvt_pk_bf16_f32 %0, %1, %2" : "=v"(r) : "v"(lo), "v"(hi)); return r; }
__device__ __forceinline__ bf16x8 acc_frag(const f32x16& X, int s) { v4u w = {cvtpk(X[8 * s], X[8 * s + 1]), cvtpk(X[8 * s + 2], X[8 * s + 3]), cvtpk(X[8 * s + 4], X[8 * s + 5]), cvtpk(X[8 * s + 6], X[8 * s + 7])}; return *reinterpret_cast<bf16x8*>(&w); }
__device__ __forceinline__ int offb(int row, int ch) { return 256 * row + 16 * (ch ^ (((row & 3) << 2) | ((row >> 2) & 3))); }
__device__ __forceinline__ bf16x8 rowrd(const LAS unsigned char* tile, int lane, int rb, int s) { return *reinterpret_cast<const LAS bf16x8*>(tile + offb((lane & 31) + 32 * rb, 2 * s + (lane >> 5))); }
__device__ __forceinline__ v2u rd8(const LAS unsigned char* tile, int row, int ch, int half) { return *reinterpret_cast<const LAS v2u*>(tile + offb(row, ch) + 8 * half); }
__device__ __forceinline__ s16x4 trr(unsigned addr) { s16x4 r; asm volatile("ds_read_b64_tr_b16 %0, %1" : "=&v"(r) : "v"(addr) : "memory"); return r; }
__device__ __forceinline__ unsigned tr_addr(unsigned base, int lane, int c, int row0) { const int blk = (lane >> 4) & 1, q = (lane & 15) >> 2, p = lane & 3; return base + offb(row0 + q, 4 * c + 2 * blk + (p >> 1)) + 8 * (p & 1); }
__device__ __forceinline__ bf16x8 tr_nat(unsigned base, int lane, int c, int ks) { const int h = lane >> 5; const s16x4 a = trr(tr_addr(base, lane, c, 16 * ks + 8 * h)), b = trr(tr_addr(base, lane, c, 16 * ks + 8 * h + 4));
    asm volatile("s_waitcnt lgkmcnt(0)" ::: "memory"); return (bf16x8){a[0], a[1], a[2], a[3], b[0], b[1], b[2], b[3]}; }
__device__ __forceinline__ bf16x8 tr_perm(unsigned base, int lane, int c, int ks) { const int h = lane >> 5; const s16x4 a = trr(tr_addr(base, lane, c, 16 * ks + 4 * h)), b = trr(tr_addr(base, lane, c, 16 * ks + 8 + 4 * h));
    asm volatile("s_waitcnt lgkmcnt(0)" ::: "memory"); return (bf16x8){a[0], a[1], a[2], a[3], b[0], b[1], b[2], b[3]}; }
__device__ __forceinline__ void dma_tile(LAS unsigned char* img, const bf16* grow0  , int wid, int lane) {
#pragma unroll
    for (int i = 0; i < 2; ++i) { const int L = (wid + 8 * i) * 64 + lane, row = L >> 4, ch = (L & 15) ^ (((row & 3) << 2) | ((row >> 2) & 3));
        __builtin_amdgcn_global_load_lds((const unsigned*)(grow0 + (size_t)row * PN + ch * 8), (LAS unsigned*)(img + (wid + 8 * i) * 1024), 16, 0, 0); }
}
__device__ __forceinline__ void dma_chunk(LAS unsigned char* lds, int buf, const bf16* proj_row0  , int h, bool with_q, int wid, int lane) {
    LAS unsigned char* b = lds + buf * BUF;
    if (with_q) dma_tile(b + T_QD, proj_row0 + OFF_GQ + h * 128, wid, lane);
    dma_tile(b + T_KI, proj_row0 + OFF_GK + h * 128, wid, lane);
    dma_tile(b + T_V, proj_row0 + OFF_GV + h * 256, wid, lane);
    dma_tile(b + T_V + 16384, proj_row0 + OFF_GV + h * 256 + 128, wid, lane);
}
__device__ __forceinline__ void s_update(f32x16 (&S)[4], const LAS unsigned char* b, unsigned bi, const float* dec, int wid, int lane, int hi) {
    const unsigned vimg = bi + T_V + (wid >> 2) * 16384, kimg = bi + T_KI;
#pragma unroll
    for (int ks = 0; ks < 4; ++ks) { const bf16x8 bv = tr_nat(vimg, lane, wid & 3, ks);
#pragma unroll
        for (int db = 0; db < 4; ++db) { const bf16x8 a = tr_nat(kimg, lane, db, ks); S[db] = __builtin_amdgcn_mfma_f32_32x32x16_bf16(a, bv, S[db], 0, 0, 0); } }
#pragma unroll
    for (int db = 0; db < 4; ++db)
#pragma unroll
        for (int g = 0; g < 4; ++g) { const f32x4 d = *reinterpret_cast<const f32x4*>(dec + 32 * db + 8 * g + 4 * hi);
#pragma unroll
            for (int i = 0; i < 4; ++i) S[db][4 * g + i] *= d[i]; }
}
__device__ __forceinline__ void pass1_item(Frame& F, int it) {
    const int tid = opaque_tid(), wid = __builtin_amdgcn_readfirstlane(tid >> 6), lane = tid & 63, hi = lane >> 5;
    const int b = it >> 5, h = (it >> 3) & 3, g = it & 7;
    const float* decb = F.DECAY + (size_t)(b * 32) * 512 + h * 128;
    const unsigned lbase = (unsigned)(uintptr_t)F.ldsg;
    f32x16 S[4];
#pragma unroll
    for (int db = 0; db < 4; ++db) S[db] = f32x16{};
    __syncthreads();
    dma_chunk(F.lds, 0, F.PROJ + (size_t)(b * T + (4 * g) * 64) * PN, h, false, wid, lane);
    asm volatile("s_waitcnt vmcnt(0)" ::: "memory"); __syncthreads();
#pragma nounroll
    for (int n = 0; n < 4; ++n) { const int ch = 4 * g + n;
        if (n < 3) dma_chunk(F.lds, (n + 1) & 1, F.PROJ + (size_t)(b * T + (ch + 1) * 64) * PN, h, false, wid, lane);
        int ln = lane; asm volatile("" : "+v"(ln));
        s_update(S, F.lds + (n & 1) * BUF, lbase + (n & 1) * BUF, decb + (size_t)ch * 512, wid, ln, ln >> 5);
        asm volatile("s_waitcnt vmcnt(0)" ::: "memory"); __syncthreads();
    }
    float* sl = (float*)(F.ws + WS_VT) + (size_t)it * 32768 + wid * 4096;
#pragma unroll
    for (int db = 0; db < 4; ++db)
#pragma unroll
        for (int g4 = 0; g4 < 4; ++g4) *reinterpret_cast<f32x4*>(sl + ((db * 4 + g4) * 64 + lane) * 4) = (f32x4){S[db][4 * g4], S[db][4 * g4 + 1], S[db][4 * g4 + 2], S[db][4 * g4 + 3]};
}
__device__ __forceinline__ void pass2_item(Frame& F, const float* norm_g, int it) {
    const int tid = opaque_tid(), wid = __builtin_amdgcn_readfirstlane(tid >> 6), lane = tid & 63, r32 = lane & 31, hi = lane >> 5;
    const int b = it >> 5, h = (it >> 3) & 3, g = it & 7;
    const float* decb = F.DECAY + (size_t)(b * 32) * 512 + h * 128;
    const unsigned lbase = (unsigned)(uintptr_t)F.ldsg;
    LAS float* ssqx = (LAS float*)(F.lds + X_SSQ);
    LAS float* Dw = (LAS float*)(F.lds + X_DW);
    __syncthreads();
    dma_chunk(F.lds, 0, F.PROJ + (size_t)(b * T + (4 * g) * 64) * PN, h, true, wid, lane);
    { const int w2 = tid >> 6, d2 = (tid & 63) * 2; const float* dp = decb + (size_t)(4 * w2) * 512 + d2;
      float p0 = 1.f, p1 = 1.f;
#pragma unroll
      for (int n = 0; n < 4; ++n) { p0 *= dp[n * 512]; p1 *= dp[n * 512 + 1]; }
      Dw[w2 * 128 + d2] = p0; Dw[w2 * 128 + d2 + 1] = p1; }
    __syncthreads();
    f32x16 S[4];
#pragma unroll
    for (int db = 0; db < 4; ++db) S[db] = f32x16{};
    for (int g2 = 0; g2 < g; ++g2) { const float* sl = (const float*)(F.ws + WS_VT) + (size_t)(it - g + g2) * 32768 + wid * 4096;
#pragma unroll
        for (int db = 0; db < 4; ++db)
#pragma unroll
            for (int g4 = 0; g4 < 4; ++g4) { const f32x4 d = *reinterpret_cast<const LAS f32x4*>(Dw + g2 * 128 + 32 * db + 8 * g4 + 4 * hi);
                const f32x4 sv = *reinterpret_cast<const f32x4*>(sl + ((db * 4 + g4) * 64 + lane) * 4);
#pragma unroll
                for (int i = 0; i < 4; ++i) S[db][4 * g4 + i] = d[i] * S[db][4 * g4 + i] + sv[i]; }
    }
    float ng[16];
#pragma unroll
    for (int r = 0; r < 16; ++r) ng[r] = norm_g[32 * wid + crow(r, hi)];
    asm volatile("s_waitcnt vmcnt(0)" ::: "memory"); __syncthreads();
#pragma nounroll
    for (int n = 0; n < 4; ++n) { const int ch = 4 * g + n; const size_t m0 = (size_t)(b * T + ch * 64);
        if (n < 3) dma_chunk(F.lds, (n + 1) & 1, F.PROJ + (m0 + 64) * PN, h, true, wid, lane);
        int ln = lane; asm volatile("" : "+v"(ln));
        const int lane = ln, r32 = ln & 31, hi = ln >> 5;
        const LAS unsigned char* bq = F.lds + (n & 1) * BUF + T_QD; const LAS unsigned char* bk = F.lds + (n & 1) * BUF + T_KI;
        const unsigned bi = lbase + (n & 1) * BUF, vimg = bi + T_V + (wid >> 2) * 16384;
        f32x16 a00 = f32x16{}, a01 = f32x16{}, a11 = f32x16{};
#pragma unroll
        for (int d0 = 0; d0 < 8; ++d0) { const bf16x8 k0 = rowrd(bk, lane, 0, d0), k1 = rowrd(bk, lane, 1, d0), q0 = rowrd(bq, lane, 0, d0), q1 = rowrd(bq, lane, 1, d0);
            a00 = __builtin_amdgcn_mfma_f32_32x32x16_bf16(k0, q0, a00, 0, 0, 0);
            a01 = __builtin_amdgcn_mfma_f32_32x32x16_bf16(k0, q1, a01, 0, 0, 0);
            a11 = __builtin_amdgcn_mfma_f32_32x32x16_bf16(k1, q1, a11, 0, 0, 0); }
#pragma unroll
        for (int r = 0; r < 16; ++r) { const bool vis = crow(r, hi) <= r32; a00[r] = vis ? a00[r] : 0.f; a11[r] = vis ? a11[r] : 0.f; }
        f32x16 o0 = f32x16{}, o1 = f32x16{};
#pragma unroll
        for (int ks = 0; ks < 2; ++ks) { const bf16x8 va = tr_perm(vimg, lane, wid & 3, ks), vb = tr_perm(vimg, lane, wid & 3, 2 + ks);
            o0 = __builtin_amdgcn_mfma_f32_32x32x16_bf16(va, acc_frag(a00, ks), o0, 0, 0, 0);
            o1 = __builtin_amdgcn_mfma_f32_32x32x16_bf16(va, acc_frag(a01, ks), o1, 0, 0, 0);
            o1 = __builtin_amdgcn_mfma_f32_32x32x16_bf16(vb, acc_frag(a11, ks), o1, 0, 0, 0); }
#pragma unroll
        for (int db = 0; db < 4; ++db)
#pragma unroll
            for (int ks = 0; ks < 2; ++ks) { const bf16x8 sa = acc_frag(S[db], ks);
                const v2u x0 = rd8(bq, r32, 4 * db + 2 * ks, hi), x1 = rd8(bq, r32, 4 * db + 2 * ks + 1, hi), y0 = rd8(bq, 32 + r32, 4 * db + 2 * ks, hi), y1 = rd8(bq, 32 + r32, 4 * db + 2 * ks + 1, hi);
                v4u wx = {x0.x, x0.y, x1.x, x1.y}, wy = {y0.x, y0.y, y1.x, y1.y};
                o0 = __builtin_amdgcn_mfma_f32_32x32x16_bf16(sa, *reinterpret_cast<bf16x8*>(&wx), o0, 0, 0, 0);
                o1 = __builtin_amdgcn_mfma_f32_32x32x16_bf16(sa, *reinterpret_cast<bf16x8*>(&wy), o1, 0, 0, 0); }
        float s0 = 0.f, s1 = 0.f;
#pragma unroll
        for (int r = 0; r < 16; ++r) { s0 += o0[r] * o0[r]; s1 += o1[r] * o1[r]; }
        { auto rr = __builtin_amdgcn_permlane32_swap(__float_as_uint(s0), __float_as_uint(s0), false, false); s0 = __uint_as_float(rr[0]) + __uint_as_float(rr[1]); }
        { auto rr = __builtin_amdgcn_permlane32_swap(__float_as_uint(s1), __float_as_uint(s1), false, false); s1 = __uint_as_float(rr[0]) + __uint_as_float(rr[1]); }
        if (hi == 0) { ssqx[wid * 64 + r32] = s0; ssqx[wid * 64 + 32 + r32] = s1; }
        const bf16* gp = F.PROJ + (m0 + r32) * PN + OFF_GG + h * 256 + 32 * wid + 4 * hi;
        v2u gg0[4], gg1[4];
#pragma unroll
        for (int g4 = 0; g4 < 4; ++g4) { gg0[g4] = *reinterpret_cast<const v2u*>(gp + 8 * g4); gg1[g4] = *reinterpret_cast<const v2u*>(gp + (size_t)32 * PN + 8 * g4); }
        __syncthreads();
        float t0s = 0.f, t1s = 0.f;
#pragma unroll
        for (int w2 = 0; w2 < 8; ++w2) { t0s += ssqx[w2 * 64 + r32]; t1s += ssqx[w2 * 64 + 32 + r32]; }
        const float rs0 = 1.0f / sqrtf(t0s * (1.f / 256.f) + EPS), rs1 = 1.0f / sqrtf(t1s * (1.f / 256.f) + EPS);
#pragma unroll
        for (int g4 = 0; g4 < 4; ++g4) {
            const float ga[4] = {blo(gg0[g4].x), bhi(gg0[g4].x), blo(gg0[g4].y), bhi(gg0[g4].y)}, gb[4] = {blo(gg1[g4].x), bhi(gg1[g4].x), blo(gg1[g4].y), bhi(gg1[g4].y)};
            float ya[4], yb[4];
#pragma unroll
            for (int i = 0; i < 4; ++i) { ya[i] = o0[4 * g4 + i] * rs0 * ng[4 * g4 + i] * (ga[i] * __builtin_amdgcn_rcpf(1.0f + __builtin_amdgcn_exp2f(-1.4426950408889634f * ga[i])));
                                          yb[i] = o1[4 * g4 + i] * rs1 * ng[4 * g4 + i] * (gb[i] * __builtin_amdgcn_rcpf(1.0f + __builtin_amdgcn_exp2f(-1.4426950408889634f * gb[i]))); }
            v2u w0 = {cvtpk(ya[0], ya[1]), cvtpk(ya[2], ya[3])}, w1 = {cvtpk(yb[0], yb[1]), cvtpk(yb[2], yb[3])};
            if (!F.dry) { *reinterpret_cast<v2u*>(const_cast<bf16*>(gp) + 8 * g4) = w0; *reinterpret_cast<v2u*>(const_cast<bf16*>(gp) + (size_t)32 * PN + 8 * g4) = w1; }
        }
        if (n < 3) s_update(S, F.lds + (n & 1) * BUF, bi, decb + (size_t)ch * 512, wid, lane, hi);
        asm volatile("s_waitcnt vmcnt(0)" ::: "memory"); __syncthreads();
    }
}
}
__device__ __forceinline__ void phase_gla_fix(Frame& F, const Args& A, int l) {
    F.tid = opaque_tid(); F.lane = F.tid & 63;
    const int gt = F.bid * 512 + F.tid, NGT = F.G * 512;
    const float* ng = A.in[5] + (size_t)l * 256;
    for (int idx = gt; idx < M * 128; idx += NGT) {
        const int m = idx >> 7, c0 = (idx & 127) * 8, h = c0 >> 8;
        const float* sp = F.SSQ + (size_t)m * 32 + h * 8;
        const float ss = ((sp[0] + sp[1]) + (sp[2] + sp[3])) + ((sp[4] + sp[5]) + (sp[6] + sp[7]));
        const float rs = 1.0f / sqrtf(ss * (1.f / 256.f) + EPS);
        const v4u ov = *(const v4u*)(F.PROJ + (size_t)m * PN + OFF_GV + c0);
        bf16* gp = F.PROJ + (size_t)m * PN + OFF_GG + c0;
        const v4u gv = *(const v4u*)gp;
        const float o[8] = {blo(ov.x), bhi(ov.x), blo(ov.y), bhi(ov.y), blo(ov.z), bhi(ov.z), blo(ov.w), bhi(ov.w)};
        const float g[8] = {blo(gv.x), bhi(gv.x), blo(gv.y), bhi(gv.y), blo(gv.z), bhi(gv.z), blo(gv.w), bhi(gv.w)};
        float r[8];
#pragma unroll
        for (int j = 0; j < 8; ++j) r[j] = o[j] * rs * ng[(c0 & 255) + j] * (g[j] * sigmoidf_(g[j]));
        v4u w; w.x = pk2(r[0], r[1]); w.y = pk2(r[2], r[3]); w.z = pk2(r[4], r[5]); w.w = pk2(r[6], r[7]);
        if (!F.dry) *(v4u*)gp = w;
    }
}

__device__ __forceinline__ float gelu_tanh(float x) { const float y = 0.7978845608028654f * (x + 0.044715f * x * x * x); const float e = __expf(2.0f * y); const float th = 1.0f - 2.0f / (e + 1.0f); return 0.5f * x * (1.0f + th); }
__device__ __forceinline__ void lru_scan_item(Frame& F, int item) {
    F.tid = opaque_tid(); F.lane = F.tid & 63;
    const int b = item >> 5, cg = item & 31, tid = F.tid, seg = tid >> 3, quad = tid & 7, ch = cg * 32 + quad * 4;
    LAS float* segP = (LAS float*)F.lds;
    LAS float* segH = segP + 64 * 32; LAS float* carry = segH + 64 * 32;
    const int m0 = b * T + seg * 32;
    float h[4] = {0, 0, 0, 0}, P[4] = {1, 1, 1, 1};
#pragma unroll
    for (int i16 = 0; i16 < 32; i16 += 16) {
        v2u om[16], uu[16];
#pragma unroll
        for (int i = 0; i < 16; ++i) { om[i] = *(const v2u*)(F.PROJ + (size_t)(m0 + i16 + i) * PN + OFF_LX + ch); uu[i] = *(const v2u*)(F.U + (size_t)(m0 + i16 + i) * D + ch); }
#pragma unroll
        for (int i = 0; i < 16; ++i) {
            const float a[4] = {1.f - blo(om[i].x), 1.f - bhi(om[i].x), 1.f - blo(om[i].y), 1.f - bhi(om[i].y)}; const float u[4] = {blo(uu[i].x), bhi(uu[i].x), blo(uu[i].y), bhi(uu[i].y)};
#pragma unroll
            for (int j = 0; j < 4; ++j) { h[j] = a[j] * h[j] + u[j]; P[j] *= a[j]; }
        }
    }
    __syncthreads();
#pragma unroll
    for (int j = 0; j < 4; ++j) { segP[seg * 32 + quad * 4 + j] = P[j]; segH[seg * 32 + quad * 4 + j] = h[j]; }
    __syncthreads();
    if (tid < 32) { float c = 0.f; for (int s = 0; s < 64; ++s) { carry[s * 32 + tid] = c; c = segP[s * 32 + tid] * c + segH[s * 32 + tid]; } }
    __syncthreads();
#pragma unroll
    for (int j = 0; j < 4; ++j) h[j] = carry[seg * 32 + quad * 4 + j];
#pragma nounroll
    for (int i8 = 0; i8 < 32; i8 += 8) {
        v2u om[8], uu[8], gv[8];
#pragma unroll
        for (int i = 0; i < 8; ++i) { om[i] = *(const v2u*)(F.PROJ + (size_t)(m0 + i8 + i) * PN + OFF_LX + ch); uu[i] = *(const v2u*)(F.U + (size_t)(m0 + i8 + i) * D + ch);
            gv[i] = *(const v2u*)(F.PROJ + (size_t)(m0 + i8 + i) * PN + OFF_LG + ch); }
#pragma unroll
        for (int i = 0; i < 8; ++i) {
            const float a[4] = {1.f - blo(om[i].x), 1.f - bhi(om[i].x), 1.f - blo(om[i].y), 1.f - bhi(om[i].y)}; const float u[4] = {blo(uu[i].x), bhi(uu[i].x), blo(uu[i].y), bhi(uu[i].y)};
            const float g[4] = {blo(gv[i].x), bhi(gv[i].x), blo(gv[i].y), bhi(gv[i].y)};
            float y[4];
#pragma unroll
            for (int j = 0; j < 4; ++j) { h[j] = a[j] * h[j] + u[j]; y[j] = h[j] * gelu_tanh(g[j]); }
            v2u w; w.x = pk2(y[0], y[1]); w.y = pk2(y[2], y[3]); if (!F.dry) *(v2u*)(F.PROJ + (size_t)(m0 + i8 + i) * PN + OFF_LG + ch) = w;
        }
    }
    __syncthreads();
}

namespace sba {
typedef float f32x16 __attribute__((ext_vector_type(16)));
typedef short s16x4 __attribute__((ext_vector_type(4)));
constexpr int SHM_V = 64 * 128 * 2, SHM_K = 64 * 128 * 2;
#define SBA_KSWZ(row, colB) ((row) * 256 + ((colB) ^ (((row) & 7) << 4)))
#define SBA_SBAR() __builtin_amdgcn_sched_barrier(0)
__device__ __forceinline__ int crow(int r, int hi) { return (r & 3) + 8 * (r >> 2) + 4 * hi; }
__device__ __forceinline__ unsigned cvtpk(float lo, float hi) { unsigned r; asm volatile("v_cvt_pk_bf16_f32 %0, %1, %2" : "=v"(r) : "v"(lo), "v"(hi)); return r; }
__device__ __forceinline__ void qkt(f32x16& p0, f32x16& p1, const char* Ks, const bf16x8* qr, int r32, int hi) {
    p0 = f32x16{}; p1 = f32x16{};
#pragma unroll
    for (int d0 = 0; d0 < 8; ++d0) { const int cb = (d0 * 16 + hi * 8) * 2;
        const bf16x8 b0 = *reinterpret_cast<const bf16x8*>(Ks + SBA_KSWZ(r32, cb));
        const bf16x8 b1 = *reinterpret_cast<const bf16x8*>(Ks + SBA_KSWZ(32 + r32, cb));
        p0 = __builtin_amdgcn_mfma_f32_32x32x16_bf16(b0, qr[d0], p0, 0, 0, 0);
        p1 = __builtin_amdgcn_mfma_f32_32x32x16_bf16(b1, qr[d0], p1, 0, 0, 0); }
}
__device__ __forceinline__ void sig_part(f32x16& p0, f32x16& p1, bool partial, int krel, int hi) {
#pragma unroll
    for (int r = 0; r < 16; ++r) { p0[r] = __builtin_amdgcn_rcpf(1.0f + __builtin_amdgcn_exp2f(p0[r])); p1[r] = __builtin_amdgcn_rcpf(1.0f + __builtin_amdgcn_exp2f(p1[r])); }
    if (partial) {
#pragma unroll
        for (int r = 0; r < 16; ++r) { const int kk = krel + crow(r, hi); p0[r] = (kk < 0) ? p0[r] : 1.0f; p1[r] = (kk + 32 < 0) ? p1[r] : 1.0f; }
    }
}
__device__ __forceinline__ void finish(f32x16& p0, f32x16& p1, float& R, int hi, bf16x8& pa0, bf16x8& pa1, bf16x8& pa2, bf16x8& pa3) {
    float lo[8], hv[8];
#pragma unroll
    for (int g = 0; g < 4; ++g) {
        const float ga = (p0[4 * g] * p0[4 * g + 1]) * (p0[4 * g + 2] * p0[4 * g + 3]), gb = (p1[4 * g] * p1[4 * g + 1]) * (p1[4 * g + 2] * p1[4 * g + 3]);
        { auto rr = __builtin_amdgcn_permlane32_swap(__float_as_uint(ga), __float_as_uint(ga), false, false); lo[g] = __uint_as_float(rr[0]); hv[g] = __uint_as_float(rr[1]); }
        { auto rr = __builtin_amdgcn_permlane32_swap(__float_as_uint(gb), __float_as_uint(gb), false, false); lo[4 + g] = __uint_as_float(rr[0]); hv[4 + g] = __uint_as_float(rr[1]); }
    }
    float ps = R;
#pragma unroll
    for (int g = 7; g >= 0; --g) {
        float run = ps * (hi == 0 ? hv[g] : 1.0f);
#pragma unroll
        for (int i = 3; i >= 0; --i) {
            if (g >= 4) { const float k = p1[4 * (g - 4) + i]; p1[4 * (g - 4) + i] = (1.0f - k) * run; run *= k; }
            else        { const float k = p0[4 * g + i];       p0[4 * g + i]       = (1.0f - k) * run; run *= k; }
        }
        ps = ps * (lo[g] * hv[g]);
    }
    R = ps;
#define SBA_PK4(P, BASE, OUT) do { unsigned a0 = cvtpk(P[BASE + 0], P[BASE + 1]), a1 = cvtpk(P[BASE + 2], P[BASE + 3]);   \
    unsigned b0 = cvtpk(P[BASE + 4], P[BASE + 5]), b1 = cvtpk(P[BASE + 6], P[BASE + 7]);                              \
    auto r0 = __builtin_amdgcn_permlane32_swap(a0, b0, false, false); auto r1 = __builtin_amdgcn_permlane32_swap(a1, b1, false, false); \
    v4u w = {r0[0], r1[0], r0[1], r1[1]}; OUT = *reinterpret_cast<bf16x8*>(&w); } while (0)
    SBA_PK4(p0, 0, pa0); SBA_PK4(p0, 8, pa1); SBA_PK4(p1, 0, pa2); SBA_PK4(p1, 8, pa3);
#undef SBA_PK4
}
__device__ __forceinline__ int v_st(int k, int c) { const int kk = (k & ~0xC) | ((k & 4) << 1) | ((k & 8) >> 1); return ((kk >> 3) * 4 + (c >> 5)) * 512 + ((kk & 7) * 32 + (c & 31)) * 2; }
__device__ __forceinline__ int v_rd_base(int lane) { return ((lane & 3) << 3) | (((lane >> 2) & 3) << 6) | (((lane >> 4) & 1) << 5) | (((lane >> 5) & 1) << 8); }
constexpr int v_rd_off(int d0, int ks, int half) { return d0 * 512 + ks * 4096 + half * 2048; }
template <int OFF> __device__ __forceinline__ s16x4 tr_read(int vb) { s16x4 r; asm volatile("ds_read_b64_tr_b16 %0, %1 offset:%2" : "=&v"(r) : "v"(vb), "i"(OFF) : "memory"); return r; }
template <int D0> __device__ __forceinline__ void pv_one(f32x16& od, int vb, bf16x8 pa0, bf16x8 pa1, bf16x8 pa2, bf16x8 pa3) {
    const s16x4 l0 = tr_read<v_rd_off(D0, 0, 0)>(vb), h0 = tr_read<v_rd_off(D0, 0, 1)>(vb), l1 = tr_read<v_rd_off(D0, 1, 0)>(vb), h1 = tr_read<v_rd_off(D0, 1, 1)>(vb);
    const s16x4 l2 = tr_read<v_rd_off(D0, 2, 0)>(vb), h2 = tr_read<v_rd_off(D0, 2, 1)>(vb), l3 = tr_read<v_rd_off(D0, 3, 0)>(vb), h3 = tr_read<v_rd_off(D0, 3, 1)>(vb);
    asm volatile("s_waitcnt lgkmcnt(0)" ::: "memory"); SBA_SBAR();
#define SBA_PK(L, H) (bf16x8){L[0], L[1], L[2], L[3], H[0], H[1], H[2], H[3]}
    od = __builtin_amdgcn_mfma_f32_32x32x16_bf16(pa0, SBA_PK(l0, h0), od, 0, 0, 0);
    od = __builtin_amdgcn_mfma_f32_32x32x16_bf16(pa1, SBA_PK(l1, h1), od, 0, 0, 0);
    od = __builtin_amdgcn_mfma_f32_32x32x16_bf16(pa2, SBA_PK(l2, h2), od, 0, 0, 0);
    od = __builtin_amdgcn_mfma_f32_32x32x16_bf16(pa3, SBA_PK(l3, h3), od, 0, 0, 0);
#undef SBA_PK
}
__device__ __forceinline__ void pv_d0(f32x16* o, int vb, bf16x8 pa0, bf16x8 pa1, bf16x8 pa2, bf16x8 pa3) {
    pv_one<0>(o[0], vb, pa0, pa1, pa2, pa3); pv_one<1>(o[1], vb, pa0, pa1, pa2, pa3); pv_one<2>(o[2], vb, pa0, pa1, pa2, pa3); pv_one<3>(o[3], vb, pa0, pa1, pa2, pa3);
}
__device__ __forceinline__ void unit(const bf16* Qb, const bf16* __restrict__ Kh, const bf16* __restrict__ Vh, bf16* Ob, int qb, char* lds, int tid, bool dry) {
    const int wid = __builtin_amdgcn_readfirstlane(tid >> 6), lane = tid & 63, r32 = lane & 31, hi = lane >> 5;
    char* V_lds = lds; char* K_lds = lds + 2 * SHM_V;
    f32x16 o[4] = {}; bf16x8 qr[8]; float R = 1.0f;
    const bf16* Qw = Qb + (size_t)(wid * 32 + r32) * PN + hi * 8;
#pragma unroll
    for (int d0 = 0; d0 < 8; ++d0) qr[d0] = *reinterpret_cast<const bf16x8*>(Qw + d0 * 16);
    const int sr = tid >> 4, sc = (tid & 15) * 8, vst0 = v_st(sr, sc), vst1 = v_st(32 + sr, sc);
    const int vb0 = (int)(uintptr_t)V_lds + v_rd_base(lane);
    bf16x8 vs0, vs1, ks0, ks1;
#define SBA_SLOAD(k0) do { vs0 = *reinterpret_cast<const bf16x8*>(&Vh[(size_t)((k0) + sr) * PN + sc]); vs1 = *reinterpret_cast<const bf16x8*>(&Vh[(size_t)((k0) + 32 + sr) * PN + sc]); \
    ks0 = *reinterpret_cast<const bf16x8*>(&Kh[(size_t)((k0) + sr) * PN + sc]); ks1 = *reinterpret_cast<const bf16x8*>(&Kh[(size_t)((k0) + 32 + sr) * PN + sc]); } while (0)
#define SBA_SWRITE(bo) do { asm volatile("s_waitcnt vmcnt(0)" ::: "memory"); *(bf16x8*)(V_lds + (bo) + vst0) = vs0; *(bf16x8*)(V_lds + (bo) + vst1) = vs1; const int kc = sc * 2; \
    *(bf16x8*)(K_lds + (bo) + SBA_KSWZ(sr, kc)) = ks0; *(bf16x8*)(K_lds + (bo) + SBA_KSWZ(32 + sr, kc)) = ks1; } while (0)
    const int NT = 4 * (qb + 1);
    const int qrel = wid * 32 + r32;
    SBA_SLOAD((NT - 1) * 64); SBA_SWRITE(0); __syncthreads();
    for (int i = 0; i < NT; ++i) {
        const int bo = (i & 1) * SHM_V;
        if (i + 1 < NT) SBA_SLOAD((NT - 2 - i) * 64);
        SBA_SBAR();
        const bool active = (i >= 4) || (64 * (3 - i) < 32 * wid + 31);
        if (active) {
            f32x16 p0, p1; bf16x8 pa0, pa1, pa2, pa3;
            qkt(p0, p1, K_lds + bo, qr, r32, hi);
            sig_part(p0, p1, (i < 4) && (64 * (3 - i) + 63 >= 32 * wid), 64 * (3 - i) - qrel, hi);
            finish(p0, p1, R, hi, pa0, pa1, pa2, pa3); SBA_SBAR();
            pv_d0(o, vb0 + bo, pa0, pa1, pa2, pa3);
        }
        SBA_SBAR();
        if (i + 1 < NT) SBA_SWRITE(SHM_V - bo);
        __syncthreads();
    }
    bf16* Ow = Ob + (size_t)(wid * 32) * PN;
#pragma unroll
    for (int r = 0; r < 16; ++r) { const int orow = crow(r, hi);
#pragma unroll
        for (int d0 = 0; d0 < 4; ++d0) if (!dry) Ow[(size_t)orow * PN + d0 * 32 + r32] = (bf16)f2bf(o[d0][r]); }
    __syncthreads();
#undef SBA_SLOAD
#undef SBA_SWRITE
}
}
__device__ __forceinline__ void sb_attn_pair(Frame& F, int item) {
    const int tid = opaque_tid();
    const int bh = item >> 2, p = item & 3, b = bh >> 3, h = bh & 7;
    const bf16* Kh = F.PROJ + (size_t)(b * T) * PN + OFF_SK + h * 128; const bf16* Vh = F.PROJ + (size_t)(b * T) * PN + OFF_SV + h * 128;
    bf16* Qh = F.PROJ + (size_t)(b * T) * PN + OFF_SQ + h * 128;
#pragma nounroll
    for (int u = 0; u < 2; ++u) { const int qb = u ? p : 7 - p; sba::unit(Qh + (size_t)(qb * 256) * PN, Kh, Vh, Qh + (size_t)(qb * 256) * PN, qb, (char*)F.ldsg, tid, F.dry); }
}

__device__ __forceinline__ Frame make_frame(const Args& args, LAS unsigned char* lds, unsigned char* ldsg) {
    Frame F; unsigned char* ws = args.ws; float* out = args.out;
    asm volatile("" : "+s"(ws), "+s"(out));
    F.lds = lds; F.ldsg = ldsg; F.tid = opaque_tid(); F.lane = F.tid & 63; F.wave = __builtin_amdgcn_readfirstlane(F.tid >> 6);
    F.G = gridDim.x; F.bid = blockIdx.x; F.out = out; F.ws = ws; F.dry = false;
    F.XN = (bf16*)(ws + WS_XN); F.XC = (bf16*)(ws + WS_XC); F.U = (bf16*)(ws + WS_U); F.KE = (bf16*)(ws + WS_KE); F.VT = (bf16*)(ws + WS_VT); F.PROJ = (bf16*)(ws + WS_PROJ);
    F.DECAY = (float*)(ws + WS_DECAY); F.SSQ = (float*)(ws + WS_SSQ);
    return F;
}
__global__ void __launch_bounds__(512, 2) trunk_fwd(Args args) {
    extern __shared__ __attribute__((aligned(16))) unsigned char lds_raw[];
    LAS unsigned char* const lds = (LAS unsigned char*)lds_raw;
    volatile LAS unsigned* MISC = (volatile LAS unsigned*)(lds + MISC_OFF);
    if (threadIdx.x < 32) MISC[threadIdx.x] = 0u;
    __syncthreads();
    const int lo = args.ph_lo, hi = args.ph_hi;
    XcdBarrier bar; bar.bar = (unsigned*)(args.ws + WS_CTL) + CW_BAR; bar.x = 0; bar.st = MISC + 8;
    if (hi - lo > 1) bar = xcd_barrier_post((unsigned*)(args.ws + WS_CTL) + CW_BAR, MISC + 8);
#ifndef PH_MASK
#define PH_MASK 0xfff
#endif
#define IN(k) (lo <= (k) && (k) < hi)
#define EN(k) ((PH_MASK >> (k)) & 1)
#define SEAM(k) do { if (IN(k) && IN((k) + 1)) { xcd_barrier(bar); if ((PROBE_MASK >> 12) & 1) xcd_barrier(bar); } } while (0)
#define PROBE_MASK 0
#ifndef PROBE_MASK
#define PROBE_MASK 0
#endif
#define FRAME() Frame F = make_frame(args, lds, lds_raw); F.dry = (PROBE_MASK != 0) && (rep == 0) && (args.ph_hi < (1 << 30))
#define REPS(k) _Pragma("unroll") for (int rep = ((PROBE_MASK >> (k)) & 1) ? 0 : 1; rep < 2; ++rep)
#define WL(F) ((F).ws + WS_W + (size_t)l * WL_STRIDE)

    if (IN(0)) REPS(11) { FRAME(); phase_convert(F, args); }
    SEAM(0);
    for (int l = 0; l < DEPTH; ++l) {
        const int p0 = 1 + l * NP;
        if (EN(0) && IN(p0 + 0)) REPS(0) { FRAME(); phase_rmsnorm(F, (l == 0) ? args.in[0] : (const float*)F.out, args.in[1] + (size_t)l * D, F.XN); }
        SEAM(p0 + 0);
        if (EN(1) && IN(p0 + 1)) REPS(1) { FRAME();
            pg8::Gemm g{D, D, D}; SchedProj S; S.base.init(F.XN, WL(F) + WL_IN, D, D, M, PN, F.G, F.bid);
            EpiProj E{F.PROJ, F.VT};
            pg8::gemm_phase<EpiProj, SchedProj, true, true>(F.lds, g, S, E);
        }
        SEAM(p0 + 1);
        if (EN(2) && IN(p0 + 2)) REPS(2) { FRAME(); phase_prep(F, args, l); }
        SEAM(p0 + 2);
        if (EN(3) && IN(p0 + 3)) REPS(3) { FRAME();
            pg8::Gemm g{D, 256, 256}; SchedLru S{(const char*)F.XC, (const char*)(WL(F) + WL_G), F.G, F.bid};
            EpiLru E{F.XC, F.PROJ + OFF_LX, PN, F.U, args.in[9] + (size_t)l * D, args.in[11] + (size_t)l * D, (const float*)(F.ws + WS_SPL)};
            pg8::gemm_phase<EpiLru, SchedLru, true, true>(F.lds, g, S, E);
            for (int it = F.bid; it < 256; it += F.G) gla::pass1_item(F, it);
        }
        SEAM(p0 + 3);
        if (EN(4) && IN(p0 + 4)) REPS(4) {
            { REPS(13) { FRAME(); for (int it = F.bid; it < 256; it += F.G) gla::pass2_item(F, args.in[5] + (size_t)l * 256, it); } }
            __syncthreads();
            { REPS(14) { FRAME(); for (int it = F.bid; it < 256; it += F.G) lru_scan_item(F, it); } }
            __syncthreads();
            { REPS(15) { FRAME(); for (int it = F.bid; it < 256; it += F.G) sb_attn_pair(F, it); } }
        }
        SEAM(p0 + 4);
        if (EN(6) && IN(p0 + 6)) REPS(6) { FRAME();
            pg8::Gemm g{PN, D, D}; SchedBranch S{(const char*)F.PROJ, (const char*)(WL(F) + WL_BR), F.G, F.bid};
            EpiBranch E{F.PROJ, args.in[18] + (size_t)l * 3072, F.U};
            pg8::gemm_phase<EpiBranch, SchedBranch, true, true>(F.lds, g, S, E);
        }
        SEAM(p0 + 6);
        if (EN(7) && IN(p0 + 7)) REPS(7) { FRAME();
            pg8::Gemm g{D, D, D}; pg8::SchedStd S; S.init(F.U, WL(F) + WL_OUT, D, D, M, D, F.G, F.bid);
            pg8::EpiResF32 E{(l == 0) ? args.in[0] : (const float*)F.out, F.out, D, F.dry};
            pg8::gemm_phase<pg8::EpiResF32, pg8::SchedStd, false, true>(F.lds, g, S, E);
        }
        SEAM(p0 + 7);
        if (EN(8) && IN(p0 + 8)) REPS(8) { FRAME(); phase_rmsnorm(F, F.out, args.in[20] + (size_t)l * D, F.XN); }
        SEAM(p0 + 8);
        if (EN(9) && IN(p0 + 9)) REPS(9) { FRAME();
            pg8::Gemm g{D, D, D}; pg8::SchedStd S; S.init(F.XN, WL(F) + WL_UP, D, D, M, FF, F.G, F.bid);
            pg8::EpiBf16<1> E{F.PROJ, FF};
            pg8::gemm_phase<pg8::EpiBf16<1>, pg8::SchedStd, true, true>(F.lds, g, S, E);
        }
        SEAM(p0 + 9);
        if (EN(10) && IN(p0 + 10)) REPS(10) { FRAME();
            pg8::Gemm g{FF, FF, FF}; pg8::SchedStd S; S.init(F.PROJ, WL(F) + WL_DN, FF, FF, M, D, F.G, F.bid);
            pg8::EpiResF32 E{F.out, F.out, D, F.dry};
            pg8::gemm_phase<pg8::EpiResF32, pg8::SchedStd, false, true>(F.lds, g, S, E);
        }
        SEAM(p0 + 10);
    }
#undef IN
#undef SEAM
}

extern "C" void kernel_launch(void* const* d_in, const int* in_sizes, int n_in, void* d_out, int out_size, void* d_ws, size_t ws_size, hipStream_t stream) {
    static int grid = 0;
    if (grid == 0) {
        if (n_in != 23 || out_size != M * D || ws_size < WS_END) { fprintf(stderr, "kernel_launch: unexpected shapes / workspace (n_in %d, out %d, ws %zu, need %zu)\n", n_in, out_size, ws_size, (size_t)WS_END); grid = -1; return; }
        int dev = 0, cus = 0, per_cu = 0;
        if (hipGetDevice(&dev) != hipSuccess || hipDeviceGetAttribute(&cus, hipDeviceAttributeMultiprocessorCount, dev) != hipSuccess) { grid = -1; return; }
        if (hipFuncSetAttribute((const void*)trunk_fwd, hipFuncAttributeMaxDynamicSharedMemorySize, LDS_BYTES) != hipSuccess) { grid = -1; return; }
        if (hipOccupancyMaxActiveBlocksPerMultiprocessor(&per_cu, (const void*)trunk_fwd, 512, LDS_BYTES) != hipSuccess || per_cu < 1) fprintf(stderr, "kernel_launch: occupancy query says %d\n", per_cu);
        (void)hipGetLastError();
        grid = cus;
    }
    if (grid < 0) return;
    (void)hipMemsetAsync((char*)d_ws + WS_CTL, 0, CTL_ZERO_BYTES, stream);
    Args a{};
    for (int i = 0; i < 23; ++i) a.in[i] = (const float*)d_in[i];
    a.out = (float*)d_out; a.ws = (unsigned char*)d_ws;
#if MK_ONE_LAUNCH
    a.ph_lo = 0; a.ph_hi = NPH;
    hipLaunchKernelGGL(trunk_fwd, dim3(grid), dim3(512), LDS_BYTES, stream, a);
#else
    for (int p = 0; p < NPH; ++p) { a.ph_lo = p; a.ph_hi = p + 1; hipLaunchKernelGGL(trunk_fwd, dim3(grid), dim3(512), LDS_BYTES, stream, a); }
#endif
}
```

```cpp
#include <hip/hip_runtime.h>
#include <cstdio>

#ifndef MK_ONE_LAUNCH
#define MK_ONE_LAUNCH 1
#endif

#define LAS __attribute__((address_space(3)))
#define GAS __attribute__((address_space(1)))
typedef unsigned short bf16;
typedef unsigned v4u __attribute__((ext_vector_type(4)));
typedef unsigned v2u __attribute__((ext_vector_type(2)));
typedef float f32x4 __attribute__((ext_vector_type(4)));
typedef float f32x2 __attribute__((ext_vector_type(2)));
typedef short bf16x8 __attribute__((ext_vector_type(8)));

constexpr int D = 1024, BATCH = 8, T = 2048, M = BATCH * T, DEPTH = 4, FF = 4096;
constexpr int SRC_COLS = 11280;
constexpr int PN = 11264;
constexpr int OFF_GQ = 0, OFF_GK = 512, OFF_GV = 1024, OFF_GG = 2048, OFF_LX = 3072, OFF_LG = 4096, OFF_SQ = 5120, OFF_SK = 6144, OFF_SV = 7168, OFF_GATE = 8192;
constexpr int SRC_GDOWN = 3072;
constexpr float EPS = 1e-6f;
constexpr int NP = 11;
constexpr int NPH = 1 + DEPTH * NP;

constexpr size_t MiB = 1u << 20;
constexpr size_t WS_CTL = 0, CTL_ZERO_BYTES = 64 * 1024;
constexpr size_t WS_DECAY = 1 * MiB;
constexpr size_t WS_WDT = 1536 * 1024;
constexpr size_t WS_SSQ = 2 * MiB;
constexpr size_t WS_PARTA = 2 * MiB;
constexpr size_t WS_PARTB = 3 * MiB;
constexpr size_t WS_SPL = 512 * 1024;
constexpr size_t WS_W = 4 * MiB;
constexpr size_t WL_IN = 0, WL_BR = 22 * MiB, WL_OUT = 28 * MiB, WL_UP = 30 * MiB, WL_DN = 38 * MiB, WL_G = 46 * MiB, WL_STRIDE = 47 * MiB;
constexpr size_t WS_XN = 192 * MiB;
constexpr size_t WS_XC = 224 * MiB;
constexpr size_t WS_U = 256 * MiB;
constexpr size_t WS_KE = 288 * MiB;
constexpr size_t WS_VT = 304 * MiB;
constexpr size_t WS_PROJ = 336 * MiB;
constexpr size_t WS_END = WS_PROJ + (size_t)M * PN * 2;
static_assert(WS_W + DEPTH * WL_STRIDE <= WS_XN, "ws map");
constexpr int CW_BAR = 1024;

constexpr int RING_BYTES = 131072;
constexpr int MISC_OFF = 147456 - 256;
constexpr int LDS_BYTES = 147456;

template <class Tp> __device__ __forceinline__ Tp* as_global(Tp* p) {
#if defined(__HIP_DEVICE_COMPILE__)
    __builtin_assume(!__builtin_amdgcn_is_shared((const __attribute__((address_space(0))) void*)p) && !__builtin_amdgcn_is_private((const __attribute__((address_space(0))) void*)p));
#endif
    return p; }
__device__ __forceinline__ float bf2f(unsigned b) { return __uint_as_float(b << 16); }
__device__ __forceinline__ unsigned f2bf(float f) { unsigned u = __float_as_uint(f); return (u + 0x7fffu + ((u >> 16) & 1u)) >> 16; }
__device__ __forceinline__ unsigned pk2(float lo, float hi) { return f2bf(lo) | (f2bf(hi) << 16); }
__device__ __forceinline__ float blo(unsigned w) { return __uint_as_float(w << 16); }
__device__ __forceinline__ float bhi(unsigned w) { return __uint_as_float(w & 0xffff0000u); }
__device__ __forceinline__ float shx(float v, int o, int lane) { return __int_as_float(__builtin_amdgcn_ds_bpermute((lane ^ o) << 2, __float_as_int(v))); }
__device__ __forceinline__ float wave_sum(float v, int lane) {
#pragma unroll
    for (int o = 1; o < 64; o <<= 1) v += shx(v, o, lane);
    return v;
}
__device__ __forceinline__ float sigmoidf_(float x) { return 1.f / (1.f + __expf(-x)); }
__device__ __forceinline__ float logsigmoidf_(float x) { return fminf(x, 0.f) - log1pf(__expf(-fabsf(x))); }
#define LDS_WAIT() asm volatile("s_waitcnt lgkmcnt(0)" ::: "memory")
__device__ __forceinline__ int opaque_tid() { int t = threadIdx.x; asm volatile("" : "+v"(t)); return t; }

#define XB_TMO      128
#define XB_XCNT(j)  (256  + 64 * (j))
#define XB_XSUB(j)  (1280 + 64 * (j))
#define XB_XGEN(j)  (2304 + 64 * (j))
#define XB_TOP      3328
#define XB_TOPGEN   3392
#define XCD_BAR_WORDS 3456
#define XB_SPIN_CAP (1u << 18)
__device__ __forceinline__ unsigned xb_ld(unsigned* p)              { return __hip_atomic_load(p, __ATOMIC_RELAXED, __HIP_MEMORY_SCOPE_AGENT); }
__device__ __forceinline__ unsigned xb_add(unsigned* p, unsigned v) { return __hip_atomic_fetch_add(p, v, __ATOMIC_RELAXED, __HIP_MEMORY_SCOPE_AGENT); }
__device__ __forceinline__ unsigned xb_xcc_id() { return (unsigned)__builtin_amdgcn_s_getreg((3 << 11) | 20) & 0xFu; }
#define XB_SPIN(cond, bar) do { unsigned _sp = 0; while (cond) { __builtin_amdgcn_s_sleep(1); \
    if ((++_sp & 255u) == 0u) { if (xb_ld(&(bar)[XB_TMO])) break; if (_sp > XB_SPIN_CAP) { atomicAdd(&(bar)[XB_TMO], 1u); break; } } } } while (0)
struct XcdBarrier { unsigned* bar; unsigned x; volatile LAS unsigned* st; };
__device__ __forceinline__ XcdBarrier xcd_barrier_post(unsigned* bar, volatile LAS unsigned* st) {
    XcdBarrier b; b.bar = bar; b.x = xb_xcc_id(); b.st = st;
    if (threadIdx.x == 0) (void)xb_add(&bar[XB_XCNT(b.x)], 1u);
    return b;
}
__device__ __forceinline__ void xcd_barrier_complete(unsigned* bar, unsigned x, unsigned& nloc, unsigned& nx) {
    const unsigned G = gridDim.x * gridDim.y * gridDim.z;
    unsigned sum, cnt, mine, sp = 0u;
    for (;;) {
        sum = 0u; cnt = 0u; mine = 0u;
#pragma unroll
        for (unsigned j = 0; j < 16; ++j) { const unsigned c = xb_ld(&bar[XB_XCNT(j)]); sum += c; cnt += (c > 0u) ? 1u : 0u; mine = (j == x) ? c : mine; }
        if (sum == G) break;
        __builtin_amdgcn_s_sleep(1);
        if ((++sp & 255u) == 0u) { if (xb_ld(&bar[XB_TMO])) break; if (sp > XB_SPIN_CAP) { atomicAdd(&bar[XB_TMO], 1u); break; } }
    }
    nloc = mine > 0u ? mine : 1u; nx = cnt > 0u ? cnt : 1u;
}
__device__ __forceinline__ void xcd_barrier(const XcdBarrier& b) {
    asm volatile("s_waitcnt vmcnt(0)" ::: "memory");
    __syncthreads();
    if (threadIdx.x == 0) {
        unsigned* bar = b.bar; asm volatile("" : "+s"(bar));
        __builtin_amdgcn_s_waitcnt(0);
        unsigned nloc = b.st[0], nx = b.st[1];
        if (nloc == 0u) { xcd_barrier_complete(bar, b.x, nloc, nx); b.st[0] = nloc; b.st[1] = nx; }
        const unsigned old = xb_add(&bar[XB_XSUB(b.x)], 1u);
        const unsigned gen = old / nloc;
        if (old + 1u == (gen + 1u) * nloc) {
            __builtin_amdgcn_fence(__ATOMIC_RELEASE, "agent");
            asm volatile("s_waitcnt vmcnt(0)" ::: "memory");
            const unsigned og = xb_add(&bar[XB_TOP], 1u);
            const unsigned tg = og / nx;
            if (og + 1u == (tg + 1u) * nx) xb_add(&bar[XB_TOPGEN], 1u);
            else XB_SPIN(xb_ld(&bar[XB_TOPGEN]) == tg, bar);
            __builtin_amdgcn_fence(__ATOMIC_ACQUIRE, "agent");
            xb_add(&bar[XB_XGEN(b.x)], 1u);
            asm volatile("s_waitcnt vmcnt(0)" ::: "memory");
        } else {
            XB_SPIN(xb_ld(&bar[XB_XGEN(b.x)]) == gen, bar);
            __builtin_amdgcn_fence(__ATOMIC_ACQUIRE, "agent");
            asm volatile("s_waitcnt vmcnt(0)" ::: "memory");
        }
    }
    __syncthreads();
}

namespace pg8 {
constexpr int BM = 256, BK = 64, HALF = 128, HTB = HALF * BK * 2, STAGE_BYTES = 8 * HTB, NXCD = 8, WGM = 8;
__host__ __device__ __forceinline__ int lds_byte(int r, int c) { const int st = (r >> 4) * 2 + (c >> 5), rr = r & 15, cc = c & 31, ob = rr * 64 + cc * 2; return st * 1024 + (ob ^ (((ob >> 9) & 1) << 5)); }
__host__ __device__ __forceinline__ void stage_rc(int b, int& R, int& C) { const int st = b / 1024, sb = b % 1024, swz = sb ^ (((sb >> 9) & 1) << 5); R = (st >> 1) * 16 + swz / 64; C = (st & 1) * 32 + (swz % 64) / 2; }
__host__ __device__ __forceinline__ int perm32(int rho) { const int n = rho >> 4, i = rho & 15; return 8 * (i >> 2) + 4 * n + (i & 3); }
struct Unit { int pm, pn, aux; };
struct Gemm { int lda, ldb, K; };
__device__ __forceinline__ unsigned cvt_pk_bf16(float lo, float hi) { unsigned r; asm volatile("v_cvt_pk_bf16_f32 %0, %1, %2" : "=v"(r) : "v"(lo), "v"(hi)); return r; }

struct SchedStd {
    const char* A; const char* B; size_t tstepA, tstepB; int nM, nN, nwg, G, c;
    __device__ __forceinline__ void init(const void* A_, const void* B_, int lda, int ldb, int Mr, int Nc, int G_, int c_) { A = (const char*)A_; B = (const char*)B_; tstepA = (size_t)BM * lda * 2; tstepB = (size_t)BM * ldb * 2; nM = Mr / BM; nN = Nc / BM; nwg = nM * nN; G = G_; c = c_; }
    __device__ __forceinline__ bool next(int i, Unit& u) const {
        const long L = (long)i * G + c; if (L >= nwg) return false;
        int wgid = (int)L; { const int q = nwg / NXCD, r = nwg % NXCD, xcd = wgid % NXCD, off = wgid / NXCD; wgid = (xcd < r ? xcd * (q + 1) : r * (q + 1) + (xcd - r) * q) + off; }
        const int nig = WGM * nN, gid = wgid / nig, fm = gid * WGM, gsz = (nM - fm) < WGM ? (nM - fm) : WGM;
        u.pm = fm + ((wgid % nig) % gsz); u.pn = (wgid % nig) / gsz; u.aux = 0; return true;
    }
    __device__ __forceinline__ const char* abase(const Unit& u) const { return A + (size_t)u.pm * tstepA; }
    __device__ __forceinline__ const char* bbase(const Unit& u) const { return B + (size_t)u.pn * tstepB; }
};

template <class Epi, class Sched, bool ALIGN_EPI, bool SP2>
__device__ __forceinline__ void gemm_phase(LAS unsigned char* lds, const Gemm g, const Sched& S, const Epi& E) {
    const int tid = opaque_tid(), wid = __builtin_amdgcn_readfirstlane(tid >> 6), lane = tid & 63, wr = wid >> 2, wc = wid & 3, fr = lane & 15, fq = lane >> 4;
    const int K = g.K, nt = K / BK;
    unsigned voffA[2], voffB[2];
#pragma unroll
    for (int i = 0; i < 2; ++i) { int R, C; stage_rc(tid * 16 + i * 8192, R, C); const int Rb = Epi::PERM ? ((R & ~31) + perm32(R & 31)) : R;
        voffA[i] = (unsigned)(R * g.lda + C) * 2u; voffB[i] = (unsigned)(Rb * g.ldb + C) * 2u; }
    const size_t kstep = (size_t)(BK * 2);
    const size_t hstepA = (size_t)HALF * g.lda * 2, hstepB = (size_t)HALF * g.ldb * 2;
    const unsigned ldsw = (unsigned)wid * 1024u;
    const int aoff = lds_byte(wr * 64 + fr, fq * 8), boff = lds_byte(wc * 32 + fr, fq * 8);
#define PG8_SA(b, h) (((b) * 2 + (h)) * HTB)
#define PG8_SB(b, h) ((4 + (b) * 2 + (h)) * HTB)
#define PG8_STAGE(bufoff, gbase, voff) do { _Pragma("unroll") for (int _i = 0; _i < 2; ++_i) \
        __builtin_amdgcn_global_load_lds((const unsigned*)((const char*)(gbase) + (voff)[_i]), (LAS unsigned*)(lds + (bufoff) + ldsw + _i * 8192), 16, 0, 0); } while (0)
#define PG8_LDA(dst, b, h) do { _Pragma("unroll") for (int m = 0; m < 4; ++m) _Pragma("unroll") for (int k = 0; k < 2; ++k) dst[m][k] = *(const LAS bf16x8*)(lds + PG8_SA(b, h) + aoff + m * 2048 + k * 1024); } while (0)
#define PG8_LDB(dst, b, h) do { _Pragma("unroll") for (int n = 0; n < 2; ++n) _Pragma("unroll") for (int k = 0; k < 2; ++k) dst[n][k] = *(const LAS bf16x8*)(lds + PG8_SB(b, h) + boff + n * 2048 + k * 1024); } while (0)
#define PG8_MMA(ai, bj, At, Bt) do { __builtin_amdgcn_s_setprio(1); _Pragma("unroll") for (int m = 0; m < 4; ++m) _Pragma("unroll") for (int n = 0; n < 2; ++n) _Pragma("unroll") for (int k = 0; k < 2; ++k) \
        acc[ai][bj][m][n] = __builtin_amdgcn_mfma_f32_16x16x32_bf16(Bt[n][k], At[m][k], acc[ai][bj][m][n], 0, 0, 0); __builtin_amdgcn_s_setprio(0); } while (0)
#define PG8_WAIT_V(n) asm volatile("s_waitcnt vmcnt(" #n ")" ::: "memory")
#define PG8_WAIT_L(n) asm volatile("s_waitcnt lgkmcnt(" #n ")" ::: "memory")
#define PG8_BAR __builtin_amdgcn_s_barrier()
#define PG8_SCHED __builtin_amdgcn_sched_barrier(0)
    Unit cur, nxt; int ui = 0;
    if (!S.next(0, cur)) return;
    f32x4 acc[2][2][4][2];
#pragma unroll
    for (int a = 0; a < 2; ++a)
#pragma unroll
        for (int b = 0; b < 2; ++b)
#pragma unroll
            for (int m = 0; m < 4; ++m)
#pragma unroll
                for (int n = 0; n < 2; ++n) acc[a][b][m][n] = (f32x4){0.f, 0.f, 0.f, 0.f};
    bf16x8 At[4][2], B0[2][2], B1[2][2];
    const char* cA = S.abase(cur); const char* cB = S.bbase(cur);
    LAS float* const xrs = (LAS float*)(lds + 131072 + 4096);
    f32x4 rsreg = {0.f, 0.f, 0.f, 0.f};
    if constexpr (Epi::ROW_RS) { if (tid < 256) { rsreg = *(const f32x4*)(E.part + (size_t)(cur.pm * BM + tid) * 4); xrs[tid] = __builtin_amdgcn_rsqf(((rsreg.x + rsreg.y) + (rsreg.z + rsreg.w)) * (1.f / 1024.f) + 1e-6f); } }
    if constexpr (SP2) {
        PG8_STAGE(PG8_SB(0, 0), cB, voffB); PG8_STAGE(PG8_SB(0, 1), cB + hstepB, voffB); PG8_STAGE(PG8_SA(0, 0), cA, voffA); PG8_STAGE(PG8_SA(0, 1), cA + hstepA, voffA);
        if (wr == 1) PG8_BAR;
        PG8_WAIT_V(2); PG8_BAR;
        PG8_STAGE(PG8_SB(1, 0), cB + kstep, voffB); PG8_STAGE(PG8_SA(1, 0), cA + kstep, voffA); PG8_STAGE(PG8_SB(1, 1), cB + hstepB + kstep, voffB);
        PG8_WAIT_V(6); PG8_BAR;
    } else {
        PG8_STAGE(PG8_SB(0, 0), cB, voffB); PG8_STAGE(PG8_SA(0, 0), cA, voffA); PG8_STAGE(PG8_SB(0, 1), cB + hstepB, voffB); PG8_STAGE(PG8_SA(0, 1), cA + hstepA, voffA);
        if (wr == 1) PG8_BAR;
        PG8_WAIT_V(4); PG8_BAR;
        PG8_STAGE(PG8_SB(1, 0), cB + kstep, voffB); PG8_STAGE(PG8_SA(1, 0), cA + kstep, voffA); PG8_STAGE(PG8_SB(1, 1), cB + hstepB + kstep, voffB);
        PG8_WAIT_V(6); PG8_BAR;
    }
    for (;;) {
        const bool has_next = S.next(ui + 1, nxt);
        const char* nA = has_next ? S.abase(nxt) : cA; const char* nB = has_next ? S.bbase(nxt) : cB;
        if constexpr (Epi::ROW_RS) { if (has_next && tid < 256) rsreg = *(const f32x4*)(E.part + (size_t)(nxt.pm * BM + tid) * 4); }
#pragma nounroll
        for (int t = 0; t < nt; t += 2) {
            const bool last = (t == nt - 2);
            const char* a1 = cA + (size_t)(t + 1) * kstep;
            const char* a2 = last ? nA : cA + (size_t)(t + 2) * kstep; const char* b2 = last ? nB : cB + (size_t)(t + 2) * kstep;
            const char* a3 = a2 + kstep; const char* b3 = b2 + kstep;
            if constexpr (SP2) {
            PG8_LDB(B0, 0, 0); PG8_LDB(B1, 0, 1); PG8_SCHED; PG8_LDA(At, 0, 0); PG8_STAGE(PG8_SA(1, 1), a1 + hstepA, voffA);
            PG8_WAIT_V(8); PG8_WAIT_L(0); PG8_BAR; PG8_MMA(0, 0, At, B0); PG8_MMA(0, 1, At, B1); PG8_BAR; PG8_SCHED;
            PG8_LDA(At, 0, 1); PG8_STAGE(PG8_SB(0, 0), b2, voffB); PG8_STAGE(PG8_SB(0, 1), b2 + hstepB, voffB); PG8_STAGE(PG8_SA(0, 0), a2, voffA);
            PG8_WAIT_V(8); PG8_WAIT_L(0); PG8_BAR; PG8_MMA(1, 0, At, B0); PG8_MMA(1, 1, At, B1); PG8_BAR; PG8_SCHED;
            PG8_LDB(B0, 1, 0); PG8_LDB(B1, 1, 1); PG8_SCHED; PG8_LDA(At, 1, 0); PG8_STAGE(PG8_SA(0, 1), a2 + hstepA, voffA);
            PG8_WAIT_V(8); PG8_WAIT_L(0); PG8_BAR; PG8_MMA(0, 0, At, B0); PG8_MMA(0, 1, At, B1); PG8_BAR; PG8_SCHED;
            PG8_LDA(At, 1, 1); PG8_STAGE(PG8_SB(1, 0), b3, voffB); PG8_STAGE(PG8_SB(1, 1), b3 + hstepB, voffB); PG8_STAGE(PG8_SA(1, 0), a3, voffA);
            PG8_WAIT_V(8); PG8_WAIT_L(0); PG8_BAR; PG8_MMA(1, 0, At, B0); PG8_MMA(1, 1, At, B1); PG8_BAR; PG8_SCHED;
            } else {
            PG8_LDB(B0, 0, 0); PG8_SCHED; PG8_LDA(At, 0, 0); PG8_STAGE(PG8_SA(1, 1), a1 + hstepA, voffA);
            PG8_WAIT_L(8); PG8_BAR; PG8_WAIT_L(0); PG8_MMA(0, 0, At, B0); PG8_BAR; PG8_SCHED;
            PG8_LDB(B1, 0, 1); PG8_STAGE(PG8_SB(0, 0), b2, voffB);
            PG8_BAR; PG8_WAIT_L(0); PG8_MMA(0, 1, At, B1); PG8_BAR;
            PG8_LDA(At, 0, 1); PG8_STAGE(PG8_SA(0, 0), a2, voffA);
            PG8_BAR; PG8_WAIT_L(0); PG8_MMA(1, 0, At, B0); PG8_BAR; PG8_SCHED;
            PG8_STAGE(PG8_SB(0, 1), b2 + hstepB, voffB);
            PG8_WAIT_V(6); PG8_BAR; PG8_MMA(1, 1, At, B1); PG8_BAR;
            PG8_LDB(B0, 1, 0); PG8_SCHED; PG8_LDA(At, 1, 0); PG8_STAGE(PG8_SA(0, 1), a2 + hstepA, voffA);
            PG8_WAIT_L(8); PG8_BAR; PG8_WAIT_L(0); PG8_MMA(0, 0, At, B0); PG8_BAR; PG8_SCHED;
            PG8_LDB(B1, 1, 1); PG8_STAGE(PG8_SB(1, 0), b3, voffB);
            PG8_BAR; PG8_WAIT_L(0); PG8_MMA(0, 1, At, B1); PG8_BAR;
            PG8_LDA(At, 1, 1); PG8_STAGE(PG8_SA(1, 0), a3, voffA);
            PG8_BAR; PG8_WAIT_L(0); PG8_MMA(1, 0, At, B0); PG8_BAR; PG8_SCHED;
            PG8_STAGE(PG8_SB(1, 1), b3 + hstepB, voffB);
            PG8_WAIT_V(6); PG8_BAR; PG8_MMA(1, 1, At, B1); PG8_BAR;
            }
        }
        if constexpr (Epi::ROW_RS) { if (has_next && tid < 256) xrs[((ui + 1) & 1) * 256 + tid] = __builtin_amdgcn_rsqf(((rsreg.x + rsreg.y) + (rsreg.z + rsreg.w)) * (1.f / 1024.f) + 1e-6f); }
        if constexpr (ALIGN_EPI) { if (wr == 0) PG8_BAR; }
        const bool zero = E(acc, cur, wr, wc, fr, fq, xrs + (ui & 1) * 256);
        if (!has_next) break;
        if (zero) {
#pragma unroll
        for (int a = 0; a < 2; ++a)
#pragma unroll
            for (int b = 0; b < 2; ++b)
#pragma unroll
                for (int m = 0; m < 4; ++m)
#pragma unroll
                    for (int n = 0; n < 2; ++n) acc[a][b][m][n] = (f32x4){0.f, 0.f, 0.f, 0.f};
        }
        cur = nxt; cA = nA; cB = nB; ++ui;
        if constexpr (ALIGN_EPI) { if (wr == 1) PG8_BAR; }
    }
    PG8_WAIT_V(0);
    if constexpr (!ALIGN_EPI) { if (wr == 0) PG8_BAR; }
    PG8_BAR;
#undef PG8_SA
#undef PG8_SB
#undef PG8_STAGE
#undef PG8_LDA
#undef PG8_LDB
#undef PG8_MMA
#undef PG8_WAIT_V
#undef PG8_WAIT_L
#undef PG8_BAR
#undef PG8_SCHED
}

__device__ __forceinline__ float row_rs(const float* part, int row) {
    const f32x4 a = *(const f32x4*)(part + (size_t)row * 4);
    return __builtin_amdgcn_rsqf(((a.x + a.y) + (a.z + a.w)) * (1.f / 1024.f) + 1e-6f);
}
template <int ACT> struct EpiBf16 {
    static constexpr bool PERM = true, ROW_RS = true;
    bf16* O; int ldc; const float* part;
    __device__ __forceinline__ bool operator()(f32x4 (&acc)[2][2][4][2], const Unit& u, int wr, int wc, int fr, int fq, const LAS float* xrs) const {
        const int row0 = u.pm * BM + wr * 64 + fr, col0 = u.pn * BM + wc * 32 + 8 * fq;
        float rsv[8];
#pragma unroll
        for (int i = 0; i < 8; ++i) rsv[i] = xrs[wr * 64 + fr + (i >> 2) * HALF + (i & 3) * 16];
#pragma unroll
        for (int ai = 0; ai < 2; ++ai)
#pragma unroll
            for (int m = 0; m < 4; ++m) { bf16* rowp = O + (size_t)(row0 + ai * HALF + m * 16) * ldc + col0; const float rs = rsv[ai * 4 + m];
#pragma unroll
                for (int bj = 0; bj < 2; ++bj) { f32x4 v0 = acc[ai][bj][m][0] * rs, v1 = acc[ai][bj][m][1] * rs;
                    if (ACT == 1) {
#pragma unroll
                        for (int j = 0; j < 4; ++j) { const float a = fmaxf(v0[j], 0.f), b = fmaxf(v1[j], 0.f); v0[j] = a * a; v1[j] = b * b; } }
                    v4u w; w.x = cvt_pk_bf16(v0[0], v0[1]); w.y = cvt_pk_bf16(v0[2], v0[3]); w.z = cvt_pk_bf16(v1[0], v1[1]); w.w = cvt_pk_bf16(v1[2], v1[3]);
                    *(v4u*)(rowp + bj * HALF) = w; } }
        return true;
    }
};
struct EpiResF32 {
    static constexpr bool PERM = false, ROW_RS = false;
    const float* base; float* out; int ldc; bool dry; bf16* xb; LAS float* xs;
    __device__ __forceinline__ bool operator()(f32x4 (&acc)[2][2][4][2], const Unit& u, int wr, int wc, int fr, int fq, const LAS float* xrs) const {
        const int row0 = u.pm * BM + wr * 64 + fr, col0 = u.pn * BM + wc * 32 + 4 * fq;
        f32x4 bs[2][4];
#define RES_LOAD(slot, gi) do { const size_t off_ = (size_t)(row0 + ((gi) >> 2) * HALF + ((gi) & 3) * 16) * ldc + col0; \
        bs[slot][0] = *(const f32x4*)(base + off_); bs[slot][1] = *(const f32x4*)(base + off_ + 16); bs[slot][2] = *(const f32x4*)(base + off_ + HALF); bs[slot][3] = *(const f32x4*)(base + off_ + HALF + 16); } while (0)
        RES_LOAD(0, 0);
#pragma unroll
        for (int gi = 0; gi < 8; ++gi) { const int ai = gi >> 2, m = gi & 3;
            if (gi < 7) RES_LOAD((gi + 1) & 1, gi + 1);
            const int row = row0 + ai * HALF + m * 16; const size_t off = (size_t)row * ldc + col0; float ss = 0.f;
#pragma unroll
            for (int bj = 0; bj < 2; ++bj)
#pragma unroll
                for (int n = 0; n < 2; ++n) { const f32x4 v = bs[gi & 1][bj * 2 + n] + acc[ai][bj][m][n];
                    ss += (v.x * v.x + v.y * v.y) + (v.z * v.z + v.w * v.w);
                    if (!dry) { *(f32x4*)(out + off + bj * HALF + n * 16) = v; v2u w; w.x = cvt_pk_bf16(v.x, v.y); w.y = cvt_pk_bf16(v.z, v.w); *(v2u*)(xb + off + bj * HALF + n * 16) = w; } }
            ss += __shfl_xor(ss, 16); ss += __shfl_xor(ss, 32);
            if (fq == 0) xs[wc * 256 + (row - u.pm * BM)] = ss; }
#undef RES_LOAD
        return true;
    }
};
}

struct Args { const float* in[23]; float* out; unsigned char* ws; int ph_lo, ph_hi; };

struct Frame {
    LAS unsigned char* lds; unsigned char* ldsg;
    int tid, lane, wave, G, bid; bool dry;
    float* out; unsigned char* ws;
    bf16 *XN, *XC, *U, *KE, *VT, *PROJ; float *DECAY, *SSQ;
};

__device__ __forceinline__ void transpose_item(const float* W, int ldw, int nblk, bf16* WT, int K, int row_off, LAS float* scr, int item, int lane, const float* gk = nullptr) {
    const int kb = item / nblk, nb = item % nblk, k0 = 64 * kb, n0 = 32 * nb;
#pragma unroll 8
    for (int i = 0; i < 32; ++i) { const int kk = 2 * i + (lane >> 5); scr[kk * 33 + (lane & 31)] = W[(size_t)(k0 + kk) * ldw + n0 + (lane & 31)] * (gk ? gk[k0 + kk] : 1.0f); }
    LDS_WAIT(); asm volatile("" ::: "memory");
    const int c = lane & 7;
#pragma unroll
    for (int j = 0; j < 4; ++j) { const int n = (lane >> 3) + 8 * j; const LAS float* s = scr + (8 * c) * 33 + n;
        v4u o; o.x = pk2(s[0 * 33], s[1 * 33]); o.y = pk2(s[2 * 33], s[3 * 33]); o.z = pk2(s[4 * 33], s[5 * 33]); o.w = pk2(s[6 * 33], s[7 * 33]);
        *(v4u*)(WT + (size_t)(row_off + n0 + n) * K + k0 + 8 * c) = o; }
    LDS_WAIT(); asm volatile("" ::: "memory");
}
__device__ __forceinline__ void phase_convert(Frame& F, const Args& A) {
    F.tid = opaque_tid(); F.lane = F.tid & 63;
    { bf16* wdt = (bf16*)(F.ws + WS_WDT);
      for (int idx = F.bid * 512 + F.tid; idx < DEPTH * 16 * D; idx += F.G * 512) { const int l = idx >> 14, n = (idx >> 10) & 15, k = idx & 1023;
          wdt[idx] = (bf16)f2bf(as_global(A.in[2])[((size_t)l * D + k) * SRC_COLS + SRC_GDOWN + n] * as_global(A.in[1])[(size_t)l * D + k]); } }
    LAS float* scr = (LAS float*)(F.lds + F.wave * 16384);
    const int gw = F.bid * 8 + F.wave, NGW = F.G * 8;
    constexpr int PER_L = 1536 + 4096 + 1536 + 512 + 2048 + 2048 + 256;
    for (int it = gw; it < DEPTH * PER_L; it += NGW) {
        const int l = it / PER_L; int r = it % PER_L;
        unsigned char* wl = F.ws + WS_W + (size_t)l * WL_STRIDE;
        const float* win = as_global(A.in[2]) + (size_t)l * D * SRC_COLS;
        if (r < 1536) { transpose_item(win, SRC_COLS, 96, (bf16*)(wl + WL_IN), D, 0, scr, r, F.lane, as_global(A.in[1]) + (size_t)l * D); continue; } r -= 1536;
        if (r < 4096) { transpose_item(win + 3088, SRC_COLS, 256, (bf16*)(wl + WL_IN), D, 3072, scr, r, F.lane, as_global(A.in[1]) + (size_t)l * D); continue; } r -= 4096;
        if (r < 1536) { const int br = r / 512; const float* wb = br == 0 ? as_global(A.in[15]) : (br == 1 ? as_global(A.in[16]) : as_global(A.in[17])); transpose_item(wb + (size_t)l * D * D, D, 32, (bf16*)(wl + WL_BR), D, br * 1024, scr, r % 512, F.lane); continue; } r -= 1536;
        if (r < 512) { transpose_item(as_global(A.in[19]) + (size_t)l * D * D, D, 32, (bf16*)(wl + WL_OUT), D, 0, scr, r, F.lane); continue; } r -= 512;
        if (r < 2048) { transpose_item(as_global(A.in[21]) + (size_t)l * D * FF, FF, 128, (bf16*)(wl + WL_UP), D, 0, scr, r, F.lane, as_global(A.in[20]) + (size_t)l * D); continue; } r -= 2048;
        if (r < 2048) { transpose_item(as_global(A.in[22]) + (size_t)l * D * FF, D, 32, (bf16*)(wl + WL_DN), FF, 0, scr, r, F.lane); continue; } r -= 2048;
        { const int mtx = r / 32, rr = r % 32, blk = mtx >> 1, gate = mtx & 1, n0 = (rr % 8) * 32;
          const int row_off = (blk * 2 + (n0 >> 7)) * 256 + gate * 128 + (n0 & 127) - n0;
          const float* w = (gate ? as_global(A.in[10]) : as_global(A.in[8])) + (size_t)l * 262144 + (size_t)blk * 65536;
          transpose_item(w, 256, 8, (bf16*)(wl + WL_G), 256, row_off, scr, rr, F.lane); }
    }
}

__device__ __forceinline__ void phase_input_rows(Frame& F, const float* x) {
    const int gw = F.bid * 8 + F.wave, NGW = F.G * 8;
    float* part = (float*)(F.ws + WS_PARTB);
    for (int m = gw; m < M; m += NGW) {
        const f32x4* xr = (const f32x4*)(x + (size_t)m * D) + F.lane;
        f32x4 v[4]; float s = 0.f;
#pragma unroll
        for (int j = 0; j < 4; ++j) { v[j] = xr[64 * j]; s += (v[j].x * v[j].x + v[j].y * v[j].y) + (v[j].z * v[j].z + v[j].w * v[j].w); }
        s = wave_sum(s, F.lane);
        v2u* o8 = (v2u*)(F.XN + (size_t)m * D) + F.lane;
#pragma unroll
        for (int j = 0; j < 4; ++j) { v2u w; w.x = pk2(v[j].x, v[j].y); w.y = pk2(v[j].z, v[j].w); o8[64 * j] = w; }
        if (F.lane < 4) part[(size_t)m * 4 + F.lane] = F.lane == 0 ? s : 0.f;
    }
}

__device__ __forceinline__ void phase_rmsnorm(Frame& F, const float* x, const float* g, bf16* out) {
    F.tid = opaque_tid(); F.lane = F.tid & 63;
    const int gw = F.bid * 8 + F.wave, NGW = F.G * 8;
    f32x4 gv[4];
#pragma unroll
    for (int j = 0; j < 4; ++j) gv[j] = *((const f32x4*)g + F.lane + 64 * j);
    for (int m = gw; m < M; m += NGW) {
        const f32x4* xr = (const f32x4*)(x + (size_t)m * D) + F.lane;
        f32x4 v[4]; float s = 0.f;
#pragma unroll
        for (int j = 0; j < 4; ++j) { v[j] = xr[64 * j]; s += (v[j].x * v[j].x + v[j].y * v[j].y) + (v[j].z * v[j].z + v[j].w * v[j].w); }
        const float rs = 1.0f / sqrtf(wave_sum(s, F.lane) * (1.f / D) + EPS);
        v2u* o8 = (v2u*)(out + (size_t)m * D) + F.lane;
#pragma unroll
        for (int j = 0; j < 4; ++j) { v2u w; w.x = pk2(v[j].x * rs * gv[j].x, v[j].y * rs * gv[j].y); w.y = pk2(v[j].z * rs * gv[j].z, v[j].w * rs * gv[j].w); o8[64 * j] = w; }
    }
}

__device__ __forceinline__ void phase_prep(Frame& F, const Args& A, int l) {
    F.tid = opaque_tid(); F.lane = F.tid & 63;
    const int gt = F.bid * 512 + F.tid, NGT = F.G * 512;
    {
        const float* cw = as_global(A.in[6]) + (size_t)l * 4 * D; const float* cb = as_global(A.in[7]) + (size_t)l * D;
        const bf16* __restrict__ lxp = F.PROJ; bf16* __restrict__ xcp = F.XC;
#pragma unroll 4
        for (int idx = gt; idx < M * 128; idx += NGT) {
            const int m = idx >> 7, c0 = (idx & 127) * 8, t = m & (T - 1);
            float acc[8];
#pragma unroll
            for (int j = 0; j < 8; ++j) acc[j] = cb[c0 + j];
#pragma unroll
            for (int jj = 0; jj < 4; ++jj) {
                if (t - 3 + jj >= 0) {
                    const v4u xv = *(const v4u*)(lxp + (size_t)(m - 3 + jj) * PN + OFF_LX + c0);
                    const float* w = cw + jj * D + c0;
                    acc[0] += w[0] * blo(xv.x); acc[1] += w[1] * bhi(xv.x); acc[2] += w[2] * blo(xv.y); acc[3] += w[3] * bhi(xv.y);
                    acc[4] += w[4] * blo(xv.z); acc[5] += w[5] * bhi(xv.z); acc[6] += w[6] * blo(xv.w); acc[7] += w[7] * bhi(xv.w);
                }
            }
            v4u o; o.x = pk2(acc[0], acc[1]); o.y = pk2(acc[2], acc[3]); o.z = pk2(acc[4], acc[5]); o.w = pk2(acc[6], acc[7]);
            *(v4u*)(xcp + (size_t)m * D + c0) = o;
        }
    }
    if (F.bid == 0) { const float* lam = as_global(A.in[12]) + (size_t)l * D; float* spl = (float*)(F.ws + WS_SPL);
        for (int c = F.tid; c < D; c += 512) { const float nl = -lam[c]; spl[c] = fmaxf(nl, 0.f) + log1pf(__expf(-fabsf(nl))); } }
    {
        const float* qg = as_global(A.in[13]) + (size_t)l * 128; const float* kg = as_global(A.in[14]) + (size_t)l * 128;
        const int sub = F.lane >> 4, l16 = F.lane & 15;
        const int gw = F.bid * 8 + F.wave, NGW = F.G * 8;
        for (int it4 = gw; it4 < M * 16 / 4; it4 += 4 * NGW) {
            v4u xin[4]; bf16* pp[4];
#pragma unroll
            for (int u4 = 0; u4 < 4; ++u4) { const int item = (it4 + u4 * NGW) * 4 + sub, m = item >> 4, hh = item & 15;
                pp[u4] = F.PROJ + (size_t)m * PN + (hh < 8 ? OFF_SQ + hh * 128 : OFF_SK + (hh - 8) * 128) + l16 * 8; xin[u4] = *(const v4u*)pp[u4]; }
#pragma unroll
            for (int u4 = 0; u4 < 4; ++u4) { const int item = (it4 + u4 * NGW) * 4 + sub, hh = item & 15;
                const float* g = (hh < 8 ? qg : kg) + l16 * 8;
                const float sc = hh < 8 ? 0.08838834764831845f * 1.4426950408889634f : 1.0f;
                const v4u xv = xin[u4];
                float v[8] = {blo(xv.x), bhi(xv.x), blo(xv.y), bhi(xv.y), blo(xv.z), bhi(xv.z), blo(xv.w), bhi(xv.w)};
                float s = 0.f;
#pragma unroll
                for (int j = 0; j < 8; ++j) s += v[j] * v[j];
                s += shx(s, 1, F.lane); s += shx(s, 2, F.lane); s += shx(s, 4, F.lane); s += shx(s, 8, F.lane);
                const float rs = sc / sqrtf(s * (1.f / 128.f) + EPS);
                v4u o; o.x = pk2(v[0] * rs * g[0], v[1] * rs * g[1]); o.y = pk2(v[2] * rs * g[2], v[3] * rs * g[3]); o.z = pk2(v[4] * rs * g[4], v[5] * rs * g[5]); o.w = pk2(v[6] * rs * g[6], v[7] * rs * g[7]);
                if (!F.dry) *(v4u*)pp[u4] = o; }
        }
    }
    {
        LAS float* adp = (LAS float*)F.lds;
        LAS float* ad = adp + 2048;
        const bf16* wdt = (const bf16*)(F.ws + WS_WDT) + (size_t)l * 16 * D;
        const float* wup = as_global(A.in[3]) + (size_t)l * 16 * 512; const float* bal = as_global(A.in[4]) + (size_t)l * 512;
        for (int ch = F.bid; ch < M / 64; ch += F.G) {
            const int m0 = ch * 64;
            __syncthreads();
            { const int rg = F.wave & 3, kh = F.wave >> 2, l15 = F.lane & 15, q4 = F.lane >> 4;
              const bf16* ap = F.XN + (size_t)(m0 + 16 * rg + l15) * D + 512 * kh + 8 * q4; const bf16* bp = wdt + (size_t)l15 * D + 512 * kh + 8 * q4;
              f32x4 acc = {0.f, 0.f, 0.f, 0.f};
#pragma unroll 4
              for (int ks = 0; ks < 16; ++ks) acc = __builtin_amdgcn_mfma_f32_16x16x32_bf16(*reinterpret_cast<const bf16x8*>(ap + 32 * ks), *reinterpret_cast<const bf16x8*>(bp + 32 * ks), acc, 0, 0, 0);
#pragma unroll
              for (int r = 0; r < 4; ++r) adp[kh * 1024 + (16 * rg + 4 * q4 + r) * 16 + l15] = acc[r] * pg8::row_rs((const float*)(F.ws + WS_PARTB), m0 + 16 * rg + 4 * q4 + r); }
            __syncthreads();
            ad[F.tid] = adp[F.tid] + adp[1024 + F.tid]; ad[512 + F.tid] = adp[512 + F.tid] + adp[1536 + F.tid];
            __syncthreads();
            const int c = F.tid;
            float wu[16];
#pragma unroll
            for (int j = 0; j < 16; ++j) wu[j] = wup[j * 512 + c];
            const float ba = bal[c];
            float cum = 0.f;
            for (int t8 = 0; t8 < 64; t8 += 8) { float kv[8]; bf16 qin[8], kin[8];
#pragma unroll
              for (int tt = 0; tt < 8; ++tt) { qin[tt] = F.PROJ[(size_t)(m0 + t8 + tt) * PN + OFF_GQ + c]; kin[tt] = F.PROJ[(size_t)(m0 + t8 + tt) * PN + OFF_GK + c]; }
#pragma unroll
              for (int tt = 0; tt < 8; ++tt) { const int t = t8 + tt; float lg = ba;
#pragma unroll
                for (int j4 = 0; j4 < 4; ++j4) { const f32x4 a4 = *reinterpret_cast<const LAS f32x4*>(ad + t * 16 + 4 * j4); lg += a4.x * wu[4 * j4] + a4.y * wu[4 * j4 + 1] + a4.z * wu[4 * j4 + 2] + a4.w * wu[4 * j4 + 3]; }
                const float ax = fabsf(lg) * 1.4426950408889634f; const float l2 = __builtin_amdgcn_logf(1.0f + __builtin_amdgcn_exp2f(-ax));
                cum += (fminf(lg, 0.f) * 1.4426950408889634f - l2) * (1.f / 16.f);
                const float e = __builtin_amdgcn_exp2f(cum), ei = __builtin_amdgcn_rcpf(e);
                bf16* pq = F.PROJ + (size_t)(m0 + t) * PN + OFF_GQ + c; bf16* pk = F.PROJ + (size_t)(m0 + t) * PN + OFF_GK + c;
                const float q = bf2f(qin[tt]), k = bf2f(kin[tt]);
                kv[tt] = k * ei; if (!F.dry) { *pq = (bf16)f2bf(q * 0.08838834764831845f * e); *pk = (bf16)f2bf(kv[tt]); } }
              }
            F.DECAY[(size_t)ch * 512 + c] = __builtin_amdgcn_exp2f(cum);
        }
    }
}

struct SchedProj {
    pg8::SchedStd base;
    __device__ __forceinline__ bool next(int i, pg8::Unit& u) const { if (!base.next(i, u)) return false; u.aux = 0; return true; }
    __device__ __forceinline__ const char* abase(const pg8::Unit& u) const { return u.aux ? base.B + (size_t)u.pn * base.tstepB : base.A + (size_t)u.pm * base.tstepA; }
    __device__ __forceinline__ const char* bbase(const pg8::Unit& u) const { return u.aux ? base.A + (size_t)u.pm * base.tstepA : base.B + (size_t)u.pn * base.tstepB; }
};
struct EpiProj {
    static constexpr bool PERM = true, ROW_RS = true;
    bf16* O; bf16* VT; const float* part;
    __device__ __forceinline__ bool operator()(f32x4 (&acc)[2][2][4][2], const pg8::Unit& u, int wr, int wc, int fr, int fq, const LAS float* xrs) const {
        bf16* base = u.aux ? VT : O; const size_t ldc = u.aux ? (size_t)M : (size_t)PN;
        const int row0 = (u.aux ? (u.pn - 4) : u.pm) * 256 + wr * 64 + fr, col0 = (u.aux ? u.pm : u.pn) * 256 + wc * 32 + 8 * fq;
        float rsv[8];
#pragma unroll
        for (int i = 0; i < 8; ++i) rsv[i] = xrs[wr * 64 + fr + (i >> 2) * 128 + (i & 3) * 16];
#pragma unroll
        for (int ai = 0; ai < 2; ++ai)
#pragma unroll
            for (int m = 0; m < 4; ++m) { bf16* rowp = base + (size_t)(row0 + ai * 128 + m * 16) * ldc + col0; const float rs = rsv[ai * 4 + m];
#pragma unroll
                for (int bj = 0; bj < 2; ++bj) { const f32x4 v0 = acc[ai][bj][m][0] * rs, v1 = acc[ai][bj][m][1] * rs;
                    v4u w; w.x = pg8::cvt_pk_bf16(v0[0], v0[1]); w.y = pg8::cvt_pk_bf16(v0[2], v0[3]); w.z = pg8::cvt_pk_bf16(v1[0], v1[1]); w.w = pg8::cvt_pk_bf16(v1[2], v1[3]);
                    *(v4u*)(rowp + bj * 128) = w; } }
        return true;
    }
};

struct SchedLru {
    const char* A; const char* B; int G, c;
    __device__ __forceinline__ bool next(int i, pg8::Unit& u) const { const int L = i * G + c; if (L >= 512) return false; u.pm = L >> 3; u.pn = L & 7; u.aux = 0; return true; }
    __device__ __forceinline__ const char* abase(const pg8::Unit& u) const { return A + (size_t)u.pm * 256 * D * 2 + (size_t)(u.pn >> 1) * 256 * 2; }
    __device__ __forceinline__ const char* bbase(const pg8::Unit& u) const { return B + (size_t)u.pn * 256 * 256 * 2; }
};
struct EpiLru {
    static constexpr bool PERM = true, ROW_RS = false;
    const bf16* XC; bf16* OMA; int ld_oma; bf16* U; const float* ba; const float* bx; const float* lam;
    __device__ __forceinline__ bool operator()(f32x4 (&acc)[2][2][4][2], const pg8::Unit& u, int wr, int wc, int fr, int fq, const LAS float* xrs) const {
        const int row0 = u.pm * 256 + wr * 64 + fr, chb = (u.pn >> 1) * 256 + (u.pn & 1) * 128 + wc * 32 + 8 * fq;
#pragma unroll
        for (int n = 0; n < 2; ++n) {
            const int ch0 = chb + 4 * n;
            const f32x4 b_a = *(const f32x4*)(ba + ch0), b_x = *(const f32x4*)(bx + ch0), sp = *(const f32x4*)(lam + ch0) * (-8.0f * 1.4426950408889634f);
#pragma unroll
            for (int ai = 0; ai < 2; ++ai)
#pragma unroll
                for (int m = 0; m < 4; ++m) { const int row = row0 + ai * 128 + m * 16;
                    const v2u xv = *(const v2u*)(XC + (size_t)row * D + ch0);
                    const float xc[4] = {blo(xv.x), bhi(xv.x), blo(xv.y), bhi(xv.y)};
                    float oa[4], uu[4];
#pragma unroll
                    for (int j = 0; j < 4; ++j) { const float pa = acc[ai][0][m][n][j] + b_a[j], px = acc[ai][1][m][n][j] + b_x[j];
                        const float r = __builtin_amdgcn_rcpf(1.0f + __builtin_amdgcn_exp2f(-1.4426950408889634f * pa)), ig = __builtin_amdgcn_rcpf(1.0f + __builtin_amdgcn_exp2f(-1.4426950408889634f * px));
                        const float a = __builtin_amdgcn_exp2f(r * sp[j]); const float om = 1.0f - a;
                        oa[j] = om; uu[j] = __builtin_amdgcn_sqrtf(om * (1.0f + a)) * ig * xc[j]; }
                    v2u w1; w1.x = pk2(oa[0], oa[1]); w1.y = pk2(oa[2], oa[3]);
                    v2u w2; w2.x = pk2(uu[0], uu[1]); w2.y = pk2(uu[2], uu[3]);
                    *(v2u*)(OMA + (size_t)row * ld_oma + ch0) = w1; *(v2u*)(U + (size_t)row * D + ch0) = w2;
                    asm volatile("" ::: "memory"); }
        }
        return true;
    }
};

struct SchedBranch {
    const char* P; const char* B; int G, c;
    __device__ __forceinline__ bool next(int i, pg8::Unit& u) const { const int tile = (i / 3) * G + c; if (tile >= 256) return false; u.pm = tile >> 2; u.pn = tile & 3; u.aux = i % 3; return true; }
    __device__ __forceinline__ const char* abase(const pg8::Unit& u) const { const int off = u.aux == 0 ? OFF_GG : (u.aux == 1 ? OFF_LG : OFF_SQ); return P + ((size_t)u.pm * 256 * PN + off) * 2; }
    __device__ __forceinline__ const char* bbase(const pg8::Unit& u) const { return B + (size_t)(u.aux * 1024 + u.pn * 256) * D * 2; }
};
struct EpiBranch {
    static constexpr bool PERM = true, ROW_RS = false;
    const bf16* PROJ; const float* bg; bf16* O;
    __device__ __forceinline__ bool operator()(f32x4 (&acc)[2][2][4][2], const pg8::Unit& u, int wr, int wc, int fr, int fq, const LAS float* xrs) const {
        const int row0 = u.pm * 256 + wr * 64 + fr, col0 = u.pn * 256 + wc * 32 + 8 * fq, br = u.aux;
#pragma unroll
        for (int bj = 0; bj < 2; ++bj) {
            const int c = col0 + bj * 128;
            float b0[8], b1[8];
#pragma unroll
            for (int j = 0; j < 8; ++j) { b0[j] = bg[br * 1024 + c + j]; b1[j] = br < 2 ? bg[(br + 1) * 1024 + c + j] : 0.f; }
#pragma unroll
            for (int ai = 0; ai < 2; ++ai)
#pragma unroll
                for (int m = 0; m < 4; ++m) { const int row = row0 + ai * 128 + m * 16;
                    const bf16* gp = PROJ + (size_t)row * PN + OFF_GATE + br * 1024 + c;
                    const v4u l0 = *(const v4u*)gp;
                    const float x0[8] = {blo(l0.x), bhi(l0.x), blo(l0.y), bhi(l0.y), blo(l0.z), bhi(l0.z), blo(l0.w), bhi(l0.w)};
                    float f[8];
                    if (br < 2) { const v4u l1 = *(const v4u*)(gp + 1024);
                        const float x1[8] = {blo(l1.x), bhi(l1.x), blo(l1.y), bhi(l1.y), blo(l1.z), bhi(l1.z), blo(l1.w), bhi(l1.w)};
#pragma unroll
                        for (int j = 0; j < 8; ++j) f[j] = (1.0f + __expf(-(x1[j] + b1[j]))) / (1.0f + __expf(-(x0[j] + b0[j])));
                    } else {
#pragma unroll
                        for (int j = 0; j < 8; ++j) f[j] = 1.0f / (1.0f + __expf(-(x0[j] + b0[j])));
                    }
#pragma unroll
                    for (int j = 0; j < 8; ++j) acc[ai][bj][m][j >> 2][j & 3] *= f[j];
                    if (br == 2) { const f32x4 v0 = acc[ai][bj][m][0], v1 = acc[ai][bj][m][1];
                        v4u w; w.x = pg8::cvt_pk_bf16(v0[0], v0[1]); w.y = pg8::cvt_pk_bf16(v0[2], v0[3]); w.z = pg8::cvt_pk_bf16(v1[0], v1[1]); w.w = pg8::cvt_pk_bf16(v1[2], v1[3]);
                        *(v4u*)(O + (size_t)row * D + c) = w; } }
        }
        return br == 2;
    }
};

namespace gla {
typedef float f32x16 __attribute__((ext_vector_type(16)));
typedef short s16x4 __attribute__((ext_vector_type(4)));
constexpr int BUF = 65536, T_QD = 0, T_KI = 16384, T_V = 32768, X_SSQ = 131072, X_DW = 131072 + 2048;
__device__ __forceinline__ int crow(int r, int hi) { return (r & 3) + 8 * (r >> 2) + 4 * hi; }
__device__ __forceinline__ unsigned cvtpk(float lo, float hi) { unsigned r; asm volatile("v_cvt_pk_bf16_f32 %0, %1, %2" : "=v"(r) : "v"(lo), "v"(hi)); return r; }
__device__ __forceinline__ bf16x8 acc_frag(const f32x16& X, int s) { v4u w = {cvtpk(X[8 * s], X[8 * s + 1]), cvtpk(X[8 * s + 2], X[8 * s + 3]), cvtpk(X[8 * s + 4], X[8 * s + 5]), cvtpk(X[8 * s + 6], X[8 * s + 7])}; return *reinterpret_cast<bf16x8*>(&w); }
__device__ __forceinline__ int offb(int row, int ch) { return 256 * row + 16 * (ch ^ (((row & 3) << 2) | ((row >> 2) & 3))); }
__device__ __forceinline__ bf16x8 rowrd(const LAS unsigned char* tile, int lane, int rb, int s) { return *reinterpret_cast<const LAS bf16x8*>(tile + offb((lane & 31) + 32 * rb, 2 * s + (lane >> 5))); }
__device__ __forceinline__ v2u rd8(const LAS unsigned char* tile, int row, int ch, int half) { return *reinterpret_cast<const LAS v2u*>(tile + offb(row, ch) + 8 * half); }
__device__ __forceinline__ s16x4 trr(unsigned addr) { s16x4 r; asm volatile("ds_read_b64_tr_b16 %0, %1" : "=&v"(r) : "v"(addr) : "memory"); return r; }
__device__ __forceinline__ unsigned tr_addr(unsigned base, int lane, int c, int row0) { const int blk = (lane >> 4) & 1, q = (lane & 15) >> 2, p = lane & 3; return base + offb(row0 + q, 4 * c + 2 * blk + (p >> 1)) + 8 * (p & 1); }
__device__ __forceinline__ bf16x8 tr_nat(unsigned base, int lane, int c, int ks) { const int h = lane >> 5; const s16x4 a = trr(tr_addr(base, lane, c, 16 * ks + 8 * h)), b = trr(tr_addr(base, lane, c, 16 * ks + 8 * h + 4));
    asm volatile("s_waitcnt lgkmcnt(0)" ::: "memory"); return (bf16x8){a[0], a[1], a[2], a[3], b[0], b[1], b[2], b[3]}; }
__device__ __forceinline__ bf16x8 tr_perm(unsigned base, int lane, int c, int ks) { const int h = lane >> 5; const s16x4 a = trr(tr_addr(base, lane, c, 16 * ks + 4 * h)), b = trr(tr_addr(base, lane, c, 16 * ks + 8 + 4 * h));
    asm volatile("s_waitcnt lgkmcnt(0)" ::: "memory"); return (bf16x8){a[0], a[1], a[2], a[3], b[0], b[1], b[2], b[3]}; }
__device__ __forceinline__ void dma_tile(LAS unsigned char* img, const bf16* grow0  , int wid, int lane) {
#pragma unroll
    for (int i = 0; i < 2; ++i) { const int L = (wid + 8 * i) * 64 + lane, row = L >> 4, ch = (L & 15) ^ (((row & 3) << 2) | ((row >> 2) & 3));
        __builtin_amdgcn_global_load_lds((const unsigned*)(grow0 + (size_t)row * PN + ch * 8), (LAS unsigned*)(img + (wid + 8 * i) * 1024), 16, 0, 0); }
}
__device__ __forceinline__ void dma_chunk(LAS unsigned char* lds, int buf, const bf16* proj_row0  , int h, bool with_q, int wid, int lane) {
    LAS unsigned char* b = lds + buf * BUF;
    if (with_q) dma_tile(b + T_QD, proj_row0 + OFF_GQ + h * 128, wid, lane);
    dma_tile(b + T_KI, proj_row0 + OFF_GK + h * 128, wid, lane);
    dma_tile(b + T_V, proj_row0 + OFF_GV + h * 256, wid, lane);
    dma_tile(b + T_V + 16384, proj_row0 + OFF_GV + h * 256 + 128, wid, lane);
}
__device__ __forceinline__ void s_update(f32x16 (&S)[4], const LAS unsigned char* b, unsigned bi, const float* dec, int wid, int lane, int hi) {
    const unsigned vimg = bi + T_V + (wid >> 2) * 16384, kimg = bi + T_KI;
#pragma unroll
    for (int ks = 0; ks < 4; ++ks) { const bf16x8 bv = tr_nat(vimg, lane, wid & 3, ks);
#pragma unroll
        for (int db = 0; db < 4; ++db) { const bf16x8 a = tr_nat(kimg, lane, db, ks); S[db] = __builtin_amdgcn_mfma_f32_32x32x16_bf16(a, bv, S[db], 0, 0, 0); } }
#pragma unroll
    for (int db = 0; db < 4; ++db)
#pragma unroll
        for (int g = 0; g < 4; ++g) { const f32x4 d = *reinterpret_cast<const f32x4*>(dec + 32 * db + 8 * g + 4 * hi);
#pragma unroll
            for (int i = 0; i < 4; ++i) S[db][4 * g + i] *= d[i]; }
}
__device__ __forceinline__ void pass1_item(Frame& F, int it) {
    const int tid = opaque_tid(), wid = __builtin_amdgcn_readfirstlane(tid >> 6), lane = tid & 63, hi = lane >> 5;
    const int b = it >> 5, h = (it >> 3) & 3, g = it & 7;
    const float* decb = F.DECAY + (size_t)(b * 32) * 512 + h * 128;
    const unsigned lbase = (unsigned)(uintptr_t)F.ldsg;
    f32x16 S[4];
#pragma unroll
    for (int db = 0; db < 4; ++db) S[db] = f32x16{};
    __syncthreads();
    dma_chunk(F.lds, 0, F.PROJ + (size_t)(b * T + (4 * g) * 64) * PN, h, false, wid, lane);
    asm volatile("s_waitcnt vmcnt(0)" ::: "memory"); __syncthreads();
#pragma nounroll
    for (int n = 0; n < 4; ++n) { const int ch = 4 * g + n;
        if (n < 3) dma_chunk(F.lds, (n + 1) & 1, F.PROJ + (size_t)(b * T + (ch + 1) * 64) * PN, h, false, wid, lane);
        int ln = lane; asm volatile("" : "+v"(ln));
        s_update(S, F.lds + (n & 1) * BUF, lbase + (n & 1) * BUF, decb + (size_t)ch * 512, wid, ln, ln >> 5);
        asm volatile("s_waitcnt vmcnt(0)" ::: "memory"); __syncthreads();
    }
    float* sl = (float*)(F.ws + WS_VT) + (size_t)it * 32768 + wid * 4096;
#pragma unroll
    for (int db = 0; db < 4; ++db)
#pragma unroll
        for (int g4 = 0; g4 < 4; ++g4) *reinterpret_cast<f32x4*>(sl + ((db * 4 + g4) * 64 + lane) * 4) = (f32x4){S[db][4 * g4], S[db][4 * g4 + 1], S[db][4 * g4 + 2], S[db][4 * g4 + 3]};
}
__device__ __forceinline__ void pass2_item(Frame& F, const float* norm_g, int it) {
    const int tid = opaque_tid(), wid = __builtin_amdgcn_readfirstlane(tid >> 6), lane = tid & 63, r32 = lane & 31, hi = lane >> 5;
    const int b = it >> 5, h = (it >> 3) & 3, g = it & 7;
    const float* decb = F.DECAY + (size_t)(b * 32) * 512 + h * 128;
    const unsigned lbase = (unsigned)(uintptr_t)F.ldsg;
    LAS float* ssqx = (LAS float*)(F.lds + X_SSQ);
    LAS float* Dw = (LAS float*)(F.lds + X_DW);
    __syncthreads();
    dma_chunk(F.lds, 0, F.PROJ + (size_t)(b * T + (4 * g) * 64) * PN, h, true, wid, lane);
    { const int w2 = tid >> 6, d2 = (tid & 63) * 2; const float* dp = decb + (size_t)(4 * w2) * 512 + d2;
      float p0 = 1.f, p1 = 1.f;
#pragma unroll
      for (int n = 0; n < 4; ++n) { p0 *= dp[n * 512]; p1 *= dp[n * 512 + 1]; }
      Dw[w2 * 128 + d2] = p0; Dw[w2 * 128 + d2 + 1] = p1; }
    __syncthreads();
    f32x16 S[4];
#pragma unroll
    for (int db = 0; db < 4; ++db) S[db] = f32x16{};
    for (int g2 = 0; g2 < g; ++g2) { const float* sl = (const float*)(F.ws + WS_VT) + (size_t)(it - g + g2) * 32768 + wid * 4096;
#pragma unroll
        for (int db = 0; db < 4; ++db)
#pragma unroll
            for (int g4 = 0; g4 < 4; ++g4) { const f32x4 d = *reinterpret_cast<const LAS f32x4*>(Dw + g2 * 128 + 32 * db + 8 * g4 + 4 * hi);
                const f32x4 sv = *reinterpret_cast<const f32x4*>(sl + ((db * 4 + g4) * 64 + lane) * 4);
#pragma unroll
                for (int i = 0; i < 4; ++i) S[db][4 * g4 + i] = d[i] * S[db][4 * g4 + i] + sv[i]; }
    }
    float ng[16];
#pragma unroll
    for (int r = 0; r < 16; ++r) ng[r] = norm_g[32 * wid + crow(r, hi)];
    asm volatile("s_waitcnt vmcnt(0)" ::: "memory"); __syncthreads();
#pragma nounroll
    for (int n = 0; n < 4; ++n) { const int ch = 4 * g + n; const size_t m0 = (size_t)(b * T + ch * 64);
        if (n < 3) dma_chunk(F.lds, (n + 1) & 1, F.PROJ + (m0 + 64) * PN, h, true, wid, lane);
        int ln = lane; asm volatile("" : "+v"(ln));
        const int lane = ln, r32 = ln & 31, hi = ln >> 5;
        const LAS unsigned char* bq = F.lds + (n & 1) * BUF + T_QD; const LAS unsigned char* bk = F.lds + (n & 1) * BUF + T_KI;
        const unsigned bi = lbase + (n & 1) * BUF, vimg = bi + T_V + (wid >> 2) * 16384;
        f32x16 a00 = f32x16{}, a01 = f32x16{}, a11 = f32x16{};
#pragma unroll
        for (int d0 = 0; d0 < 8; ++d0) { const bf16x8 k0 = rowrd(bk, lane, 0, d0), k1 = rowrd(bk, lane, 1, d0), q0 = rowrd(bq, lane, 0, d0), q1 = rowrd(bq, lane, 1, d0);
            a00 = __builtin_amdgcn_mfma_f32_32x32x16_bf16(k0, q0, a00, 0, 0, 0);
            a01 = __builtin_amdgcn_mfma_f32_32x32x16_bf16(k0, q1, a01, 0, 0, 0);
            a11 = __builtin_amdgcn_mfma_f32_32x32x16_bf16(k1, q1, a11, 0, 0, 0); }
#pragma unroll
        for (int r = 0; r < 16; ++r) { const bool vis = crow(r, hi) <= r32; a00[r] = vis ? a00[r] : 0.f; a11[r] = vis ? a11[r] : 0.f; }
        f32x16 o0 = f32x16{}, o1 = f32x16{};
#pragma unroll
        for (int ks = 0; ks < 2; ++ks) { const bf16x8 va = tr_perm(vimg, lane, wid & 3, ks), vb = tr_perm(vimg, lane, wid & 3, 2 + ks);
            o0 = __builtin_amdgcn_mfma_f32_32x32x16_bf16(va, acc_frag(a00, ks), o0, 0, 0, 0);
            o1 = __builtin_amdgcn_mfma_f32_32x32x16_bf16(va, acc_frag(a01, ks), o1, 0, 0, 0);
            o1 = __builtin_amdgcn_mfma_f32_32x32x16_bf16(vb, acc_frag(a11, ks), o1, 0, 0, 0); }
#pragma unroll
        for (int db = 0; db < 4; ++db)
#pragma unroll
            for (int ks = 0; ks < 2; ++ks) { const bf16x8 sa = acc_frag(S[db], ks);
                const v2u x0 = rd8(bq, r32, 4 * db + 2 * ks, hi), x1 = rd8(bq, r32, 4 * db + 2 * ks + 1, hi), y0 = rd8(bq, 32 + r32, 4 * db + 2 * ks, hi), y1 = rd8(bq, 32 + r32, 4 * db + 2 * ks + 1, hi);
                v4u wx = {x0.x, x0.y, x1.x, x1.y}, wy = {y0.x, y0.y, y1.x, y1.y};
                o0 = __builtin_amdgcn_mfma_f32_32x32x16_bf16(sa, *reinterpret_cast<bf16x8*>(&wx), o0, 0, 0, 0);
                o1 = __builtin_amdgcn_mfma_f32_32x32x16_bf16(sa, *reinterpret_cast<bf16x8*>(&wy), o1, 0, 0, 0); }
        float s0 = 0.f, s1 = 0.f;
#pragma unroll
        for (int r = 0; r < 16; ++r) { s0 += o0[r] * o0[r]; s1 += o1[r] * o1[r]; }
        { auto rr = __builtin_amdgcn_permlane32_swap(__float_as_uint(s0), __float_as_uint(s0), false, false); s0 = __uint_as_float(rr[0]) + __uint_as_float(rr[1]); }
        { auto rr = __builtin_amdgcn_permlane32_swap(__float_as_uint(s1), __float_as_uint(s1), false, false); s1 = __uint_as_float(rr[0]) + __uint_as_float(rr[1]); }
        if (hi == 0) { ssqx[wid * 64 + r32] = s0; ssqx[wid * 64 + 32 + r32] = s1; }
        const bf16* gp = F.PROJ + (m0 + r32) * PN + OFF_GG + h * 256 + 32 * wid + 4 * hi;
        v2u gg0[4], gg1[4];
#pragma unroll
        for (int g4 = 0; g4 < 4; ++g4) { gg0[g4] = *reinterpret_cast<const v2u*>(gp + 8 * g4); gg1[g4] = *reinterpret_cast<const v2u*>(gp + (size_t)32 * PN + 8 * g4); }
        __syncthreads();
        float t0s = 0.f, t1s = 0.f;
#pragma unroll
        for (int w2 = 0; w2 < 8; ++w2) { t0s += ssqx[w2 * 64 + r32]; t1s += ssqx[w2 * 64 + 32 + r32]; }
        const float rs0 = 1.0f / sqrtf(t0s * (1.f / 256.f) + EPS), rs1 = 1.0f / sqrtf(t1s * (1.f / 256.f) + EPS);
#pragma unroll
        for (int g4 = 0; g4 < 4; ++g4) {
            const float ga[4] = {blo(gg0[g4].x), bhi(gg0[g4].x), blo(gg0[g4].y), bhi(gg0[g4].y)}, gb[4] = {blo(gg1[g4].x), bhi(gg1[g4].x), blo(gg1[g4].y), bhi(gg1[g4].y)};
            float ya[4], yb[4];
#pragma unroll
            for (int i = 0; i < 4; ++i) { ya[i] = o0[4 * g4 + i] * rs0 * ng[4 * g4 + i] * (ga[i] * __builtin_amdgcn_rcpf(1.0f + __builtin_amdgcn_exp2f(-1.4426950408889634f * ga[i])));
                                          yb[i] = o1[4 * g4 + i] * rs1 * ng[4 * g4 + i] * (gb[i] * __builtin_amdgcn_rcpf(1.0f + __builtin_amdgcn_exp2f(-1.4426950408889634f * gb[i]))); }
            v2u w0 = {cvtpk(ya[0], ya[1]), cvtpk(ya[2], ya[3])}, w1 = {cvtpk(yb[0], yb[1]), cvtpk(yb[2], yb[3])};
            if (!F.dry) { *reinterpret_cast<v2u*>(const_cast<bf16*>(gp) + 8 * g4) = w0; *reinterpret_cast<v2u*>(const_cast<bf16*>(gp) + (size_t)32 * PN + 8 * g4) = w1; }
        }
        if (n < 3) s_update(S, F.lds + (n & 1) * BUF, bi, decb + (size_t)ch * 512, wid, lane, hi);
        asm volatile("s_waitcnt vmcnt(0)" ::: "memory"); __syncthreads();
    }
}
}
__device__ __forceinline__ void phase_gla_fix(Frame& F, const Args& A, int l) {
    F.tid = opaque_tid(); F.lane = F.tid & 63;
    const int gt = F.bid * 512 + F.tid, NGT = F.G * 512;
    const float* ng = as_global(A.in[5]) + (size_t)l * 256;
    for (int idx = gt; idx < M * 128; idx += NGT) {
        const int m = idx >> 7, c0 = (idx & 127) * 8, h = c0 >> 8;
        const float* sp = F.SSQ + (size_t)m * 32 + h * 8;
        const float ss = ((sp[0] + sp[1]) + (sp[2] + sp[3])) + ((sp[4] + sp[5]) + (sp[6] + sp[7]));
        const float rs = 1.0f / sqrtf(ss * (1.f / 256.f) + EPS);
        const v4u ov = *(const v4u*)(F.PROJ + (size_t)m * PN + OFF_GV + c0);
        bf16* gp = F.PROJ + (size_t)m * PN + OFF_GG + c0;
        const v4u gv = *(const v4u*)gp;
        const float o[8] = {blo(ov.x), bhi(ov.x), blo(ov.y), bhi(ov.y), blo(ov.z), bhi(ov.z), blo(ov.w), bhi(ov.w)};
        const float g[8] = {blo(gv.x), bhi(gv.x), blo(gv.y), bhi(gv.y), blo(gv.z), bhi(gv.z), blo(gv.w), bhi(gv.w)};
        float r[8];
#pragma unroll
        for (int j = 0; j < 8; ++j) r[j] = o[j] * rs * ng[(c0 & 255) + j] * (g[j] * sigmoidf_(g[j]));
        v4u w; w.x = pk2(r[0], r[1]); w.y = pk2(r[2], r[3]); w.z = pk2(r[4], r[5]); w.w = pk2(r[6], r[7]);
        if (!F.dry) *(v4u*)gp = w;
    }
}

__device__ __forceinline__ float gelu_tanh(float x) { const float y = 0.7978845608028654f * (x + 0.044715f * x * x * x); const float e = __expf(2.0f * y); const float th = 1.0f - 2.0f / (e + 1.0f); return 0.5f * x * (1.0f + th); }
__device__ __forceinline__ void lru_scan_item(Frame& F, int item) {
    F.tid = opaque_tid(); F.lane = F.tid & 63;
    const int b = item >> 5, cg = item & 31, tid = F.tid, seg = tid >> 3, quad = tid & 7, ch = cg * 32 + quad * 4;
    LAS float* segP = (LAS float*)F.lds;
    LAS float* segH = segP + 64 * 32; LAS float* carry = segH + 64 * 32;
    const int m0 = b * T + seg * 32;
    float h[4] = {0, 0, 0, 0}, P[4] = {1, 1, 1, 1};
#pragma unroll
    for (int i16 = 0; i16 < 32; i16 += 16) {
        v2u om[16], uu[16];
#pragma unroll
        for (int i = 0; i < 16; ++i) { om[i] = *(const v2u*)(F.PROJ + (size_t)(m0 + i16 + i) * PN + OFF_LX + ch); uu[i] = *(const v2u*)(F.U + (size_t)(m0 + i16 + i) * D + ch); }
#pragma unroll
        for (int i = 0; i < 16; ++i) {
            const float a[4] = {1.f - blo(om[i].x), 1.f - bhi(om[i].x), 1.f - blo(om[i].y), 1.f - bhi(om[i].y)}; const float u[4] = {blo(uu[i].x), bhi(uu[i].x), blo(uu[i].y), bhi(uu[i].y)};
#pragma unroll
            for (int j = 0; j < 4; ++j) { h[j] = a[j] * h[j] + u[j]; P[j] *= a[j]; }
        }
    }
    __syncthreads();
#pragma unroll
    for (int j = 0; j < 4; ++j) { segP[seg * 32 + quad * 4 + j] = P[j]; segH[seg * 32 + quad * 4 + j] = h[j]; }
    __syncthreads();
    if (tid < 32) { float c = 0.f; for (int s = 0; s < 64; ++s) { carry[s * 32 + tid] = c; c = segP[s * 32 + tid] * c + segH[s * 32 + tid]; } }
    __syncthreads();
#pragma unroll
    for (int j = 0; j < 4; ++j) h[j] = carry[seg * 32 + quad * 4 + j];
#pragma nounroll
    for (int i8 = 0; i8 < 32; i8 += 8) {
        v2u om[8], uu[8], gv[8];
#pragma unroll
        for (int i = 0; i < 8; ++i) { om[i] = *(const v2u*)(F.PROJ + (size_t)(m0 + i8 + i) * PN + OFF_LX + ch); uu[i] = *(const v2u*)(F.U + (size_t)(m0 + i8 + i) * D + ch);
            gv[i] = *(const v2u*)(F.PROJ + (size_t)(m0 + i8 + i) * PN + OFF_LG + ch); }
#pragma unroll
        for (int i = 0; i < 8; ++i) {
            const float a[4] = {1.f - blo(om[i].x), 1.f - bhi(om[i].x), 1.f - blo(om[i].y), 1.f - bhi(om[i].y)}; const float u[4] = {blo(uu[i].x), bhi(uu[i].x), blo(uu[i].y), bhi(uu[i].y)};
            const float g[4] = {blo(gv[i].x), bhi(gv[i].x), blo(gv[i].y), bhi(gv[i].y)};
            float y[4];
#pragma unroll
            for (int j = 0; j < 4; ++j) { h[j] = a[j] * h[j] + u[j]; y[j] = h[j] * gelu_tanh(g[j]); }
            v2u w; w.x = pk2(y[0], y[1]); w.y = pk2(y[2], y[3]); if (!F.dry) *(v2u*)(F.PROJ + (size_t)(m0 + i8 + i) * PN + OFF_LG + ch) = w;
        }
    }
    __syncthreads();
}

namespace sba {
typedef float f32x16 __attribute__((ext_vector_type(16)));
typedef short s16x4 __attribute__((ext_vector_type(4)));
constexpr int SHM_V = 64 * 128 * 2, SHM_K = 64 * 128 * 2;
#define SBA_KSWZ(row, colB) ((row) * 256 + ((colB) ^ (((row) & 7) << 4)))
#define SBA_SBAR() __builtin_amdgcn_sched_barrier(0)
__device__ __forceinline__ int crow(int r, int hi) { return (r & 3) + 8 * (r >> 2) + 4 * hi; }
__device__ __forceinline__ unsigned cvtpk(float lo, float hi) { unsigned r; asm volatile("v_cvt_pk_bf16_f32 %0, %1, %2" : "=v"(r) : "v"(lo), "v"(hi)); return r; }
__device__ __forceinline__ void qkt(f32x16& p0, f32x16& p1, const char* Ks, const bf16x8* qr, int r32, int hi) {
    p0 = f32x16{}; p1 = f32x16{};
#pragma unroll
    for (int d0 = 0; d0 < 8; ++d0) { const int cb = (d0 * 16 + hi * 8) * 2;
        const bf16x8 b0 = *reinterpret_cast<const bf16x8*>(Ks + SBA_KSWZ(r32, cb));
        const bf16x8 b1 = *reinterpret_cast<const bf16x8*>(Ks + SBA_KSWZ(32 + r32, cb));
        p0 = __builtin_amdgcn_mfma_f32_32x32x16_bf16(b0, qr[d0], p0, 0, 0, 0);
        p1 = __builtin_amdgcn_mfma_f32_32x32x16_bf16(b1, qr[d0], p1, 0, 0, 0); }
}
__device__ __forceinline__ void sig_part(f32x16& p0, f32x16& p1, bool partial, int krel, int hi) {
#pragma unroll
    for (int r = 0; r < 16; ++r) { p0[r] = __builtin_amdgcn_rcpf(1.0f + __builtin_amdgcn_exp2f(p0[r])); p1[r] = __builtin_amdgcn_rcpf(1.0f + __builtin_amdgcn_exp2f(p1[r])); }
    if (partial) {
#pragma unroll
        for (int r = 0; r < 16; ++r) { const int kk = krel + crow(r, hi); p0[r] = (kk < 0) ? p0[r] : 1.0f; p1[r] = (kk + 32 < 0) ? p1[r] : 1.0f; }
    }
}
__device__ __forceinline__ void finish(f32x16& p0, f32x16& p1, float& R, int hi, bf16x8& pa0, bf16x8& pa1, bf16x8& pa2, bf16x8& pa3) {
    float lo[8], hv[8];
#pragma unroll
    for (int g = 0; g < 4; ++g) {
        const float ga = (p0[4 * g] * p0[4 * g + 1]) * (p0[4 * g + 2] * p0[4 * g + 3]), gb = (p1[4 * g] * p1[4 * g + 1]) * (p1[4 * g + 2] * p1[4 * g + 3]);
        { auto rr = __builtin_amdgcn_permlane32_swap(__float_as_uint(ga), __float_as_uint(ga), false, false); lo[g] = __uint_as_float(rr[0]); hv[g] = __uint_as_float(rr[1]); }
        { auto rr = __builtin_amdgcn_permlane32_swap(__float_as_uint(gb), __float_as_uint(gb), false, false); lo[4 + g] = __uint_as_float(rr[0]); hv[4 + g] = __uint_as_float(rr[1]); }
    }
    float ps = R;
#pragma unroll
    for (int g = 7; g >= 0; --g) {
        float run = ps * (hi == 0 ? hv[g] : 1.0f);
#pragma unroll
        for (int i = 3; i >= 0; --i) {
            if (g >= 4) { const float k = p1[4 * (g - 4) + i]; p1[4 * (g - 4) + i] = (1.0f - k) * run; run *= k; }
            else        { const float k = p0[4 * g + i];       p0[4 * g + i]       = (1.0f - k) * run; run *= k; }
        }
        ps = ps * (lo[g] * hv[g]);
    }
    R = ps;
#define SBA_PK4(P, BASE, OUT) do { unsigned a0 = cvtpk(P[BASE + 0], P[BASE + 1]), a1 = cvtpk(P[BASE + 2], P[BASE + 3]);   \
    unsigned b0 = cvtpk(P[BASE + 4], P[BASE + 5]), b1 = cvtpk(P[BASE + 6], P[BASE + 7]);                              \
    auto r0 = __builtin_amdgcn_permlane32_swap(a0, b0, false, false); auto r1 = __builtin_amdgcn_permlane32_swap(a1, b1, false, false); \
    v4u w = {r0[0], r1[0], r0[1], r1[1]}; OUT = *reinterpret_cast<bf16x8*>(&w); } while (0)
    SBA_PK4(p0, 0, pa0); SBA_PK4(p0, 8, pa1); SBA_PK4(p1, 0, pa2); SBA_PK4(p1, 8, pa3);
#undef SBA_PK4
}
__device__ __forceinline__ int v_st(int k, int c) { const int kk = (k & ~0xC) | ((k & 4) << 1) | ((k & 8) >> 1); return ((kk >> 3) * 4 + (c >> 5)) * 512 + ((kk & 7) * 32 + (c & 31)) * 2; }
__device__ __forceinline__ int v_rd_base(int lane) { return ((lane & 3) << 3) | (((lane >> 2) & 3) << 6) | (((lane >> 4) & 1) << 5) | (((lane >> 5) & 1) << 8); }
constexpr int v_rd_off(int d0, int ks, int half) { return d0 * 512 + ks * 4096 + half * 2048; }
template <int OFF> __device__ __forceinline__ s16x4 tr_read(int vb) { s16x4 r; asm volatile("ds_read_b64_tr_b16 %0, %1 offset:%2" : "=&v"(r) : "v"(vb), "i"(OFF) : "memory"); return r; }
template <int D0> __device__ __forceinline__ void pv_one(f32x16& od, int vb, bf16x8 pa0, bf16x8 pa1, bf16x8 pa2, bf16x8 pa3) {
    const s16x4 l0 = tr_read<v_rd_off(D0, 0, 0)>(vb), h0 = tr_read<v_rd_off(D0, 0, 1)>(vb), l1 = tr_read<v_rd_off(D0, 1, 0)>(vb), h1 = tr_read<v_rd_off(D0, 1, 1)>(vb);
    const s16x4 l2 = tr_read<v_rd_off(D0, 2, 0)>(vb), h2 = tr_read<v_rd_off(D0, 2, 1)>(vb), l3 = tr_read<v_rd_off(D0, 3, 0)>(vb), h3 = tr_read<v_rd_off(D0, 3, 1)>(vb);
    asm volatile("s_waitcnt lgkmcnt(0)" ::: "memory"); SBA_SBAR();
#define SBA_PK(L, H) (bf16x8){L[0], L[1], L[2], L[3], H[0], H[1], H[2], H[3]}
    od = __builtin_amdgcn_mfma_f32_32x32x16_bf16(pa0, SBA_PK(l0, h0), od, 0, 0, 0);
    od = __builtin_amdgcn_mfma_f32_32x32x16_bf16(pa1, SBA_PK(l1, h1), od, 0, 0, 0);
    od = __builtin_amdgcn_mfma_f32_32x32x16_bf16(pa2, SBA_PK(l2, h2), od, 0, 0, 0);
    od = __builtin_amdgcn_mfma_f32_32x32x16_bf16(pa3, SBA_PK(l3, h3), od, 0, 0, 0);
#undef SBA_PK
}
__device__ __forceinline__ void pv_d0(f32x16* o, int vb, bf16x8 pa0, bf16x8 pa1, bf16x8 pa2, bf16x8 pa3) {
    pv_one<0>(o[0], vb, pa0, pa1, pa2, pa3); pv_one<1>(o[1], vb, pa0, pa1, pa2, pa3); pv_one<2>(o[2], vb, pa0, pa1, pa2, pa3); pv_one<3>(o[3], vb, pa0, pa1, pa2, pa3);
}
__device__ __forceinline__ void unit(const bf16* Qb, const bf16* __restrict__ Kh, const bf16* __restrict__ Vh, bf16* Ob, int qb, char* lds, int tid, bool dry) {
    const int wid = __builtin_amdgcn_readfirstlane(tid >> 6), lane = tid & 63, r32 = lane & 31, hi = lane >> 5;
    char* V_lds = lds; char* K_lds = lds + 2 * SHM_V;
    f32x16 o[4] = {}; bf16x8 qr[8]; float R = 1.0f;
    const bf16* Qw = Qb + (size_t)(wid * 32 + r32) * PN + hi * 8;
#pragma unroll
    for (int d0 = 0; d0 < 8; ++d0) qr[d0] = *reinterpret_cast<const bf16x8*>(Qw + d0 * 16);
    const int sr = tid >> 4, sc = (tid & 15) * 8, vst0 = v_st(sr, sc), vst1 = v_st(32 + sr, sc);
    const int vb0 = (int)(uintptr_t)V_lds + v_rd_base(lane);
    bf16x8 vs0, vs1, ks0, ks1;
#define SBA_SLOAD(k0) do { vs0 = *reinterpret_cast<const bf16x8*>(&Vh[(size_t)((k0) + sr) * PN + sc]); vs1 = *reinterpret_cast<const bf16x8*>(&Vh[(size_t)((k0) + 32 + sr) * PN + sc]); \
    ks0 = *reinterpret_cast<const bf16x8*>(&Kh[(size_t)((k0) + sr) * PN + sc]); ks1 = *reinterpret_cast<const bf16x8*>(&Kh[(size_t)((k0) + 32 + sr) * PN + sc]); } while (0)
#define SBA_SWRITE(bo) do { asm volatile("s_waitcnt vmcnt(0)" ::: "memory"); *(bf16x8*)(V_lds + (bo) + vst0) = vs0; *(bf16x8*)(V_lds + (bo) + vst1) = vs1; const int kc = sc * 2; \
    *(bf16x8*)(K_lds + (bo) + SBA_KSWZ(sr, kc)) = ks0; *(bf16x8*)(K_lds + (bo) + SBA_KSWZ(32 + sr, kc)) = ks1; } while (0)
    const int NT = 4 * (qb + 1);
    const int qrel = wid * 32 + r32;
    SBA_SLOAD((NT - 1) * 64); SBA_SWRITE(0); __syncthreads();
    for (int i = 0; i < NT; ++i) {
        const int bo = (i & 1) * SHM_V;
        if (i + 1 < NT) SBA_SLOAD((NT - 2 - i) * 64);
        SBA_SBAR();
        const bool alive = __any(R != 0.0f);
        const bool active = alive && ((i >= 4) || (64 * (3 - i) < 32 * wid + 31));
        if (active) {
            f32x16 p0, p1; bf16x8 pa0, pa1, pa2, pa3;
            qkt(p0, p1, K_lds + bo, qr, r32, hi);
            sig_part(p0, p1, (i < 4) && (64 * (3 - i) + 63 >= 32 * wid), 64 * (3 - i) - qrel, hi);
            finish(p0, p1, R, hi, pa0, pa1, pa2, pa3); SBA_SBAR();
            pv_d0(o, vb0 + bo, pa0, pa1, pa2, pa3);
        }
        SBA_SBAR();
        if (i + 1 < NT) SBA_SWRITE(SHM_V - bo);
        if (!__syncthreads_or((int)(i < 3 || __any(R != 0.0f)))) break;
    }
    bf16* Ow = Ob + (size_t)(wid * 32) * PN;
#pragma unroll
    for (int r = 0; r < 16; ++r) { const int orow = crow(r, hi);
#pragma unroll
        for (int d0 = 0; d0 < 4; ++d0) if (!dry) Ow[(size_t)orow * PN + d0 * 32 + r32] = (bf16)f2bf(o[d0][r]); }
    __syncthreads();
#undef SBA_SLOAD
#undef SBA_SWRITE
}
}
__device__ __forceinline__ void sb_attn_pair(Frame& F, int item) {
    const int tid = opaque_tid();
    const int bh = item >> 2, p = item & 3, b = bh >> 3, h = bh & 7;
    const bf16* Kh = F.PROJ + (size_t)(b * T) * PN + OFF_SK + h * 128; const bf16* Vh = F.PROJ + (size_t)(b * T) * PN + OFF_SV + h * 128;
    bf16* Qh = F.PROJ + (size_t)(b * T) * PN + OFF_SQ + h * 128;
#pragma nounroll
    for (int u = 0; u < 2; ++u) { const int qb = u ? p : 7 - p; sba::unit(Qh + (size_t)(qb * 256) * PN, Kh, Vh, Qh + (size_t)(qb * 256) * PN, qb, (char*)F.ldsg, tid, F.dry); }
}

__device__ __forceinline__ Frame make_frame(const Args& args, LAS unsigned char* lds, unsigned char* ldsg) {
    Frame F; unsigned char* ws = args.ws; float* out = args.out;
    { size_t z = 0; asm volatile("" : "+s"(z)); ws += z; out += z; }
    F.lds = lds; F.ldsg = ldsg; F.tid = opaque_tid(); F.lane = F.tid & 63; F.wave = __builtin_amdgcn_readfirstlane(F.tid >> 6);
    F.G = gridDim.x; F.bid = blockIdx.x; F.out = out; F.ws = ws; F.dry = false;
    F.XN = (bf16*)(ws + WS_XN); F.XC = (bf16*)(ws + WS_XC); F.U = (bf16*)(ws + WS_U); F.KE = (bf16*)(ws + WS_KE); F.VT = (bf16*)(ws + WS_VT); F.PROJ = (bf16*)(ws + WS_PROJ);
    F.DECAY = (float*)(ws + WS_DECAY); F.SSQ = (float*)(ws + WS_SSQ);
    return F;
}
__global__ void __launch_bounds__(512, 2) trunk_fwd(Args args) {
    extern __shared__ __attribute__((aligned(16))) unsigned char lds_raw[];
    LAS unsigned char* const lds = (LAS unsigned char*)lds_raw;
    volatile LAS unsigned* MISC = (volatile LAS unsigned*)(lds + MISC_OFF);
    if (threadIdx.x < 32) MISC[threadIdx.x] = 0u;
    __syncthreads();
    const int lo = args.ph_lo, hi = args.ph_hi;
    XcdBarrier bar; bar.bar = (unsigned*)(args.ws + WS_CTL) + CW_BAR; bar.x = 0; bar.st = MISC + 8;
    if (hi - lo > 1) bar = xcd_barrier_post((unsigned*)(args.ws + WS_CTL) + CW_BAR, MISC + 8);
#ifndef PH_MASK
#define PH_MASK 0xfff
#endif
#define IN(k) (lo <= (k) && (k) < hi)
#define EN(k) ((PH_MASK >> (k)) & 1)
#define SEAM(k) do { if (IN(k) && IN((k) + 1)) { xcd_barrier(bar); if ((PROBE_MASK >> 12) & 1) xcd_barrier(bar); } } while (0)
#define PROBE_MASK 0
#ifndef PROBE_MASK
#define PROBE_MASK 0
#endif
#define FRAME() Frame F = make_frame(args, lds, lds_raw); F.dry = (PROBE_MASK != 0) && (rep == 0) && (args.ph_hi < (1 << 30))
#define REPS(k) _Pragma("unroll") for (int rep = ((PROBE_MASK >> (k)) & 1) ? 0 : 1; rep < 2; ++rep)
#define WL(F) ((F).ws + WS_W + (size_t)l * WL_STRIDE)
#define ROW_PARTIALS(WSOFF) do { __syncthreads(); pg8::Unit u_; if (S.next(0, u_) && F.tid < 256 && !F.dry) { const LAS float* xs_ = (const LAS float*)(F.lds + 131072); \
    ((float*)(F.ws + (WSOFF)))[(size_t)(u_.pm * 256 + F.tid) * 4 + u_.pn] = (xs_[F.tid] + xs_[256 + F.tid]) + (xs_[512 + F.tid] + xs_[768 + F.tid]); } __syncthreads(); } while (0)

    if (IN(0)) REPS(11) { FRAME(); phase_convert(F, args); phase_input_rows(F, as_global(args.in[0])); }
    SEAM(0);
    for (int l = 0; l < DEPTH; ++l) {
        const int p0 = 1 + l * NP;
        if (EN(1) && IN(p0 + 1)) REPS(1) { FRAME();
            pg8::Gemm g{D, D, D}; SchedProj S; S.base.init(F.XN, WL(F) + WL_IN, D, D, M, PN, F.G, F.bid);
            EpiProj E{F.PROJ, F.VT, (const float*)(F.ws + WS_PARTB)};
            pg8::gemm_phase<EpiProj, SchedProj, true, true>(F.lds, g, S, E);
        }
        SEAM(p0 + 1);
        if (EN(2) && IN(p0 + 2)) REPS(2) { FRAME(); phase_prep(F, args, l); }
        SEAM(p0 + 2);
        if (EN(3) && IN(p0 + 3)) REPS(3) { FRAME();
            pg8::Gemm g{D, 256, 256}; SchedLru S{(const char*)F.XC, (const char*)(WL(F) + WL_G), F.G, F.bid};
            EpiLru E{F.XC, F.PROJ + OFF_LX, PN, F.U, as_global(args.in[9]) + (size_t)l * D, as_global(args.in[11]) + (size_t)l * D, (const float*)(F.ws + WS_SPL)};
            pg8::gemm_phase<EpiLru, SchedLru, true, true>(F.lds, g, S, E);
            for (int it = F.bid; it < 256; it += F.G) gla::pass1_item(F, it);
        }
        SEAM(p0 + 3);
        if (EN(4) && IN(p0 + 4)) REPS(4) {
            { REPS(13) { FRAME(); for (int it = F.bid; it < 256; it += F.G) gla::pass2_item(F, as_global(args.in[5]) + (size_t)l * 256, it); } }
            __syncthreads();
            { REPS(14) { FRAME(); for (int it = F.bid; it < 256; it += F.G) lru_scan_item(F, it); } }
            __syncthreads();
            { REPS(15) { FRAME(); for (int it = F.bid; it < 256; it += F.G) sb_attn_pair(F, it); } }
        }
        SEAM(p0 + 4);
        if (EN(6) && IN(p0 + 6)) REPS(6) { FRAME();
            pg8::Gemm g{PN, D, D}; SchedBranch S{(const char*)F.PROJ, (const char*)(WL(F) + WL_BR), F.G, F.bid};
            EpiBranch E{F.PROJ, as_global(args.in[18]) + (size_t)l * 3072, F.U};
            pg8::gemm_phase<EpiBranch, SchedBranch, true, true>(F.lds, g, S, E);
        }
        SEAM(p0 + 6);
        if (EN(7) && IN(p0 + 7)) REPS(7) { FRAME();
            pg8::Gemm g{D, D, D}; pg8::SchedStd S; S.init(F.U, WL(F) + WL_OUT, D, D, M, D, F.G, F.bid);
            pg8::EpiResF32 E{(l == 0) ? as_global(args.in[0]) : (const float*)F.out, F.out, D, F.dry, F.XN, (LAS float*)(F.lds + 131072)};
            pg8::gemm_phase<pg8::EpiResF32, pg8::SchedStd, false, true>(F.lds, g, S, E);
            ROW_PARTIALS(WS_PARTA);
        }
        SEAM(p0 + 7);
        if (EN(9) && IN(p0 + 9)) REPS(9) { FRAME();
            pg8::Gemm g{D, D, D}; pg8::SchedStd S; S.init(F.XN, WL(F) + WL_UP, D, D, M, FF, F.G, F.bid);
            pg8::EpiBf16<1> E{F.PROJ, FF, (const float*)(F.ws + WS_PARTA)};
            pg8::gemm_phase<pg8::EpiBf16<1>, pg8::SchedStd, true, true>(F.lds, g, S, E);
        }
        SEAM(p0 + 9);
        if (EN(10) && IN(p0 + 10)) REPS(10) { FRAME();
            pg8::Gemm g{FF, FF, FF}; pg8::SchedStd S; S.init(F.PROJ, WL(F) + WL_DN, FF, FF, M, D, F.G, F.bid);
            pg8::EpiResF32 E{F.out, F.out, D, F.dry, F.XN, (LAS float*)(F.lds + 131072)};
            pg8::gemm_phase<pg8::EpiResF32, pg8::SchedStd, false, true>(F.lds, g, S, E);
            ROW_PARTIALS(WS_PARTB);
        }
        SEAM(p0 + 10);
    }
#undef IN
#undef SEAM
}

extern "C" void kernel_launch(void* const* d_in, const int* in_sizes, int n_in, void* d_out, int out_size, void* d_ws, size_t ws_size, hipStream_t stream) {
    static int grid = 0;
    if (grid == 0) {
        if (n_in != 23 || out_size != M * D || ws_size < WS_END) { fprintf(stderr, "kernel_launch: unexpected shapes / workspace (n_in %d, out %d, ws %zu, need %zu)\n", n_in, out_size, ws_size, (size_t)WS_END); grid = -1; return; }
        int dev = 0, cus = 0, per_cu = 0;
        if (hipGetDevice(&dev) != hipSuccess || hipDeviceGetAttribute(&cus, hipDeviceAttributeMultiprocessorCount, dev) != hipSuccess) { grid = -1; return; }
        if (hipFuncSetAttribute((const void*)trunk_fwd, hipFuncAttributeMaxDynamicSharedMemorySize, LDS_BYTES) != hipSuccess) { grid = -1; return; }
        if (hipOccupancyMaxActiveBlocksPerMultiprocessor(&per_cu, (const void*)trunk_fwd, 512, LDS_BYTES) != hipSuccess || per_cu < 1) fprintf(stderr, "kernel_launch: occupancy query says %d\n", per_cu);
        (void)hipGetLastError();
        grid = cus;
    }
    if (grid < 0) return;
    (void)hipMemsetAsync((char*)d_ws + WS_CTL, 0, CTL_ZERO_BYTES, stream);
    Args a{};
    for (int i = 0; i < 23; ++i) a.in[i] = (const float*)d_in[i];
    a.out = (float*)d_out; a.ws = (unsigned char*)d_ws;
#if MK_ONE_LAUNCH
    a.ph_lo = 0; a.ph_hi = NPH;
    hipLaunchKernelGGL(trunk_fwd, dim3(grid), dim3(512), LDS_BYTES, stream, a);
#else
    for (int p = 0; p < NPH; ++p) { a.ph_lo = p; a.ph_hi = p + 1; hipLaunchKernelGGL(trunk_fwd, dim3(grid), dim3(512), LDS_BYTES, stream, a); }
#endif
}
```

```cpp
#include <hip/hip_runtime.h>
#include <cstdio>

#ifndef PROBE_SUB
#define PROBE_SUB 0
#endif
#ifndef PROBE_BUILD
#define PROBE_BUILD 0
#endif
#ifndef MK_ONE_LAUNCH
#define MK_ONE_LAUNCH 1
#endif

#define LAS __attribute__((address_space(3)))
#define GAS __attribute__((address_space(1)))
typedef unsigned short bf16;
typedef unsigned v4u __attribute__((ext_vector_type(4)));
typedef unsigned v2u __attribute__((ext_vector_type(2)));
typedef float f32x4 __attribute__((ext_vector_type(4)));
typedef float f32x2 __attribute__((ext_vector_type(2)));
typedef short bf16x8 __attribute__((ext_vector_type(8)));

constexpr int D = 1024, BATCH = 8, T = 2048, M = BATCH * T, DEPTH = 4, FF = 4096;
constexpr int SRC_COLS = 11280;
constexpr int PN = 11264;
constexpr int OFF_GQ = 0, OFF_GK = 512, OFF_GV = 1024, OFF_GG = 2048, OFF_LX = 3072, OFF_LG = 4096, OFF_SQ = 5120, OFF_SK = 6144, OFF_SV = 7168, OFF_GATE = 8192;
constexpr int SRC_GDOWN = 3072;
constexpr float EPS = 1e-6f;
constexpr int NP = 11;
constexpr int NPH = 1 + DEPTH * NP;

constexpr size_t MiB = 1u << 20;
constexpr size_t WS_CTL = 0, CTL_ZERO_BYTES = 64 * 1024;
constexpr size_t WS_DECAY = 1 * MiB;
constexpr size_t WS_WDT = 1536 * 1024;
constexpr size_t WS_SSQ = 2 * MiB;
constexpr size_t WS_PARTA = 2 * MiB;
constexpr size_t WS_PARTB = 3 * MiB;
constexpr size_t WS_SPL = 512 * 1024;
constexpr size_t WS_W = 4 * MiB;
constexpr size_t WL_IN = 0, WL_BR = 22 * MiB, WL_OUT = 28 * MiB, WL_UP = 30 * MiB, WL_DN = 38 * MiB, WL_G = 46 * MiB, WL_STRIDE = 47 * MiB;
constexpr size_t WS_XN = 192 * MiB;
constexpr size_t WS_XC = 224 * MiB;
constexpr size_t WS_U = 256 * MiB;
constexpr size_t WS_KE = 288 * MiB;
constexpr size_t WS_VT = 304 * MiB;
constexpr size_t WS_PROJ = 336 * MiB;
constexpr size_t WS_END = WS_PROJ + (size_t)M * PN * 2;
static_assert(WS_W + DEPTH * WL_STRIDE <= WS_XN, "ws map");
constexpr int CW_BAR = 1024;

constexpr int RING_BYTES = 131072;
constexpr int MISC_OFF = 147456 - 256;
constexpr int LDS_BYTES = 147456;

template <class Tp> __device__ __forceinline__ Tp* as_global(Tp* p) {
#if defined(__HIP_DEVICE_COMPILE__)
    __builtin_assume(!__builtin_amdgcn_is_shared((const __attribute__((address_space(0))) void*)p) && !__builtin_amdgcn_is_private((const __attribute__((address_space(0))) void*)p));
#endif
    return p; }
__device__ __forceinline__ float bf2f(unsigned b) { return __uint_as_float(b << 16); }
__device__ __forceinline__ unsigned f2bf(float f) { unsigned u = __float_as_uint(f); return (u + 0x7fffu + ((u >> 16) & 1u)) >> 16; }
__device__ __forceinline__ unsigned pk2(float lo, float hi) { return f2bf(lo) | (f2bf(hi) << 16); }
__device__ __forceinline__ float blo(unsigned w) { return __uint_as_float(w << 16); }
__device__ __forceinline__ float bhi(unsigned w) { return __uint_as_float(w & 0xffff0000u); }
__device__ __forceinline__ float shx(float v, int o, int lane) { return __int_as_float(__builtin_amdgcn_ds_bpermute((lane ^ o) << 2, __float_as_int(v))); }
__device__ __forceinline__ float wave_sum(float v, int lane) {
#pragma unroll
    for (int o = 1; o < 64; o <<= 1) v += shx(v, o, lane);
    return v;
}
__device__ __forceinline__ float sigmoidf_(float x) { return 1.f / (1.f + __expf(-x)); }
__device__ __forceinline__ float logsigmoidf_(float x) { return fminf(x, 0.f) - log1pf(__expf(-fabsf(x))); }
#define LDS_WAIT() asm volatile("s_waitcnt lgkmcnt(0)" ::: "memory")
__device__ __forceinline__ int opaque_tid() { int t = threadIdx.x; asm volatile("" : "+v"(t)); return t; }

#define XB_TMO      128
#define XB_XCNT(j)  (256  + 64 * (j))
#define XB_XSUB(j)  (1280 + 64 * (j))
#define XB_XGEN(j)  (2304 + 64 * (j))
#define XB_TOP      3328
#define XB_TOPGEN   3392
#define XCD_BAR_WORDS 3456
#define XB_SPIN_CAP (1u << 18)
__device__ __forceinline__ unsigned xb_ld(unsigned* p)              { return __hip_atomic_load(p, __ATOMIC_RELAXED, __HIP_MEMORY_SCOPE_AGENT); }
__device__ __forceinline__ unsigned xb_add(unsigned* p, unsigned v) { return __hip_atomic_fetch_add(p, v, __ATOMIC_RELAXED, __HIP_MEMORY_SCOPE_AGENT); }
__device__ __forceinline__ unsigned xb_xcc_id() { return (unsigned)__builtin_amdgcn_s_getreg((3 << 11) | 20) & 0xFu; }
#define XB_SPIN(cond, bar) do { unsigned _sp = 0; while (cond) { __builtin_amdgcn_s_sleep(1); \
    if ((++_sp & 255u) == 0u) { if (xb_ld(&(bar)[XB_TMO])) break; if (_sp > XB_SPIN_CAP) { atomicAdd(&(bar)[XB_TMO], 1u); break; } } } } while (0)
struct XcdBarrier { unsigned* bar; unsigned x; volatile LAS unsigned* st; };
__device__ __forceinline__ XcdBarrier xcd_barrier_post(unsigned* bar, volatile LAS unsigned* st) {
    XcdBarrier b; b.bar = bar; b.x = xb_xcc_id(); b.st = st;
    if (threadIdx.x == 0) (void)xb_add(&bar[XB_XCNT(b.x)], 1u);
    return b;
}
__device__ __forceinline__ void xcd_barrier_complete(unsigned* bar, unsigned x, unsigned& nloc, unsigned& nx) {
    const unsigned G = gridDim.x * gridDim.y * gridDim.z;
    unsigned sum, cnt, mine, sp = 0u;
    for (;;) {
        sum = 0u; cnt = 0u; mine = 0u;
#pragma unroll
        for (unsigned j = 0; j < 16; ++j) { const unsigned c = xb_ld(&bar[XB_XCNT(j)]); sum += c; cnt += (c > 0u) ? 1u : 0u; mine = (j == x) ? c : mine; }
        if (sum == G) break;
        __builtin_amdgcn_s_sleep(1);
        if ((++sp & 255u) == 0u) { if (xb_ld(&bar[XB_TMO])) break; if (sp > XB_SPIN_CAP) { atomicAdd(&bar[XB_TMO], 1u); break; } }
    }
    nloc = mine > 0u ? mine : 1u; nx = cnt > 0u ? cnt : 1u;
}
__device__ __forceinline__ void xcd_barrier(const XcdBarrier& b) {
    asm volatile("s_waitcnt vmcnt(0)" ::: "memory");
    __syncthreads();
    if (threadIdx.x == 0) {
        unsigned* bar = b.bar; asm volatile("" : "+s"(bar));
        __builtin_amdgcn_s_waitcnt(0);
        unsigned nloc = b.st[0], nx = b.st[1];
        if (nloc == 0u) { xcd_barrier_complete(bar, b.x, nloc, nx); b.st[0] = nloc; b.st[1] = nx; }
        const unsigned old = xb_add(&bar[XB_XSUB(b.x)], 1u);
        const unsigned gen = old / nloc;
        if (old + 1u == (gen + 1u) * nloc) {
            __builtin_amdgcn_fence(__ATOMIC_RELEASE, "agent");
            asm volatile("s_waitcnt vmcnt(0)" ::: "memory");
            const unsigned og = xb_add(&bar[XB_TOP], 1u);
            const unsigned tg = og / nx;
            if (og + 1u == (tg + 1u) * nx) xb_add(&bar[XB_TOPGEN], 1u);
            else XB_SPIN(xb_ld(&bar[XB_TOPGEN]) == tg, bar);
            __builtin_amdgcn_fence(__ATOMIC_ACQUIRE, "agent");
            xb_add(&bar[XB_XGEN(b.x)], 1u);
            asm volatile("s_waitcnt vmcnt(0)" ::: "memory");
        } else {
            XB_SPIN(xb_ld(&bar[XB_XGEN(b.x)]) == gen, bar);
            __builtin_amdgcn_fence(__ATOMIC_ACQUIRE, "agent");
            asm volatile("s_waitcnt vmcnt(0)" ::: "memory");
        }
    }
    __syncthreads();
}

namespace pg8 {
constexpr int BM = 256, BK = 64, HALF = 128, HTB = HALF * BK * 2, STAGE_BYTES = 8 * HTB, NXCD = 8, WGM = 8;
__host__ __device__ __forceinline__ int lds_byte(int r, int c) { const int st = (r >> 4) * 2 + (c >> 5), rr = r & 15, cc = c & 31, ob = rr * 64 + cc * 2; return st * 1024 + (ob ^ (((ob >> 9) & 1) << 5)); }
__host__ __device__ __forceinline__ void stage_rc(int b, int& R, int& C) { const int st = b / 1024, sb = b % 1024, swz = sb ^ (((sb >> 9) & 1) << 5); R = (st >> 1) * 16 + swz / 64; C = (st & 1) * 32 + (swz % 64) / 2; }
__host__ __device__ __forceinline__ int perm32(int rho) { const int n = rho >> 4, i = rho & 15; return 8 * (i >> 2) + 4 * n + (i & 3); }
struct Unit { int pm, pn, aux; };
struct Gemm { int lda, ldb, K; };
__device__ __forceinline__ unsigned cvt_pk_bf16(float lo, float hi) { unsigned r; asm volatile("v_cvt_pk_bf16_f32 %0, %1, %2" : "=v"(r) : "v"(lo), "v"(hi)); return r; }

struct SchedStd {
    const char* A; const char* B; size_t tstepA, tstepB; int nM, nN, nwg, G, c;
    __device__ __forceinline__ void init(const void* A_, const void* B_, int lda, int ldb, int Mr, int Nc, int G_, int c_) { A = (const char*)A_; B = (const char*)B_; tstepA = (size_t)BM * lda * 2; tstepB = (size_t)BM * ldb * 2; nM = Mr / BM; nN = Nc / BM; nwg = nM * nN; G = G_; c = c_; }
    __device__ __forceinline__ bool next(int i, Unit& u) const {
        const long L = (long)i * G + c; if (L >= nwg) return false;
        int wgid = (int)L; { const int q = nwg / NXCD, r = nwg % NXCD, xcd = wgid % NXCD, off = wgid / NXCD; wgid = (xcd < r ? xcd * (q + 1) : r * (q + 1) + (xcd - r) * q) + off; }
        const int nig = WGM * nN, gid = wgid / nig, fm = gid * WGM, gsz = (nM - fm) < WGM ? (nM - fm) : WGM;
        u.pm = fm + ((wgid % nig) % gsz); u.pn = (wgid % nig) / gsz; u.aux = 0; return true;
    }
    __device__ __forceinline__ const char* abase(const Unit& u) const { return A + (size_t)u.pm * tstepA; }
    __device__ __forceinline__ const char* bbase(const Unit& u) const { return B + (size_t)u.pn * tstepB; }
};

template <class Epi, class Sched, bool ALIGN_EPI, bool SP2>
__device__ __forceinline__ void gemm_phase(LAS unsigned char* lds, const Gemm g, const Sched& S, const Epi& E) {
    const int tid = opaque_tid(), wid = __builtin_amdgcn_readfirstlane(tid >> 6), lane = tid & 63, wr = wid >> 2, wc = wid & 3, fr = lane & 15, fq = lane >> 4;
    const int K = g.K, nt = K / BK;
    unsigned voffA[2], voffB[2];
#pragma unroll
    for (int i = 0; i < 2; ++i) { int R, C; stage_rc(tid * 16 + i * 8192, R, C); const int Rb = Epi::PERM ? ((R & ~31) + perm32(R & 31)) : R;
        voffA[i] = (unsigned)(R * g.lda + C) * 2u; voffB[i] = (unsigned)(Rb * g.ldb + C) * 2u; }
    const size_t kstep = (size_t)(BK * 2);
    const size_t hstepA = (size_t)HALF * g.lda * 2, hstepB = (size_t)HALF * g.ldb * 2;
    const unsigned ldsw = (unsigned)wid * 1024u;
    const int aoff = lds_byte(wr * 64 + fr, fq * 8), boff = lds_byte(wc * 32 + fr, fq * 8);
#define PG8_SA(b, h) (((b) * 2 + (h)) * HTB)
#define PG8_SB(b, h) ((4 + (b) * 2 + (h)) * HTB)
#define PG8_STAGE(bufoff, gbase, voff) do { _Pragma("unroll") for (int _i = 0; _i < 2; ++_i) \
        __builtin_amdgcn_global_load_lds((const unsigned*)((const char*)(gbase) + (voff)[_i]), (LAS unsigned*)(lds + (bufoff) + ldsw + _i * 8192), 16, 0, 0); } while (0)
#define PG8_LDA(dst, b, h) do { _Pragma("unroll") for (int m = 0; m < 4; ++m) _Pragma("unroll") for (int k = 0; k < 2; ++k) dst[m][k] = *(const LAS bf16x8*)(lds + PG8_SA(b, h) + aoff + m * 2048 + k * 1024); } while (0)
#define PG8_LDB(dst, b, h) do { _Pragma("unroll") for (int n = 0; n < 2; ++n) _Pragma("unroll") for (int k = 0; k < 2; ++k) dst[n][k] = *(const LAS bf16x8*)(lds + PG8_SB(b, h) + boff + n * 2048 + k * 1024); } while (0)
#define PG8_MMA(ai, bj, At, Bt) do { __builtin_amdgcn_s_setprio(1); _Pragma("unroll") for (int m = 0; m < 4; ++m) _Pragma("unroll") for (int n = 0; n < 2; ++n) _Pragma("unroll") for (int k = 0; k < 2; ++k) \
        acc[ai][bj][m][n] = __builtin_amdgcn_mfma_f32_16x16x32_bf16(Bt[n][k], At[m][k], acc[ai][bj][m][n], 0, 0, 0); __builtin_amdgcn_s_setprio(0); } while (0)
#define PG8_WAIT_V(n) asm volatile("s_waitcnt vmcnt(" #n ")" ::: "memory")
#define PG8_WAIT_L(n) asm volatile("s_waitcnt lgkmcnt(" #n ")" ::: "memory")
#define PG8_BAR __builtin_amdgcn_s_barrier()
#define PG8_SCHED __builtin_amdgcn_sched_barrier(0)
    Unit cur, nxt; int ui = 0;
    if (!S.next(0, cur)) return;
    f32x4 acc[2][2][4][2];
#pragma unroll
    for (int a = 0; a < 2; ++a)
#pragma unroll
        for (int b = 0; b < 2; ++b)
#pragma unroll
            for (int m = 0; m < 4; ++m)
#pragma unroll
                for (int n = 0; n < 2; ++n) acc[a][b][m][n] = (f32x4){0.f, 0.f, 0.f, 0.f};
    bf16x8 At[4][2], B0[2][2], B1[2][2];
    const char* cA = S.abase(cur); const char* cB = S.bbase(cur);
    LAS float* const xrs = (LAS float*)(lds + 131072 + 4096);
    f32x4 rsreg = {0.f, 0.f, 0.f, 0.f};
    if constexpr (Epi::ROW_RS) { if (tid < 256) { rsreg = *(const f32x4*)(E.part + (size_t)(cur.pm * BM + tid) * 4); xrs[tid] = __builtin_amdgcn_rsqf(((rsreg.x + rsreg.y) + (rsreg.z + rsreg.w)) * (1.f / 1024.f) + 1e-6f); } }
    if constexpr (SP2) {
        PG8_STAGE(PG8_SB(0, 0), cB, voffB); PG8_STAGE(PG8_SB(0, 1), cB + hstepB, voffB); PG8_STAGE(PG8_SA(0, 0), cA, voffA); PG8_STAGE(PG8_SA(0, 1), cA + hstepA, voffA);
        if (wr == 1) PG8_BAR;
        PG8_WAIT_V(2); PG8_BAR;
        PG8_STAGE(PG8_SB(1, 0), cB + kstep, voffB); PG8_STAGE(PG8_SA(1, 0), cA + kstep, voffA); PG8_STAGE(PG8_SB(1, 1), cB + hstepB + kstep, voffB);
        PG8_WAIT_V(6); PG8_BAR;
    } else {
        PG8_STAGE(PG8_SB(0, 0), cB, voffB); PG8_STAGE(PG8_SA(0, 0), cA, voffA); PG8_STAGE(PG8_SB(0, 1), cB + hstepB, voffB); PG8_STAGE(PG8_SA(0, 1), cA + hstepA, voffA);
        if (wr == 1) PG8_BAR;
        PG8_WAIT_V(4); PG8_BAR;
        PG8_STAGE(PG8_SB(1, 0), cB + kstep, voffB); PG8_STAGE(PG8_SA(1, 0), cA + kstep, voffA); PG8_STAGE(PG8_SB(1, 1), cB + hstepB + kstep, voffB);
        PG8_WAIT_V(6); PG8_BAR;
    }
    for (;;) {
        const bool has_next = S.next(ui + 1, nxt);
        const char* nA = has_next ? S.abase(nxt) : cA; const char* nB = has_next ? S.bbase(nxt) : cB;
        if constexpr (Epi::ROW_RS) { if (has_next && tid < 256) rsreg = *(const f32x4*)(E.part + (size_t)(nxt.pm * BM + tid) * 4); }
#pragma nounroll
        for (int t = 0; t < nt; t += 2) {
            const bool last = (t == nt - 2);
            const char* a1 = cA + (size_t)(t + 1) * kstep;
            const char* a2 = last ? nA : cA + (size_t)(t + 2) * kstep; const char* b2 = last ? nB : cB + (size_t)(t + 2) * kstep;
            const char* a3 = a2 + kstep; const char* b3 = b2 + kstep;
            if constexpr (SP2) {
            PG8_LDB(B0, 0, 0); PG8_LDB(B1, 0, 1); PG8_SCHED; PG8_LDA(At, 0, 0); PG8_STAGE(PG8_SA(1, 1), a1 + hstepA, voffA);
            PG8_WAIT_V(8); PG8_WAIT_L(0); PG8_BAR; PG8_MMA(0, 0, At, B0); PG8_MMA(0, 1, At, B1); PG8_BAR; PG8_SCHED;
            PG8_LDA(At, 0, 1); PG8_STAGE(PG8_SB(0, 0), b2, voffB); PG8_STAGE(PG8_SB(0, 1), b2 + hstepB, voffB); PG8_STAGE(PG8_SA(0, 0), a2, voffA);
            PG8_WAIT_V(8); PG8_WAIT_L(0); PG8_BAR; PG8_MMA(1, 0, At, B0); PG8_MMA(1, 1, At, B1); PG8_BAR; PG8_SCHED;
            PG8_LDB(B0, 1, 0); PG8_LDB(B1, 1, 1); PG8_SCHED; PG8_LDA(At, 1, 0); PG8_STAGE(PG8_SA(0, 1), a2 + hstepA, voffA);
            PG8_WAIT_V(8); PG8_WAIT_L(0); PG8_BAR; PG8_MMA(0, 0, At, B0); PG8_MMA(0, 1, At, B1); PG8_BAR; PG8_SCHED;
            PG8_LDA(At, 1, 1); PG8_STAGE(PG8_SB(1, 0), b3, voffB); PG8_STAGE(PG8_SB(1, 1), b3 + hstepB, voffB); PG8_STAGE(PG8_SA(1, 0), a3, voffA);
            PG8_WAIT_V(8); PG8_WAIT_L(0); PG8_BAR; PG8_MMA(1, 0, At, B0); PG8_MMA(1, 1, At, B1); PG8_BAR; PG8_SCHED;
            } else {
            PG8_LDB(B0, 0, 0); PG8_SCHED; PG8_LDA(At, 0, 0); PG8_STAGE(PG8_SA(1, 1), a1 + hstepA, voffA);
            PG8_WAIT_L(8); PG8_BAR; PG8_WAIT_L(0); PG8_MMA(0, 0, At, B0); PG8_BAR; PG8_SCHED;
            PG8_LDB(B1, 0, 1); PG8_STAGE(PG8_SB(0, 0), b2, voffB);
            PG8_BAR; PG8_WAIT_L(0); PG8_MMA(0, 1, At, B1); PG8_BAR;
            PG8_LDA(At, 0, 1); PG8_STAGE(PG8_SA(0, 0), a2, voffA);
            PG8_BAR; PG8_WAIT_L(0); PG8_MMA(1, 0, At, B0); PG8_BAR; PG8_SCHED;
            PG8_STAGE(PG8_SB(0, 1), b2 + hstepB, voffB);
            PG8_WAIT_V(6); PG8_BAR; PG8_MMA(1, 1, At, B1); PG8_BAR;
            PG8_LDB(B0, 1, 0); PG8_SCHED; PG8_LDA(At, 1, 0); PG8_STAGE(PG8_SA(0, 1), a2 + hstepA, voffA);
            PG8_WAIT_L(8); PG8_BAR; PG8_WAIT_L(0); PG8_MMA(0, 0, At, B0); PG8_BAR; PG8_SCHED;
            PG8_LDB(B1, 1, 1); PG8_STAGE(PG8_SB(1, 0), b3, voffB);
            PG8_BAR; PG8_WAIT_L(0); PG8_MMA(0, 1, At, B1); PG8_BAR;
            PG8_LDA(At, 1, 1); PG8_STAGE(PG8_SA(1, 0), a3, voffA);
            PG8_BAR; PG8_WAIT_L(0); PG8_MMA(1, 0, At, B0); PG8_BAR; PG8_SCHED;
            PG8_STAGE(PG8_SB(1, 1), b3 + hstepB, voffB);
            PG8_WAIT_V(6); PG8_BAR; PG8_MMA(1, 1, At, B1); PG8_BAR;
            }
        }
        if constexpr (Epi::ROW_RS) { if (has_next && tid < 256) xrs[((ui + 1) & 1) * 256 + tid] = __builtin_amdgcn_rsqf(((rsreg.x + rsreg.y) + (rsreg.z + rsreg.w)) * (1.f / 1024.f) + 1e-6f); }
        if constexpr (ALIGN_EPI) { if (wr == 0) PG8_BAR; }
        const bool zero = E(acc, cur, wr, wc, fr, fq, xrs + (ui & 1) * 256);
        if (!has_next) break;
        if (zero) {
#pragma unroll
        for (int a = 0; a < 2; ++a)
#pragma unroll
            for (int b = 0; b < 2; ++b)
#pragma unroll
                for (int m = 0; m < 4; ++m)
#pragma unroll
                    for (int n = 0; n < 2; ++n) acc[a][b][m][n] = (f32x4){0.f, 0.f, 0.f, 0.f};
        }
        cur = nxt; cA = nA; cB = nB; ++ui;
        if constexpr (ALIGN_EPI) { if (wr == 1) PG8_BAR; }
    }
    PG8_WAIT_V(0);
    if constexpr (!ALIGN_EPI) { if (wr == 0) PG8_BAR; }
    PG8_BAR;
#undef PG8_SA
#undef PG8_SB
#undef PG8_STAGE
#undef PG8_LDA
#undef PG8_LDB
#undef PG8_MMA
#undef PG8_WAIT_V
#undef PG8_WAIT_L
#undef PG8_BAR
#undef PG8_SCHED
}

__device__ __forceinline__ float row_rs(const float* part, int row) {
    const f32x4 a = *(const f32x4*)(part + (size_t)row * 4);
    return __builtin_amdgcn_rsqf(((a.x + a.y) + (a.z + a.w)) * (1.f / 1024.f) + 1e-6f);
}
template <int ACT> struct EpiBf16 {
    static constexpr bool PERM = true, ROW_RS = true;
    bf16* O; int ldc; const float* part;
    __device__ __forceinline__ bool operator()(f32x4 (&acc)[2][2][4][2], const Unit& u, int wr, int wc, int fr, int fq, const LAS float* xrs) const {
        const int row0 = u.pm * BM + wr * 64 + fr, col0 = u.pn * BM + wc * 32 + 8 * fq;
        float rsv[8];
#pragma unroll
        for (int i = 0; i < 8; ++i) rsv[i] = xrs[wr * 64 + fr + (i >> 2) * HALF + (i & 3) * 16];
#pragma unroll
        for (int ai = 0; ai < 2; ++ai)
#pragma unroll
            for (int m = 0; m < 4; ++m) { bf16* rowp = O + (size_t)(row0 + ai * HALF + m * 16) * ldc + col0; const float rs = rsv[ai * 4 + m];
#pragma unroll
                for (int bj = 0; bj < 2; ++bj) { f32x4 v0 = acc[ai][bj][m][0] * rs, v1 = acc[ai][bj][m][1] * rs;
                    if (ACT == 1) {
#pragma unroll
                        for (int j = 0; j < 4; ++j) { const float a = fmaxf(v0[j], 0.f), b = fmaxf(v1[j], 0.f); v0[j] = a * a; v1[j] = b * b; } }
                    v4u w; w.x = cvt_pk_bf16(v0[0], v0[1]); w.y = cvt_pk_bf16(v0[2], v0[3]); w.z = cvt_pk_bf16(v1[0], v1[1]); w.w = cvt_pk_bf16(v1[2], v1[3]);
                    __builtin_nontemporal_store(w, (v4u*)(rowp + bj * HALF)); } }
        return true;
    }
};
struct EpiResF32 {
    static constexpr bool PERM = false, ROW_RS = false;
    const float* base; float* out; int ldc; bool dry; bf16* xb; LAS float* xs;
    __device__ __forceinline__ bool operator()(f32x4 (&acc)[2][2][4][2], const Unit& u, int wr, int wc, int fr, int fq, const LAS float* xrs) const {
        const int row0 = u.pm * BM + wr * 64 + fr, col0 = u.pn * BM + wc * 32 + 4 * fq;
        f32x4 bs[2][4];
#define RES_LOAD(slot, gi) do { const size_t off_ = (size_t)(row0 + ((gi) >> 2) * HALF + ((gi) & 3) * 16) * ldc + col0; \
        bs[slot][0] = *(const f32x4*)(base + off_); bs[slot][1] = *(const f32x4*)(base + off_ + 16); bs[slot][2] = *(const f32x4*)(base + off_ + HALF); bs[slot][3] = *(const f32x4*)(base + off_ + HALF + 16); } while (0)
        RES_LOAD(0, 0);
#pragma unroll
        for (int gi = 0; gi < 8; ++gi) { const int ai = gi >> 2, m = gi & 3;
            if (gi < 7) RES_LOAD((gi + 1) & 1, gi + 1);
            const int row = row0 + ai * HALF + m * 16; const size_t off = (size_t)row * ldc + col0; float ss = 0.f;
#pragma unroll
            for (int bj = 0; bj < 2; ++bj)
#pragma unroll
                for (int n = 0; n < 2; ++n) { const f32x4 v = bs[gi & 1][bj * 2 + n] + acc[ai][bj][m][n];
                    ss += (v.x * v.x + v.y * v.y) + (v.z * v.z + v.w * v.w);
                    if (!dry) { *(f32x4*)(out + off + bj * HALF + n * 16) = v; v2u w; w.x = cvt_pk_bf16(v.x, v.y); w.y = cvt_pk_bf16(v.z, v.w); *(v2u*)(xb + off + bj * HALF + n * 16) = w; } }
            ss += __shfl_xor(ss, 16); ss += __shfl_xor(ss, 32);
            if (fq == 0) xs[wc * 256 + (row - u.pm * BM)] = ss; }
#undef RES_LOAD
        return true;
    }
};
}

struct Args { const float* in[23]; float* out; unsigned char* ws; int ph_lo, ph_hi, dry, pad; };

struct Frame {
    LAS unsigned char* lds; unsigned char* ldsg;
    int tid, lane, wave, G, bid; bool dry;
    float* out; unsigned char* ws;
    bf16 *XN, *XC, *U, *KE, *VT, *PROJ; float *DECAY, *SSQ;
};

__device__ __forceinline__ void transpose_item(const float* W, int ldw, int nblk, bf16* WT, int K, int row_off, LAS float* scr, int item, int lane, const float* gk = nullptr) {
    const int kb = item / nblk, nb = item % nblk, k0 = 64 * kb, n0 = 32 * nb;
#pragma unroll 8
    for (int i = 0; i < 32; ++i) { const int kk = 2 * i + (lane >> 5); scr[kk * 33 + (lane & 31)] = W[(size_t)(k0 + kk) * ldw + n0 + (lane & 31)] * (gk ? gk[k0 + kk] : 1.0f); }
    LDS_WAIT(); asm volatile("" ::: "memory");
    const int c = lane & 7;
#pragma unroll
    for (int j = 0; j < 4; ++j) { const int n = (lane >> 3) + 8 * j; const LAS float* s = scr + (8 * c) * 33 + n;
        v4u o; o.x = pk2(s[0 * 33], s[1 * 33]); o.y = pk2(s[2 * 33], s[3 * 33]); o.z = pk2(s[4 * 33], s[5 * 33]); o.w = pk2(s[6 * 33], s[7 * 33]);
        *(v4u*)(WT + (size_t)(row_off + n0 + n) * K + k0 + 8 * c) = o; }
    LDS_WAIT(); asm volatile("" ::: "memory");
}
__device__ __forceinline__ void phase_convert(Frame& F, const Args& A) {
    F.tid = opaque_tid(); F.lane = F.tid & 63;
    { bf16* wdt = (bf16*)(F.ws + WS_WDT);
      for (int idx = F.bid * 512 + F.tid; idx < DEPTH * 16 * D; idx += F.G * 512) { const int l = idx >> 14, n = (idx >> 10) & 15, k = idx & 1023;
          wdt[idx] = (bf16)f2bf(as_global(A.in[2])[((size_t)l * D + k) * SRC_COLS + SRC_GDOWN + n] * as_global(A.in[1])[(size_t)l * D + k]); } }
    LAS float* scr = (LAS float*)(F.lds + F.wave * 16384);
    const int gw = F.bid * 8 + F.wave, NGW = F.G * 8;
    constexpr int PER_L = 1536 + 4096 + 1536 + 512 + 2048 + 2048 + 256;
    for (int it = gw; it < DEPTH * PER_L; it += NGW) {
        const int l = it / PER_L; int r = it % PER_L;
        unsigned char* wl = F.ws + WS_W + (size_t)l * WL_STRIDE;
        const float* win = as_global(A.in[2]) + (size_t)l * D * SRC_COLS;
        if (r < 1536) { transpose_item(win, SRC_COLS, 96, (bf16*)(wl + WL_IN), D, 0, scr, r, F.lane, as_global(A.in[1]) + (size_t)l * D); continue; } r -= 1536;
        if (r < 4096) { transpose_item(win + 3088, SRC_COLS, 256, (bf16*)(wl + WL_IN), D, 3072, scr, r, F.lane, as_global(A.in[1]) + (size_t)l * D); continue; } r -= 4096;
        if (r < 1536) { const int br = r / 512; const float* wb = br == 0 ? as_global(A.in[15]) : (br == 1 ? as_global(A.in[16]) : as_global(A.in[17])); transpose_item(wb + (size_t)l * D * D, D, 32, (bf16*)(wl + WL_BR), D, br * 1024, scr, r % 512, F.lane); continue; } r -= 1536;
        if (r < 512) { transpose_item(as_global(A.in[19]) + (size_t)l * D * D, D, 32, (bf16*)(wl + WL_OUT), D, 0, scr, r, F.lane); continue; } r -= 512;
        if (r < 2048) { transpose_item(as_global(A.in[21]) + (size_t)l * D * FF, FF, 128, (bf16*)(wl + WL_UP), D, 0, scr, r, F.lane, as_global(A.in[20]) + (size_t)l * D); continue; } r -= 2048;
        if (r < 2048) { transpose_item(as_global(A.in[22]) + (size_t)l * D * FF, D, 32, (bf16*)(wl + WL_DN), FF, 0, scr, r, F.lane); continue; } r -= 2048;
        { const int mtx = r / 32, rr = r % 32, blk = mtx >> 1, gate = mtx & 1, n0 = (rr % 8) * 32;
          const int row_off = (blk * 2 + (n0 >> 7)) * 256 + gate * 128 + (n0 & 127) - n0;
          const float* w = (gate ? as_global(A.in[10]) : as_global(A.in[8])) + (size_t)l * 262144 + (size_t)blk * 65536;
          transpose_item(w, 256, 8, (bf16*)(wl + WL_G), 256, row_off, scr, rr, F.lane); }
    }
}

__device__ __forceinline__ void phase_input_rows(Frame& F, const float* x) {
    const int gw = F.bid * 8 + F.wave, NGW = F.G * 8;
    float* part = (float*)(F.ws + WS_PARTB);
    for (int m = gw; m < M; m += NGW) {
        const f32x4* xr = (const f32x4*)(x + (size_t)m * D) + F.lane;
        f32x4 v[4]; float s = 0.f;
#pragma unroll
        for (int j = 0; j < 4; ++j) { v[j] = xr[64 * j]; s += (v[j].x * v[j].x + v[j].y * v[j].y) + (v[j].z * v[j].z + v[j].w * v[j].w); }
        s = wave_sum(s, F.lane);
        v2u* o8 = (v2u*)(F.XN + (size_t)m * D) + F.lane;
#pragma unroll
        for (int j = 0; j < 4; ++j) { v2u w; w.x = pk2(v[j].x, v[j].y); w.y = pk2(v[j].z, v[j].w); o8[64 * j] = w; }
        if (F.lane < 4) part[(size_t)m * 4 + F.lane] = F.lane == 0 ? s : 0.f;
    }
}

__device__ __forceinline__ void phase_rmsnorm(Frame& F, const float* x, const float* g, bf16* out) {
    F.tid = opaque_tid(); F.lane = F.tid & 63;
    const int gw = F.bid * 8 + F.wave, NGW = F.G * 8;
    f32x4 gv[4];
#pragma unroll
    for (int j = 0; j < 4; ++j) gv[j] = *((const f32x4*)g + F.lane + 64 * j);
    for (int m = gw; m < M; m += NGW) {
        const f32x4* xr = (const f32x4*)(x + (size_t)m * D) + F.lane;
        f32x4 v[4]; float s = 0.f;
#pragma unroll
        for (int j = 0; j < 4; ++j) { v[j] = xr[64 * j]; s += (v[j].x * v[j].x + v[j].y * v[j].y) + (v[j].z * v[j].z + v[j].w * v[j].w); }
        const float rs = 1.0f / sqrtf(wave_sum(s, F.lane) * (1.f / D) + EPS);
        v2u* o8 = (v2u*)(out + (size_t)m * D) + F.lane;
#pragma unroll
        for (int j = 0; j < 4; ++j) { v2u w; w.x = pk2(v[j].x * rs * gv[j].x, v[j].y * rs * gv[j].y); w.y = pk2(v[j].z * rs * gv[j].z, v[j].w * rs * gv[j].w); o8[64 * j] = w; }
    }
}

__device__ __forceinline__ void phase_prep(Frame& F, const Args& A, int l) {
#define PSUB(n) (!PROBE_BUILD || A.pad == 0 || ((A.pad >> (n)) & 1))
    F.tid = opaque_tid(); F.lane = F.tid & 63;
    const int gt = F.bid * 512 + F.tid, NGT = F.G * 512;
    if (PSUB(0)) {
        const float* cw = as_global(A.in[6]) + (size_t)l * 4 * D; const float* cb = as_global(A.in[7]) + (size_t)l * D;
        const bf16* __restrict__ lxp = F.PROJ; bf16* __restrict__ xcp = F.XC;
#pragma unroll 4
        for (int idx = gt; idx < M * 128; idx += NGT) {
            const int m = idx >> 7, c0 = (idx & 127) * 8, t = m & (T - 1);
            float acc[8];
#pragma unroll
            for (int j = 0; j < 8; ++j) acc[j] = cb[c0 + j];
#pragma unroll
            for (int jj = 0; jj < 4; ++jj) {
                if (t - 3 + jj >= 0) {
                    const v4u xv = *(const v4u*)(lxp + (size_t)(m - 3 + jj) * PN + OFF_LX + c0);
                    const float* w = cw + jj * D + c0;
                    acc[0] += w[0] * blo(xv.x); acc[1] += w[1] * bhi(xv.x); acc[2] += w[2] * blo(xv.y); acc[3] += w[3] * bhi(xv.y);
                    acc[4] += w[4] * blo(xv.z); acc[5] += w[5] * bhi(xv.z); acc[6] += w[6] * blo(xv.w); acc[7] += w[7] * bhi(xv.w);
                }
            }
            v4u o; o.x = pk2(acc[0], acc[1]); o.y = pk2(acc[2], acc[3]); o.z = pk2(acc[4], acc[5]); o.w = pk2(acc[6], acc[7]);
            *(v4u*)(xcp + (size_t)m * D + c0) = o;
        }
    }
    if (F.bid == 0) { const float* lam = as_global(A.in[12]) + (size_t)l * D; float* spl = (float*)(F.ws + WS_SPL);
        for (int c = F.tid; c < D; c += 512) { const float nl = -lam[c]; spl[c] = fmaxf(nl, 0.f) + 0.6931471805599453f * __builtin_amdgcn_logf(1.0f + __builtin_amdgcn_exp2f(-1.4426950408889634f * fabsf(nl))); } }
    if (PSUB(3)) {
        LAS float* adp = (LAS float*)F.lds;
        LAS float* ad = adp + 2048;
        const bf16* wdt = (const bf16*)(F.ws + WS_WDT) + (size_t)l * 16 * D;
        const float* wup = as_global(A.in[3]) + (size_t)l * 16 * 512; const float* bal = as_global(A.in[4]) + (size_t)l * 512;
        for (int ch = F.bid; ch < M / 64; ch += F.G) {
            const int m0 = ch * 64;
            __syncthreads();
            { const int rg = F.wave & 3, kh = F.wave >> 2, l15 = F.lane & 15, q4 = F.lane >> 4;
              const bf16* ap = F.XN + (size_t)(m0 + 16 * rg + l15) * D + 512 * kh + 8 * q4; const bf16* bp = wdt + (size_t)l15 * D + 512 * kh + 8 * q4;
              f32x4 acc = {0.f, 0.f, 0.f, 0.f};
#pragma unroll 4
              for (int ks = 0; ks < 16; ++ks) acc = __builtin_amdgcn_mfma_f32_16x16x32_bf16(*reinterpret_cast<const bf16x8*>(ap + 32 * ks), *reinterpret_cast<const bf16x8*>(bp + 32 * ks), acc, 0, 0, 0);
#pragma unroll
              for (int r = 0; r < 4; ++r) adp[kh * 1024 + (16 * rg + 4 * q4 + r) * 16 + l15] = acc[r] * pg8::row_rs((const float*)(F.ws + WS_PARTB), m0 + 16 * rg + 4 * q4 + r); }
            __syncthreads();
            ad[F.tid] = adp[F.tid] + adp[1024 + F.tid]; ad[512 + F.tid] = adp[512 + F.tid] + adp[1536 + F.tid];
            __syncthreads();
            const int c = F.tid;
            float wu[16];
#pragma unroll
            for (int j = 0; j < 16; ++j) wu[j] = wup[j * 512 + c];
            const float ba = bal[c];
            float cum = 0.f;
            for (int t8 = 0; t8 < 64; t8 += 8) { float kv[8]; bf16 qin[8], kin[8];
#pragma unroll
              for (int tt = 0; tt < 8; ++tt) { qin[tt] = F.PROJ[(size_t)(m0 + t8 + tt) * PN + OFF_GQ + c]; kin[tt] = F.PROJ[(size_t)(m0 + t8 + tt) * PN + OFF_GK + c]; }
#pragma unroll
              for (int tt = 0; tt < 8; ++tt) { const int t = t8 + tt; float lg = ba;
#pragma unroll
                for (int j4 = 0; j4 < 4; ++j4) { const f32x4 a4 = *reinterpret_cast<const LAS f32x4*>(ad + t * 16 + 4 * j4); lg += a4.x * wu[4 * j4] + a4.y * wu[4 * j4 + 1] + a4.z * wu[4 * j4 + 2] + a4.w * wu[4 * j4 + 3]; }
                const float ax = fabsf(lg) * 1.4426950408889634f; const float l2 = __builtin_amdgcn_logf(1.0f + __builtin_amdgcn_exp2f(-ax));
                cum += (fminf(lg, 0.f) * 1.4426950408889634f - l2) * (1.f / 16.f);
                const float e = __builtin_amdgcn_exp2f(cum), ei = __builtin_amdgcn_rcpf(e);
                bf16* pq = F.PROJ + (size_t)(m0 + t) * PN + OFF_GQ + c; bf16* pk = F.PROJ + (size_t)(m0 + t) * PN + OFF_GK + c;
                const float q = bf2f(qin[tt]), k = bf2f(kin[tt]);
                kv[tt] = k * ei; if (!F.dry) { *pq = (bf16)f2bf(q * 0.08838834764831845f * e); *pk = (bf16)f2bf(kv[tt]); } }
              }
            F.DECAY[(size_t)ch * 512 + c] = __builtin_amdgcn_exp2f(cum);
        }
    }
}

struct SchedProj {
    pg8::SchedStd base;
    __device__ __forceinline__ bool next(int i, pg8::Unit& u) const { if (!base.next(i, u)) return false; u.aux = 0; return true; }
    __device__ __forceinline__ const char* abase(const pg8::Unit& u) const { return u.aux ? base.B + (size_t)u.pn * base.tstepB : base.A + (size_t)u.pm * base.tstepA; }
    __device__ __forceinline__ const char* bbase(const pg8::Unit& u) const { return u.aux ? base.A + (size_t)u.pm * base.tstepA : base.B + (size_t)u.pn * base.tstepB; }
};
struct EpiProj {
    static constexpr bool PERM = true, ROW_RS = true;
    bf16* O; bf16* VT; const float* part; bool dry;
    __device__ __forceinline__ bool operator()(f32x4 (&acc)[2][2][4][2], const pg8::Unit& u, int wr, int wc, int fr, int fq, const LAS float* xrs) const {
        bf16* base = u.aux ? VT : O; const size_t ldc = u.aux ? (size_t)M : (size_t)PN;
        const int row0 = (u.aux ? (u.pn - 4) : u.pm) * 256 + wr * 64 + fr, col0 = (u.aux ? u.pm : u.pn) * 256 + wc * 32 + 8 * fq;
        float rsv[8];
#pragma unroll
        for (int i = 0; i < 8; ++i) rsv[i] = xrs[wr * 64 + fr + (i >> 2) * 128 + (i & 3) * 16];
#pragma unroll
        for (int ai = 0; ai < 2; ++ai)
#pragma unroll
            for (int m = 0; m < 4; ++m) { bf16* rowp = base + (size_t)(row0 + ai * 128 + m * 16) * ldc + col0; const float rs = rsv[ai * 4 + m];
#pragma unroll
                for (int bj = 0; bj < 2; ++bj) { const f32x4 v0 = acc[ai][bj][m][0] * rs, v1 = acc[ai][bj][m][1] * rs;
                    v4u w; w.x = pg8::cvt_pk_bf16(v0[0], v0[1]); w.y = pg8::cvt_pk_bf16(v0[2], v0[3]); w.z = pg8::cvt_pk_bf16(v1[0], v1[1]); w.w = pg8::cvt_pk_bf16(v1[2], v1[3]);
                    if (!dry) __builtin_nontemporal_store(w, (v4u*)(rowp + bj * 128)); } }
        return true;
    }
};

struct SchedLru {
    const char* A; const char* B; int G, c;
    __device__ __forceinline__ bool next(int i, pg8::Unit& u) const { int L = i * G + c; if (L >= 512) return false; if ((G & 7) == 0) L = i * G + (c & 7) * (G >> 3) + (c >> 3); u.pm = L >> 3; u.pn = L & 7; u.aux = 0; return true; }
    __device__ __forceinline__ const char* abase(const pg8::Unit& u) const { return A + (size_t)u.pm * 256 * D * 2 + (size_t)(u.pn >> 1) * 256 * 2; }
    __device__ __forceinline__ const char* bbase(const pg8::Unit& u) const { return B + (size_t)u.pn * 256 * 256 * 2; }
};
struct EpiLru {
    static constexpr bool PERM = true, ROW_RS = false;
    const bf16* XC; bf16* OMA; int ld_oma; bf16* U; const float* ba; const float* bx; const float* lam;
    __device__ __forceinline__ bool operator()(f32x4 (&acc)[2][2][4][2], const pg8::Unit& u, int wr, int wc, int fr, int fq, const LAS float* xrs) const {
        const int row0 = u.pm * 256 + wr * 64 + fr, ch0 = (u.pn >> 1) * 256 + (u.pn & 1) * 128 + wc * 32 + 8 * fq;
#pragma unroll
        for (int n = 0; n < 2; ++n) {
            const int chn = ch0 + 4 * n;
            v2u xcv[8];
#pragma unroll
            for (int i = 0; i < 8; ++i) xcv[i] = *(const v2u*)(XC + (size_t)(row0 + (i >> 2) * 128 + (i & 3) * 16) * D + chn);
            const f32x4 b_a = *(const f32x4*)(ba + chn), b_x = *(const f32x4*)(bx + chn), sp = *(const f32x4*)(lam + chn) * (-8.0f * 1.4426950408889634f);
#pragma unroll
            for (int ai = 0; ai < 2; ++ai)
#pragma unroll
                for (int m = 0; m < 4; ++m) { const int row = row0 + ai * 128 + m * 16; const v2u xv = xcv[ai * 4 + m];
                    const float xc[4] = {blo(xv.x), bhi(xv.x), blo(xv.y), bhi(xv.y)};
                    float oa[4], uu[4];
#pragma unroll
                    for (int j = 0; j < 4; ++j) { const float pa = acc[ai][0][m][n][j] + b_a[j], px = acc[ai][1][m][n][j] + b_x[j];
                        const float r = __builtin_amdgcn_rcpf(1.0f + __builtin_amdgcn_exp2f(-1.4426950408889634f * pa)), ig = __builtin_amdgcn_rcpf(1.0f + __builtin_amdgcn_exp2f(-1.4426950408889634f * px));
                        const float a = __builtin_amdgcn_exp2f(r * sp[j]); const float om = 1.0f - a;
                        oa[j] = om; uu[j] = __builtin_amdgcn_sqrtf(om * (1.0f + a)) * ig * xc[j]; }
                    v2u w1; w1.x = pk2(oa[0], oa[1]); w1.y = pk2(oa[2], oa[3]);
                    v2u w2; w2.x = pk2(uu[0], uu[1]); w2.y = pk2(uu[2], uu[3]);
                    *(v2u*)(OMA + (size_t)row * ld_oma + chn) = w1; *(v2u*)(U + (size_t)row * D + chn) = w2; }
        }
        return true;
    }
};

struct SchedBranch {
    const char* P; const char* B; int G, c;
    __device__ __forceinline__ bool next(int i, pg8::Unit& u) const { int tile = (i / 3) * G + c; if (tile >= 256) return false; if ((G & 7) == 0) tile = (i / 3) * G + (c & 7) * (G >> 3) + (c >> 3);
        u.pm = tile >> 2; u.pn = tile & 3; u.aux = i % 3; return true; }
    __device__ __forceinline__ const char* abase(const pg8::Unit& u) const { const int off = u.aux == 0 ? OFF_GG : (u.aux == 1 ? OFF_LG : OFF_SQ); return P + ((size_t)u.pm * 256 * PN + off) * 2; }
    __device__ __forceinline__ const char* bbase(const pg8::Unit& u) const { return B + (size_t)(u.aux * 1024 + u.pn * 256) * D * 2; }
};
struct EpiBranch {
    static constexpr bool PERM = true, ROW_RS = false, WIDE = false;
    const bf16* PROJ; const float* bg; bf16* O;
    __device__ __forceinline__ bool operator()(f32x4 (&acc)[2][2][4][2], const pg8::Unit& u, int wr, int wc, int fr, int fq, const LAS float* xrs) const {
        const int row0 = u.pm * 256 + wr * 64 + fr, col0 = u.pn * 256 + wc * 32 + 8 * fq, br = u.aux;
#pragma unroll
        for (int bj = 0; bj < 2; ++bj) {
            const int c = col0 + bj * 128;
            float b0[8], b1[8];
#pragma unroll
            for (int j = 0; j < 8; ++j) { b0[j] = bg[br * 1024 + c + j] * -1.4426950408889634f; b1[j] = br < 2 ? bg[(br + 1) * 1024 + c + j] * -1.4426950408889634f : 0.f; }
#pragma unroll
            for (int ai = 0; ai < 2; ++ai) {
                v4u l0[4], l1[4];
#pragma unroll
                for (int m = 0; m < 4; ++m) { const bf16* gp = PROJ + (size_t)(row0 + ai * 128 + m * 16) * PN + OFF_GATE + br * 1024 + c; l0[m] = *(const v4u*)gp; l1[m] = br < 2 ? *(const v4u*)(gp + 1024) : l0[m]; }
#pragma unroll
                for (int m = 0; m < 4; ++m) { const int row = row0 + ai * 128 + m * 16; const v4u a0 = l0[m], a1 = l1[m];
                    const float x0[8] = {blo(a0.x), bhi(a0.x), blo(a0.y), bhi(a0.y), blo(a0.z), bhi(a0.z), blo(a0.w), bhi(a0.w)};
                    const float x1[8] = {blo(a1.x), bhi(a1.x), blo(a1.y), bhi(a1.y), blo(a1.z), bhi(a1.z), blo(a1.w), bhi(a1.w)};
#pragma unroll
                    for (int j = 0; j < 8; ++j) { const float r0 = __builtin_amdgcn_rcpf(1.0f + __builtin_amdgcn_exp2f(x0[j] * -1.4426950408889634f + b0[j]));
                        const float f = br < 2 ? (1.0f + __builtin_amdgcn_exp2f(x1[j] * -1.4426950408889634f + b1[j])) * r0 : r0;
                        acc[ai][bj][m][j >> 2][j & 3] *= f; }
                    if (br == 2) { const f32x4 v0 = acc[ai][bj][m][0], v1 = acc[ai][bj][m][1];
                        v4u w; w.x = pg8::cvt_pk_bf16(v0[0], v0[1]); w.y = pg8::cvt_pk_bf16(v0[2], v0[3]); w.z = pg8::cvt_pk_bf16(v1[0], v1[1]); w.w = pg8::cvt_pk_bf16(v1[2], v1[3]);
                        *(v4u*)(O + (size_t)row * D + c) = w; } }
            }
        }
        return br == 2;
    }
};

namespace gla {
typedef float f32x16 __attribute__((ext_vector_type(16)));
typedef short s16x4 __attribute__((ext_vector_type(4)));
constexpr int BUF = 65536, T_QD = 0, T_KI = 16384, T_V = 32768, X_SSQ = 131072, X_DW = 131072 + 2048;
__device__ __forceinline__ int crow(int r, int hi) { return (r & 3) + 8 * (r >> 2) + 4 * hi; }
__device__ __forceinline__ unsigned cvtpk(float lo, float hi) { unsigned r; asm volatile("v_cvt_pk_bf16_f32 %0, %1, %2" : "=v"(r) : "v"(lo), "v"(hi)); return r; }
__device__ __forceinline__ bf16x8 acc_frag(const f32x16& X, int s) { v4u w = {cvtpk(X[8 * s], X[8 * s + 1]), cvtpk(X[8 * s + 2], X[8 * s + 3]), cvtpk(X[8 * s + 4], X[8 * s + 5]), cvtpk(X[8 * s + 6], X[8 * s + 7])}; return *reinterpret_cast<bf16x8*>(&w); }
__device__ __forceinline__ int offb(int row, int ch) { return 256 * row + 16 * (ch ^ (((row & 3) << 2) | ((row >> 2) & 3))); }
__device__ __forceinline__ bf16x8 rowrd(const LAS unsigned char* tile, int lane, int rb, int s) { return *reinterpret_cast<const LAS bf16x8*>(tile + offb((lane & 31) + 32 * rb, 2 * s + (lane >> 5))); }
__device__ __forceinline__ v2u rd8(const LAS unsigned char* tile, int row, int ch, int half) { return *reinterpret_cast<const LAS v2u*>(tile + offb(row, ch) + 8 * half); }
__device__ __forceinline__ s16x4 trr(unsigned addr) { s16x4 r; asm volatile("ds_read_b64_tr_b16 %0, %1" : "=&v"(r) : "v"(addr) : "memory"); return r; }
__device__ __forceinline__ unsigned tr_addr(unsigned base, int lane, int c, int row0) { const int blk = (lane >> 4) & 1, q = (lane & 15) >> 2, p = lane & 3; return base + offb(row0 + q, 4 * c + 2 * blk + (p >> 1)) + 8 * (p & 1); }
struct TrPair { s16x4 a, b; };
__device__ __forceinline__ TrPair tr_nat(unsigned base, int lane, int c, int ks) { const int h = lane >> 5; TrPair p; p.a = trr(tr_addr(base, lane, c, 16 * ks + 8 * h)); p.b = trr(tr_addr(base, lane, c, 16 * ks + 8 * h + 4)); return p; }
__device__ __forceinline__ TrPair tr_perm(unsigned base, int lane, int c, int ks) { const int h = lane >> 5; TrPair p; p.a = trr(tr_addr(base, lane, c, 16 * ks + 4 * h)); p.b = trr(tr_addr(base, lane, c, 16 * ks + 8 + 4 * h)); return p; }
__device__ __forceinline__ bf16x8 tr_frag(const TrPair& p) { return (bf16x8){p.a[0], p.a[1], p.a[2], p.a[3], p.b[0], p.b[1], p.b[2], p.b[3]}; }
#define LDS_TR_WAIT() do { asm volatile("s_waitcnt lgkmcnt(0)" ::: "memory"); __builtin_amdgcn_sched_barrier(0); } while (0)
__device__ __forceinline__ void dma_tile(LAS unsigned char* img, const bf16* grow0  , int wid, int lane) {
#pragma unroll
    for (int i = 0; i < 2; ++i) { const int L = (wid + 8 * i) * 64 + lane, row = L >> 4, ch = (L & 15) ^ (((row & 3) << 2) | ((row >> 2) & 3));
        __builtin_amdgcn_global_load_lds((const unsigned*)(grow0 + (size_t)row * PN + ch * 8), (LAS unsigned*)(img + (wid + 8 * i) * 1024), 16, 0, 0); }
}
__device__ __forceinline__ void dma_chunk(LAS unsigned char* lds, int buf, const bf16* proj_row0  , int h, bool with_q, int wid, int lane) {
    LAS unsigned char* b = lds + buf * BUF;
    if (with_q) dma_tile(b + T_QD, proj_row0 + OFF_GQ + h * 128, wid, lane);
    dma_tile(b + T_KI, proj_row0 + OFF_GK + h * 128, wid, lane);
    dma_tile(b + T_V, proj_row0 + OFF_GV + h * 256, wid, lane);
    dma_tile(b + T_V + 16384, proj_row0 + OFF_GV + h * 256 + 128, wid, lane);
}
__device__ __forceinline__ void s_update(f32x16 (&S)[4], const LAS unsigned char* b, unsigned bi, const float* dec, int wid, int lane, int hi) {
    const unsigned vimg = bi + T_V + (wid >> 2) * 16384, kimg = bi + T_KI;
#pragma unroll
    for (int ks = 0; ks < 4; ++ks) { const TrPair pv = tr_nat(vimg, lane, wid & 3, ks); TrPair pk[4];
#pragma unroll
        for (int db = 0; db < 4; ++db) pk[db] = tr_nat(kimg, lane, db, ks);
        LDS_TR_WAIT();
        const bf16x8 bv = tr_frag(pv);
#pragma unroll
        for (int db = 0; db < 4; ++db) S[db] = __builtin_amdgcn_mfma_f32_32x32x16_bf16(tr_frag(pk[db]), bv, S[db], 0, 0, 0); }
#pragma unroll
    for (int db = 0; db < 4; ++db)
#pragma unroll
        for (int g = 0; g < 4; ++g) { const f32x4 d = *reinterpret_cast<const f32x4*>(dec + 32 * db + 8 * g + 4 * hi);
#pragma unroll
            for (int i = 0; i < 4; ++i) S[db][4 * g + i] *= d[i]; }
}
__device__ __forceinline__ void pass1_item(Frame& F, int it) {
    const int tid = opaque_tid(), wid = __builtin_amdgcn_readfirstlane(tid >> 6), lane = tid & 63, hi = lane >> 5;
    const int b = it >> 5, h = (it >> 3) & 3, g = it & 7;
    const float* decb = F.DECAY + (size_t)(b * 32) * 512 + h * 128;
    const unsigned lbase = (unsigned)(uintptr_t)F.ldsg;
    f32x16 S[4];
#pragma unroll
    for (int db = 0; db < 4; ++db) S[db] = f32x16{};
    __syncthreads();
    dma_chunk(F.lds, 0, F.PROJ + (size_t)(b * T + (4 * g) * 64) * PN, h, false, wid, lane);
    asm volatile("s_waitcnt vmcnt(0)" ::: "memory"); __syncthreads();
#pragma nounroll
    for (int n = 0; n < 4; ++n) { const int ch = 4 * g + n;
        if (n < 3) dma_chunk(F.lds, (n + 1) & 1, F.PROJ + (size_t)(b * T + (ch + 1) * 64) * PN, h, false, wid, lane);
        int ln = lane; asm volatile("" : "+v"(ln));
        s_update(S, F.lds + (n & 1) * BUF, lbase + (n & 1) * BUF, decb + (size_t)ch * 512, wid, ln, ln >> 5);
        asm volatile("s_waitcnt vmcnt(0)" ::: "memory"); __syncthreads();
    }
    float* sl = (float*)(F.ws + WS_VT) + (size_t)it * 32768 + wid * 4096;
#pragma unroll
    for (int db = 0; db < 4; ++db)
#pragma unroll
        for (int g4 = 0; g4 < 4; ++g4) *reinterpret_cast<f32x4*>(sl + ((db * 4 + g4) * 64 + lane) * 4) = (f32x4){S[db][4 * g4], S[db][4 * g4 + 1], S[db][4 * g4 + 2], S[db][4 * g4 + 3]};
}
__device__ __forceinline__ void prefix_item(Frame& F, int it) {
    const int tid = opaque_tid(), b = it >> 5, h = (it >> 3) & 3, e = it & 7;
    const float* sl = (const float*)(F.ws + WS_VT) + (size_t)(it - e) * 32768 + e * 4096;
    float* cin = (float*)(F.ws + WS_XC) + (size_t)(it - e) * 32768 + e * 4096;
    const float* decb = F.DECAY + (size_t)(b * 32) * 512 + h * 128;
#pragma unroll
    for (int j = 0; j < 2; ++j) { const int q = tid + 512 * j, dk = 32 * (q >> 8) + 8 * ((q >> 6) & 3) + 4 * ((q & 63) >> 5);
        f32x4 sv[8], dv[8];
#pragma unroll
        for (int g = 0; g < 8; ++g) { sv[g] = *(const f32x4*)(sl + (size_t)g * 32768 + 4 * q);
            const float* dp = decb + (size_t)(4 * g) * 512 + dk; dv[g] = (*(const f32x4*)dp * *(const f32x4*)(dp + 512)) * (*(const f32x4*)(dp + 1024) * *(const f32x4*)(dp + 1536)); }
        f32x4 C = {0.f, 0.f, 0.f, 0.f};
#pragma unroll
        for (int g = 0; g < 8; ++g) { *(f32x4*)(cin + (size_t)g * 32768 + 4 * q) = C; C = dv[g] * C + sv[g]; }
    }
}
__device__ __forceinline__ void pass2_item(Frame& F, const float* norm_g, int it) {
    const int tid = opaque_tid(), wid = __builtin_amdgcn_readfirstlane(tid >> 6), lane = tid & 63, r32 = lane & 31, hi = lane >> 5;
    const int b = it >> 5, h = (it >> 3) & 3, g = it & 7;
    const float* decb = F.DECAY + (size_t)(b * 32) * 512 + h * 128;
    const unsigned lbase = (unsigned)(uintptr_t)F.ldsg;
    LAS float* ssqx = (LAS float*)(F.lds + X_SSQ);
    __syncthreads();
    dma_chunk(F.lds, 0, F.PROJ + (size_t)(b * T + (4 * g) * 64) * PN, h, true, wid, lane);
    f32x16 S[4];
    { const float* ci = (const float*)(F.ws + WS_XC) + (size_t)it * 32768 + wid * 4096;
#pragma unroll
      for (int db = 0; db < 4; ++db)
#pragma unroll
          for (int g4 = 0; g4 < 4; ++g4) { const f32x4 sv = *reinterpret_cast<const f32x4*>(ci + ((db * 4 + g4) * 64 + lane) * 4);
#pragma unroll
              for (int i = 0; i < 4; ++i) S[db][4 * g4 + i] = sv[i]; } }
    float ng[16];
#pragma unroll
    for (int r = 0; r < 16; ++r) ng[r] = norm_g[32 * wid + crow(r, hi)];
    asm volatile("s_waitcnt vmcnt(0)" ::: "memory"); __syncthreads();
#pragma nounroll
    for (int n = 0; n < 4; ++n) { const int ch = 4 * g + n; const size_t m0 = (size_t)(b * T + ch * 64);
        if (n < 3) dma_chunk(F.lds, (n + 1) & 1, F.PROJ + (m0 + 64) * PN, h, true, wid, lane);
        int ln = lane; asm volatile("" : "+v"(ln));
        const int lane = ln, r32 = ln & 31, hi = ln >> 5;
        const LAS unsigned char* bq = F.lds + (n & 1) * BUF + T_QD; const LAS unsigned char* bk = F.lds + (n & 1) * BUF + T_KI;
        const unsigned bi = lbase + (n & 1) * BUF, vimg = bi + T_V + (wid >> 2) * 16384;
        f32x16 a00 = f32x16{}, a01 = f32x16{}, a11 = f32x16{};
#pragma unroll
        for (int d0 = 0; d0 < 8; ++d0) { const bf16x8 k0 = rowrd(bk, lane, 0, d0), k1 = rowrd(bk, lane, 1, d0), q0 = rowrd(bq, lane, 0, d0), q1 = rowrd(bq, lane, 1, d0);
            a00 = __builtin_amdgcn_mfma_f32_32x32x16_bf16(k0, q0, a00, 0, 0, 0);
            a01 = __builtin_amdgcn_mfma_f32_32x32x16_bf16(k0, q1, a01, 0, 0, 0);
            a11 = __builtin_amdgcn_mfma_f32_32x32x16_bf16(k1, q1, a11, 0, 0, 0); }
#pragma unroll
        for (int r = 0; r < 16; ++r) { const bool vis = crow(r, hi) <= r32; a00[r] = vis ? a00[r] : 0.f; a11[r] = vis ? a11[r] : 0.f; }
        f32x16 o0 = f32x16{}, o1 = f32x16{};
        { TrPair pva[2], pvb[2];
#pragma unroll
          for (int ks = 0; ks < 2; ++ks) { pva[ks] = tr_perm(vimg, lane, wid & 3, ks); pvb[ks] = tr_perm(vimg, lane, wid & 3, 2 + ks); }
          LDS_TR_WAIT();
#pragma unroll
          for (int ks = 0; ks < 2; ++ks) { const bf16x8 va = tr_frag(pva[ks]), vb = tr_frag(pvb[ks]);
            o0 = __builtin_amdgcn_mfma_f32_32x32x16_bf16(va, acc_frag(a00, ks), o0, 0, 0, 0);
            o1 = __builtin_amdgcn_mfma_f32_32x32x16_bf16(va, acc_frag(a01, ks), o1, 0, 0, 0);
            o1 = __builtin_amdgcn_mfma_f32_32x32x16_bf16(vb, acc_frag(a11, ks), o1, 0, 0, 0); } }
#pragma unroll
        for (int db = 0; db < 4; ++db)
#pragma unroll
            for (int ks = 0; ks < 2; ++ks) { const bf16x8 sa = acc_frag(S[db], ks);
                const v2u x0 = rd8(bq, r32, 4 * db + 2 * ks, hi), x1 = rd8(bq, r32, 4 * db + 2 * ks + 1, hi), y0 = rd8(bq, 32 + r32, 4 * db + 2 * ks, hi), y1 = rd8(bq, 32 + r32, 4 * db + 2 * ks + 1, hi);
                v4u wx = {x0.x, x0.y, x1.x, x1.y}, wy = {y0.x, y0.y, y1.x, y1.y};
                o0 = __builtin_amdgcn_mfma_f32_32x32x16_bf16(sa, *reinterpret_cast<bf16x8*>(&wx), o0, 0, 0, 0);
                o1 = __builtin_amdgcn_mfma_f32_32x32x16_bf16(sa, *reinterpret_cast<bf16x8*>(&wy), o1, 0, 0, 0); }
        float s0 = 0.f, s1 = 0.f;
#pragma unroll
        for (int r = 0; r < 16; ++r) { s0 += o0[r] * o0[r]; s1 += o1[r] * o1[r]; }
        { auto rr = __builtin_amdgcn_permlane32_swap(__float_as_uint(s0), __float_as_uint(s0), false, false); s0 = __uint_as_float(rr[0]) + __uint_as_float(rr[1]); }
        { auto rr = __builtin_amdgcn_permlane32_swap(__float_as_uint(s1), __float_as_uint(s1), false, false); s1 = __uint_as_float(rr[0]) + __uint_as_float(rr[1]); }
        if (hi == 0) { ssqx[wid * 64 + r32] = s0; ssqx[wid * 64 + 32 + r32] = s1; }
        const bf16* gp = F.PROJ + (m0 + r32) * PN + OFF_GG + h * 256 + 32 * wid + 4 * hi;
        v2u gg0[4], gg1[4];
#pragma unroll
        for (int g4 = 0; g4 < 4; ++g4) { gg0[g4] = *reinterpret_cast<const v2u*>(gp + 8 * g4); gg1[g4] = *reinterpret_cast<const v2u*>(gp + (size_t)32 * PN + 8 * g4); }
        __syncthreads();
        float t0s = 0.f, t1s = 0.f;
#pragma unroll
        for (int w2 = 0; w2 < 8; ++w2) { t0s += ssqx[w2 * 64 + r32]; t1s += ssqx[w2 * 64 + 32 + r32]; }
        const float rs0 = 1.0f / sqrtf(t0s * (1.f / 256.f) + EPS), rs1 = 1.0f / sqrtf(t1s * (1.f / 256.f) + EPS);
#pragma unroll
        for (int g4 = 0; g4 < 4; ++g4) {
            const float ga[4] = {blo(gg0[g4].x), bhi(gg0[g4].x), blo(gg0[g4].y), bhi(gg0[g4].y)}, gb[4] = {blo(gg1[g4].x), bhi(gg1[g4].x), blo(gg1[g4].y), bhi(gg1[g4].y)};
            float ya[4], yb[4];
#pragma unroll
            for (int i = 0; i < 4; ++i) { ya[i] = o0[4 * g4 + i] * rs0 * ng[4 * g4 + i] * (ga[i] * __builtin_amdgcn_rcpf(1.0f + __builtin_amdgcn_exp2f(-1.4426950408889634f * ga[i])));
                                          yb[i] = o1[4 * g4 + i] * rs1 * ng[4 * g4 + i] * (gb[i] * __builtin_amdgcn_rcpf(1.0f + __builtin_amdgcn_exp2f(-1.4426950408889634f * gb[i]))); }
            v2u w0 = {cvtpk(ya[0], ya[1]), cvtpk(ya[2], ya[3])}, w1 = {cvtpk(yb[0], yb[1]), cvtpk(yb[2], yb[3])};
            if (!F.dry) { *reinterpret_cast<v2u*>(const_cast<bf16*>(gp) + 8 * g4) = w0; *reinterpret_cast<v2u*>(const_cast<bf16*>(gp) + (size_t)32 * PN + 8 * g4) = w1; }
        }
        if (n < 3) s_update(S, F.lds + (n & 1) * BUF, bi, decb + (size_t)ch * 512, wid, lane, hi);
        asm volatile("s_waitcnt vmcnt(0)" ::: "memory"); __syncthreads();
    }
}
}
__device__ __forceinline__ void phase_gla_fix(Frame& F, const Args& A, int l) {
    F.tid = opaque_tid(); F.lane = F.tid & 63;
    const int gt = F.bid * 512 + F.tid, NGT = F.G * 512;
    const float* ng = as_global(A.in[5]) + (size_t)l * 256;
    for (int idx = gt; idx < M * 128; idx += NGT) {
        const int m = idx >> 7, c0 = (idx & 127) * 8, h = c0 >> 8;
        const float* sp = F.SSQ + (size_t)m * 32 + h * 8;
        const float ss = ((sp[0] + sp[1]) + (sp[2] + sp[3])) + ((sp[4] + sp[5]) + (sp[6] + sp[7]));
        const float rs = 1.0f / sqrtf(ss * (1.f / 256.f) + EPS);
        const v4u ov = *(const v4u*)(F.PROJ + (size_t)m * PN + OFF_GV + c0);
        bf16* gp = F.PROJ + (size_t)m * PN + OFF_GG + c0;
        const v4u gv = *(const v4u*)gp;
        const float o[8] = {blo(ov.x), bhi(ov.x), blo(ov.y), bhi(ov.y), blo(ov.z), bhi(ov.z), blo(ov.w), bhi(ov.w)};
        const float g[8] = {blo(gv.x), bhi(gv.x), blo(gv.y), bhi(gv.y), blo(gv.z), bhi(gv.z), blo(gv.w), bhi(gv.w)};
        float r[8];
#pragma unroll
        for (int j = 0; j < 8; ++j) r[j] = o[j] * rs * ng[(c0 & 255) + j] * (g[j] * sigmoidf_(g[j]));
        v4u w; w.x = pk2(r[0], r[1]); w.y = pk2(r[2], r[3]); w.z = pk2(r[4], r[5]); w.w = pk2(r[6], r[7]);
        if (!F.dry) *(v4u*)gp = w;
    }
}

__device__ __forceinline__ float gelu_tanh(float x) { const float y = 0.7978845608028654f * (x + 0.044715f * x * x * x); const float e = __expf(2.0f * y); const float th = 1.0f - 2.0f / (e + 1.0f); return 0.5f * x * (1.0f + th); }
constexpr size_t WS_LSUM = WS_KE;
constexpr size_t WS_WSUM = WS_KE + 4 * MiB;
__device__ __forceinline__ void lru_scan_a(Frame& F, int it) {
    const int tid = opaque_tid(), wid = __builtin_amdgcn_readfirstlane(tid >> 6), lane = tid & 63;
    const int b = it >> 5, cg = (it >> 3) & 3, tb = it & 7, ch = cg * 256 + lane * 4, m0 = b * T + tb * 256 + wid * 32, quad = cg * 64 + lane;
    LAS float* xs = (LAS float*)F.lds;
    f32x4 h = {0.f, 0.f, 0.f, 0.f}, P = {1.f, 1.f, 1.f, 1.f};
#pragma unroll
    for (int i16 = 0; i16 < 32; i16 += 16) {
        v2u om[16], uu[16];
#pragma unroll
        for (int i = 0; i < 16; ++i) { om[i] = *(const v2u*)(F.PROJ + (size_t)(m0 + i16 + i) * PN + OFF_LX + ch); uu[i] = *(const v2u*)(F.U + (size_t)(m0 + i16 + i) * D + ch); }
#pragma unroll
        for (int i = 0; i < 16; ++i) { const f32x4 a = {1.f - blo(om[i].x), 1.f - bhi(om[i].x), 1.f - blo(om[i].y), 1.f - bhi(om[i].y)}, u = {blo(uu[i].x), bhi(uu[i].x), blo(uu[i].y), bhi(uu[i].y)};
            h = a * h + u; P = P * a; }
    }
    float* ls = (float*)(F.ws + WS_LSUM) + ((size_t)(b * 64 + tb * 8 + wid) * 256 + quad) * 8;
    *(f32x4*)ls = P; *(f32x4*)(ls + 4) = h;
    __syncthreads();
    *(LAS f32x4*)(xs + (wid * 64 + lane) * 8) = P; *(LAS f32x4*)(xs + (wid * 64 + lane) * 8 + 4) = h;
    __syncthreads();
    if (wid == 0) { f32x4 Pt = {1.f, 1.f, 1.f, 1.f}, Ht = {0.f, 0.f, 0.f, 0.f};
#pragma unroll
        for (int w2 = 0; w2 < 8; ++w2) { const f32x4 p = *(const LAS f32x4*)(xs + (w2 * 64 + lane) * 8), hh = *(const LAS f32x4*)(xs + (w2 * 64 + lane) * 8 + 4); Ht = p * Ht + hh; Pt = Pt * p; }
        float* wsm = (float*)(F.ws + WS_WSUM) + ((size_t)(b * 8 + tb) * 256 + quad) * 8;
        *(f32x4*)wsm = Pt; *(f32x4*)(wsm + 4) = Ht; }
}
__device__ __forceinline__ void lru_scan_b(Frame& F, int it) {
    const int tid = opaque_tid(), wid = __builtin_amdgcn_readfirstlane(tid >> 6), lane = tid & 63;
    const int b = it >> 5, cg = (it >> 3) & 3, tb = it & 7, ch = cg * 256 + lane * 4, m0 = b * T + tb * 256 + wid * 32, quad = cg * 64 + lane;
    f32x4 h = {0.f, 0.f, 0.f, 0.f};
    { const float* wsm = (const float*)(F.ws + WS_WSUM) + ((size_t)(b * 8) * 256 + quad) * 8;
      f32x4 pp[7], hh[7];
#pragma unroll
      for (int j = 0; j < 7; ++j) { pp[j] = *(const f32x4*)(wsm + (size_t)j * 2048); hh[j] = *(const f32x4*)(wsm + (size_t)j * 2048 + 4); }
#pragma unroll
      for (int j = 0; j < 7; ++j) if (j < tb) h = pp[j] * h + hh[j]; }
    { const float* ls = (const float*)(F.ws + WS_LSUM) + ((size_t)(b * 64 + tb * 8) * 256 + quad) * 8;
      f32x4 pp[7], hh[7];
#pragma unroll
      for (int j = 0; j < 7; ++j) { pp[j] = *(const f32x4*)(ls + (size_t)j * 2048); hh[j] = *(const f32x4*)(ls + (size_t)j * 2048 + 4); }
#pragma unroll
      for (int j = 0; j < 7; ++j) if (j < wid) h = pp[j] * h + hh[j]; }
#pragma nounroll
    for (int i8 = 0; i8 < 32; i8 += 8) {
        v2u om[8], uu[8], gv[8];
#pragma unroll
        for (int i = 0; i < 8; ++i) { om[i] = *(const v2u*)(F.PROJ + (size_t)(m0 + i8 + i) * PN + OFF_LX + ch); uu[i] = *(const v2u*)(F.U + (size_t)(m0 + i8 + i) * D + ch);
            gv[i] = *(const v2u*)(F.PROJ + (size_t)(m0 + i8 + i) * PN + OFF_LG + ch); }
#pragma unroll
        for (int i = 0; i < 8; ++i) {
            const f32x4 a = {1.f - blo(om[i].x), 1.f - bhi(om[i].x), 1.f - blo(om[i].y), 1.f - bhi(om[i].y)}, u = {blo(uu[i].x), bhi(uu[i].x), blo(uu[i].y), bhi(uu[i].y)};
            const float g[4] = {blo(gv[i].x), bhi(gv[i].x), blo(gv[i].y), bhi(gv[i].y)};
            h = a * h + u;
            v2u w; w.x = pk2(h.x * gelu_tanh(g[0]), h.y * gelu_tanh(g[1])); w.y = pk2(h.z * gelu_tanh(g[2]), h.w * gelu_tanh(g[3]));
            if (!F.dry) *(v2u*)(F.PROJ + (size_t)(m0 + i8 + i) * PN + OFF_LG + ch) = w;
        }
    }
}

namespace sba {
typedef float f32x16 __attribute__((ext_vector_type(16)));
typedef short s16x4 __attribute__((ext_vector_type(4)));
constexpr int SHM_V = 64 * 128 * 2, SHM_K = 64 * 128 * 2;
#define SBA_KSWZ(row, colB) ((row) * 256 + ((colB) ^ (((row) & 7) << 4)))
#define SBA_SBAR() __builtin_amdgcn_sched_barrier(0)
__device__ __forceinline__ int crow(int r, int hi) { return (r & 3) + 8 * (r >> 2) + 4 * hi; }
__device__ __forceinline__ unsigned cvtpk(float lo, float hi) { unsigned r; asm volatile("v_cvt_pk_bf16_f32 %0, %1, %2" : "=v"(r) : "v"(lo), "v"(hi)); return r; }
__device__ __forceinline__ void qkt(f32x16& p0, f32x16& p1, const char* Ks, const bf16x8* qr, int r32, int hi) {
    p0 = f32x16{}; p1 = f32x16{};
#pragma unroll
    for (int d0 = 0; d0 < 8; ++d0) { const int cb = (d0 * 16 + hi * 8) * 2;
        const bf16x8 b0 = *reinterpret_cast<const bf16x8*>(Ks + SBA_KSWZ(r32, cb));
        const bf16x8 b1 = *reinterpret_cast<const bf16x8*>(Ks + SBA_KSWZ(32 + r32, cb));
        p0 = __builtin_amdgcn_mfma_f32_32x32x16_bf16(b0, qr[d0], p0, 0, 0, 0);
        p1 = __builtin_amdgcn_mfma_f32_32x32x16_bf16(b1, qr[d0], p1, 0, 0, 0); }
}
__device__ __forceinline__ void sig_part(f32x16& p0, f32x16& p1, bool partial, int krel, int hi) {
#pragma unroll
    for (int r = 0; r < 16; ++r) { p0[r] = __builtin_amdgcn_rcpf(1.0f + __builtin_amdgcn_exp2f(p0[r])); p1[r] = __builtin_amdgcn_rcpf(1.0f + __builtin_amdgcn_exp2f(p1[r])); }
    if (partial) {
#pragma unroll
        for (int r = 0; r < 16; ++r) { const int kk = krel + crow(r, hi); p0[r] = (kk < 0) ? p0[r] : 1.0f; p1[r] = (kk + 32 < 0) ? p1[r] : 1.0f; }
    }
}
__device__ __forceinline__ void finish(f32x16& p0, f32x16& p1, float& R, int hi, bf16x8& pa0, bf16x8& pa1, bf16x8& pa2, bf16x8& pa3) {
    float lo[8], hv[8];
#pragma unroll
    for (int g = 0; g < 4; ++g) {
        const float ga = (p0[4 * g] * p0[4 * g + 1]) * (p0[4 * g + 2] * p0[4 * g + 3]), gb = (p1[4 * g] * p1[4 * g + 1]) * (p1[4 * g + 2] * p1[4 * g + 3]);
        { auto rr = __builtin_amdgcn_permlane32_swap(__float_as_uint(ga), __float_as_uint(ga), false, false); lo[g] = __uint_as_float(rr[0]); hv[g] = __uint_as_float(rr[1]); }
        { auto rr = __builtin_amdgcn_permlane32_swap(__float_as_uint(gb), __float_as_uint(gb), false, false); lo[4 + g] = __uint_as_float(rr[0]); hv[4 + g] = __uint_as_float(rr[1]); }
    }
    float ps = R;
#pragma unroll
    for (int g = 7; g >= 0; --g) {
        float run = ps * (hi == 0 ? hv[g] : 1.0f);
#pragma unroll
        for (int i = 3; i >= 0; --i) {
            if (g >= 4) { const float k = p1[4 * (g - 4) + i]; p1[4 * (g - 4) + i] = (1.0f - k) * run; run *= k; }
            else        { const float k = p0[4 * g + i];       p0[4 * g + i]       = (1.0f - k) * run; run *= k; }
        }
        ps = ps * (lo[g] * hv[g]);
    }
    R = ps;
#define SBA_PK4(P, BASE, OUT) do { unsigned a0 = cvtpk(P[BASE + 0], P[BASE + 1]), a1 = cvtpk(P[BASE + 2], P[BASE + 3]);   \
    unsigned b0 = cvtpk(P[BASE + 4], P[BASE + 5]), b1 = cvtpk(P[BASE + 6], P[BASE + 7]);                              \
    auto r0 = __builtin_amdgcn_permlane32_swap(a0, b0, false, false); auto r1 = __builtin_amdgcn_permlane32_swap(a1, b1, false, false); \
    v4u w = {r0[0], r1[0], r0[1], r1[1]}; OUT = *reinterpret_cast<bf16x8*>(&w); } while (0)
    SBA_PK4(p0, 0, pa0); SBA_PK4(p0, 8, pa1); SBA_PK4(p1, 0, pa2); SBA_PK4(p1, 8, pa3);
#undef SBA_PK4
}
__device__ __forceinline__ int v_st(int k, int c) { const int kk = (k & ~0xC) | ((k & 4) << 1) | ((k & 8) >> 1); return ((kk >> 3) * 4 + (c >> 5)) * 512 + ((kk & 7) * 32 + (c & 31)) * 2; }
__device__ __forceinline__ int v_rd_base(int lane) { return ((lane & 3) << 3) | (((lane >> 2) & 3) << 6) | (((lane >> 4) & 1) << 5) | (((lane >> 5) & 1) << 8); }
constexpr int v_rd_off(int d0, int ks, int half) { return d0 * 512 + ks * 4096 + half * 2048; }
template <int OFF> __device__ __forceinline__ s16x4 tr_read(int vb) { s16x4 r; asm volatile("ds_read_b64_tr_b16 %0, %1 offset:%2" : "=&v"(r) : "v"(vb), "i"(OFF) : "memory"); return r; }
template <int D0> __device__ __forceinline__ void pv_one(f32x16& od, int vb, bf16x8 pa0, bf16x8 pa1, bf16x8 pa2, bf16x8 pa3) {
    const s16x4 l0 = tr_read<v_rd_off(D0, 0, 0)>(vb), h0 = tr_read<v_rd_off(D0, 0, 1)>(vb), l1 = tr_read<v_rd_off(D0, 1, 0)>(vb), h1 = tr_read<v_rd_off(D0, 1, 1)>(vb);
    const s16x4 l2 = tr_read<v_rd_off(D0, 2, 0)>(vb), h2 = tr_read<v_rd_off(D0, 2, 1)>(vb), l3 = tr_read<v_rd_off(D0, 3, 0)>(vb), h3 = tr_read<v_rd_off(D0, 3, 1)>(vb);
    asm volatile("s_waitcnt lgkmcnt(0)" ::: "memory"); SBA_SBAR();
#define SBA_PK(L, H) (bf16x8){L[0], L[1], L[2], L[3], H[0], H[1], H[2], H[3]}
    od = __builtin_amdgcn_mfma_f32_32x32x16_bf16(pa0, SBA_PK(l0, h0), od, 0, 0, 0);
    od = __builtin_amdgcn_mfma_f32_32x32x16_bf16(pa1, SBA_PK(l1, h1), od, 0, 0, 0);
    od = __builtin_amdgcn_mfma_f32_32x32x16_bf16(pa2, SBA_PK(l2, h2), od, 0, 0, 0);
    od = __builtin_amdgcn_mfma_f32_32x32x16_bf16(pa3, SBA_PK(l3, h3), od, 0, 0, 0);
#undef SBA_PK
}
__device__ __forceinline__ void pv_d0(f32x16* o, int vb, bf16x8 pa0, bf16x8 pa1, bf16x8 pa2, bf16x8 pa3) {
    pv_one<0>(o[0], vb, pa0, pa1, pa2, pa3); pv_one<1>(o[1], vb, pa0, pa1, pa2, pa3); pv_one<2>(o[2], vb, pa0, pa1, pa2, pa3); pv_one<3>(o[3], vb, pa0, pa1, pa2, pa3);
}
__device__ __forceinline__ void unit(const bf16* Qb, const bf16* __restrict__ Kh, const bf16* __restrict__ Vh, bf16* Ob, int qb, char* lds, int tid, bool dry, const float* qg, const float* kg) {
    const int wid = __builtin_amdgcn_readfirstlane(tid >> 6), lane = tid & 63, r32 = lane & 31, hi = lane >> 5;
    char* V_lds = lds; char* K_lds = lds + 2 * SHM_V;
    f32x16 o[4] = {}; bf16x8 qr[8]; float R = 1.0f;
    const bf16* Qw = Qb + (size_t)(wid * 32 + r32) * PN + hi * 8;
#pragma unroll
    for (int d0 = 0; d0 < 8; ++d0) qr[d0] = *reinterpret_cast<const bf16x8*>(Qw + d0 * 16);
    { float ss = 0.f;
#pragma unroll
      for (int d0 = 0; d0 < 8; ++d0) { const v4u w = *reinterpret_cast<const v4u*>(&qr[d0]); const float e[8] = {blo(w.x), bhi(w.x), blo(w.y), bhi(w.y), blo(w.z), bhi(w.z), blo(w.w), bhi(w.w)};
#pragma unroll
          for (int j = 0; j < 8; ++j) ss += e[j] * e[j]; }
      { auto rr = __builtin_amdgcn_permlane32_swap(__float_as_uint(ss), __float_as_uint(ss), false, false); ss = __uint_as_float(rr[0]) + __uint_as_float(rr[1]); }
      const float rs = __builtin_amdgcn_rsqf(ss * (1.f / 128.f) + EPS) * (0.08838834764831845f * 1.4426950408889634f);
#pragma unroll
      for (int d0 = 0; d0 < 8; ++d0) { const v4u w = *reinterpret_cast<const v4u*>(&qr[d0]); const float e[8] = {blo(w.x), bhi(w.x), blo(w.y), bhi(w.y), blo(w.z), bhi(w.z), blo(w.w), bhi(w.w)};
          const f32x4 g0 = *reinterpret_cast<const f32x4*>(qg + 16 * d0 + 8 * hi), g1 = *reinterpret_cast<const f32x4*>(qg + 16 * d0 + 8 * hi + 4);
          v4u o; o.x = cvtpk(e[0] * rs * g0.x, e[1] * rs * g0.y); o.y = cvtpk(e[2] * rs * g0.z, e[3] * rs * g0.w); o.z = cvtpk(e[4] * rs * g1.x, e[5] * rs * g1.y); o.w = cvtpk(e[6] * rs * g1.z, e[7] * rs * g1.w);
          qr[d0] = *reinterpret_cast<bf16x8*>(&o); } }
    const f32x4 kg0 = *reinterpret_cast<const f32x4*>(kg + (tid & 15) * 8), kg1 = *reinterpret_cast<const f32x4*>(kg + (tid & 15) * 8 + 4);
#define SBA_KNORM(X) do { const v4u w_ = *reinterpret_cast<const v4u*>(&(X)); const float e_[8] = {blo(w_.x), bhi(w_.x), blo(w_.y), bhi(w_.y), blo(w_.z), bhi(w_.z), blo(w_.w), bhi(w_.w)}; \
        float s_ = 0.f; _Pragma("unroll") for (int j_ = 0; j_ < 8; ++j_) s_ += e_[j_] * e_[j_]; \
        s_ += shx(s_, 1, lane); s_ += shx(s_, 2, lane); s_ += shx(s_, 4, lane); s_ += shx(s_, 8, lane); \
        const float r_ = __builtin_amdgcn_rsqf(s_ * (1.f / 128.f) + EPS); \
        v4u o_; o_.x = cvtpk(e_[0] * r_ * kg0.x, e_[1] * r_ * kg0.y); o_.y = cvtpk(e_[2] * r_ * kg0.z, e_[3] * r_ * kg0.w); o_.z = cvtpk(e_[4] * r_ * kg1.x, e_[5] * r_ * kg1.y); o_.w = cvtpk(e_[6] * r_ * kg1.z, e_[7] * r_ * kg1.w); \
        (X) = *reinterpret_cast<bf16x8*>(&o_); } while (0)
    const int sr = tid >> 4, sc = (tid & 15) * 8, vst0 = v_st(sr, sc), vst1 = v_st(32 + sr, sc);
    const int vb0 = (int)(uintptr_t)V_lds + v_rd_base(lane);
    bf16x8 vsA0, vsA1, ksA0, ksA1, vsB0, vsB1, ksB0, ksB1;
#define SBA_SLOAD(S, k0) do { vs##S##0 = *reinterpret_cast<const bf16x8*>(&Vh[(size_t)((k0) + sr) * PN + sc]); vs##S##1 = *reinterpret_cast<const bf16x8*>(&Vh[(size_t)((k0) + 32 + sr) * PN + sc]); \
    ks##S##0 = *reinterpret_cast<const bf16x8*>(&Kh[(size_t)((k0) + sr) * PN + sc]); ks##S##1 = *reinterpret_cast<const bf16x8*>(&Kh[(size_t)((k0) + 32 + sr) * PN + sc]); } while (0)
#define SBA_SWRITE(S, bo) do { SBA_KNORM(ks##S##0); SBA_KNORM(ks##S##1); *(bf16x8*)(V_lds + (bo) + vst0) = vs##S##0; *(bf16x8*)(V_lds + (bo) + vst1) = vs##S##1; const int kc = sc * 2; \
    *(bf16x8*)(K_lds + (bo) + SBA_KSWZ(sr, kc)) = ks##S##0; *(bf16x8*)(K_lds + (bo) + SBA_KSWZ(32 + sr, kc)) = ks##S##1; } while (0)
#define SBA_WAIT(more) do { if (more) asm volatile("s_waitcnt vmcnt(4)" ::: "memory"); else asm volatile("s_waitcnt vmcnt(0)" ::: "memory"); } while (0)
    const int NT = 4 * (qb + 1);
    const int qrel = wid * 32 + r32;
#define SBA_TILE(i) ((NT - 1 - (i)) * 64)
#define SBA_STEP(i, bo) do { const bool alive_ = __any(R != 0.0f); \
        if (alive_ && (((i) >= 4) || (64 * (3 - (i)) < 32 * wid + 31))) { f32x16 p0, p1; bf16x8 pa0, pa1, pa2, pa3; \
            qkt(p0, p1, K_lds + (bo), qr, r32, hi); \
            sig_part(p0, p1, ((i) < 4) && (64 * (3 - (i)) + 63 >= 32 * wid), 64 * (3 - (i)) - qrel, hi); \
            finish(p0, p1, R, hi, pa0, pa1, pa2, pa3); SBA_SBAR(); \
            pv_d0(o, vb0 + (bo), pa0, pa1, pa2, pa3); } SBA_SBAR(); } while (0)
    SBA_SLOAD(A, SBA_TILE(0)); SBA_WAIT(false); SBA_SWRITE(A, 0); __syncthreads();
    SBA_SLOAD(B, SBA_TILE(1)); SBA_SLOAD(A, SBA_TILE(2));
    for (int i = 0; i < NT; i += 2) {
        SBA_STEP(i, 0);
        SBA_WAIT(i + 2 < NT); SBA_SWRITE(B, SHM_V);
        if (i + 3 < NT) SBA_SLOAD(B, SBA_TILE(i + 3));
        if (!__syncthreads_or((int)(i < 3 || __any(R != 0.0f)))) break;
        SBA_STEP(i + 1, SHM_V);
        if (i + 2 < NT) { SBA_WAIT(i + 3 < NT); SBA_SWRITE(A, 0); }
        if (i + 4 < NT) SBA_SLOAD(A, SBA_TILE(i + 4));
        if (!__syncthreads_or((int)(i + 1 < 3 || __any(R != 0.0f)))) break;
    }
    asm volatile("s_waitcnt vmcnt(0)" ::: "memory");
#undef SBA_STEP
#undef SBA_TILE
#undef SBA_WAIT
#undef SBA_KNORM
    bf16* Ow = Ob + (size_t)(wid * 32) * PN;
#pragma unroll
    for (int r = 0; r < 16; ++r) { const int orow = crow(r, hi);
#pragma unroll
        for (int d0 = 0; d0 < 4; ++d0) if (!dry) Ow[(size_t)orow * PN + d0 * 32 + r32] = (bf16)f2bf(o[d0][r]); }
    __syncthreads();
#undef SBA_SLOAD
#undef SBA_SWRITE
}
}
__device__ __forceinline__ void sb_attn_pair(Frame& F, const float* qg, const float* kg, int item) {
    const int tid = opaque_tid();
    const int bh = item >> 2, p = item & 3, b = bh >> 3, h = bh & 7;
    const bf16* Kh = F.PROJ + (size_t)(b * T) * PN + OFF_SK + h * 128; const bf16* Vh = F.PROJ + (size_t)(b * T) * PN + OFF_SV + h * 128;
    bf16* Qh = F.PROJ + (size_t)(b * T) * PN + OFF_SQ + h * 128;
#pragma nounroll
    for (int u = 0; u < 2; ++u) { const int qb = u ? p : 7 - p; sba::unit(Qh + (size_t)(qb * 256) * PN, Kh, Vh, Qh + (size_t)(qb * 256) * PN, qb, (char*)F.ldsg, tid, F.dry, qg, kg); }
}

__device__ __forceinline__ Frame make_frame(const Args& args, LAS unsigned char* lds, unsigned char* ldsg) {
    Frame F; unsigned char* ws = args.ws; float* out = args.out;
    { size_t z = 0; asm volatile("" : "+s"(z)); ws += z; out += z; }
    F.lds = lds; F.ldsg = ldsg; F.tid = opaque_tid(); F.lane = F.tid & 63; F.wave = __builtin_amdgcn_readfirstlane(F.tid >> 6);
    F.G = gridDim.x; F.bid = blockIdx.x; F.out = out; F.ws = ws; F.dry = false;
    F.XN = (bf16*)(ws + WS_XN); F.XC = (bf16*)(ws + WS_XC); F.U = (bf16*)(ws + WS_U); F.KE = (bf16*)(ws + WS_KE); F.VT = (bf16*)(ws + WS_VT); F.PROJ = (bf16*)(ws + WS_PROJ);
    F.DECAY = (float*)(ws + WS_DECAY); F.SSQ = (float*)(ws + WS_SSQ);
    return F;
}
__global__ void __launch_bounds__(512, 2) trunk_fwd(Args args) {
    extern __shared__ __attribute__((aligned(16))) unsigned char lds_raw[];
    LAS unsigned char* const lds = (LAS unsigned char*)lds_raw;
    volatile LAS unsigned* MISC = (volatile LAS unsigned*)(lds + MISC_OFF);
    if (threadIdx.x < 32) MISC[threadIdx.x] = 0u;
    __syncthreads();
    const int lo = args.ph_lo, hi = args.ph_hi;
    XcdBarrier bar; bar.bar = (unsigned*)(args.ws + WS_CTL) + CW_BAR; bar.x = 0; bar.st = MISC + 8;
    if (hi - lo > 1) bar = xcd_barrier_post((unsigned*)(args.ws + WS_CTL) + CW_BAR, MISC + 8);
#ifndef PH_MASK
#define PH_MASK 0xfff
#endif
#define IN(k) (lo <= (k) && (k) < hi)
#define EN(k) ((PH_MASK >> (k)) & 1)
#define SEAM(k) do { if (IN(k) && IN((k) + 1)) { xcd_barrier(bar); if ((PROBE_MASK >> 12) & 1) xcd_barrier(bar); } } while (0)
#define PROBE_MASK 0
#ifndef PROBE_MASK
#define PROBE_MASK 0
#endif
#define SUB(n) (!PROBE_BUILD || args.pad == 0 || ((args.pad >> (n)) & 1))
#define FRAME() Frame F = make_frame(args, lds, lds_raw); F.dry = PROBE_BUILD && (((PROBE_MASK != 0) && (rep == 0) && (args.ph_hi < (1 << 30))) || (args.dry != 0))
#define REPS(k) _Pragma("unroll") for (int rep = ((PROBE_MASK >> (k)) & 1) ? 0 : 1; rep < 2; ++rep)
#define WL(F) ((F).ws + WS_W + (size_t)l * WL_STRIDE)
#define ROW_PARTIALS(WSOFF) do { __syncthreads(); pg8::Unit u_; if (S.next(0, u_) && F.tid < 256 && !F.dry) { const LAS float* xs_ = (const LAS float*)(F.lds + 131072); \
    ((float*)(F.ws + (WSOFF)))[(size_t)(u_.pm * 256 + F.tid) * 4 + u_.pn] = (xs_[F.tid] + xs_[256 + F.tid]) + (xs_[512 + F.tid] + xs_[768 + F.tid]); } __syncthreads(); } while (0)

    if (IN(0)) REPS(11) { FRAME(); phase_convert(F, args); phase_input_rows(F, as_global(args.in[0])); }
    SEAM(0);
    for (int l = 0; l < DEPTH; ++l) {
        const int p0 = 1 + l * NP;
        if (EN(1) && IN(p0 + 1)) REPS(1) { FRAME();
            pg8::Gemm g{D, D, D}; SchedProj S; S.base.init(F.XN, WL(F) + WL_IN, D, D, M, PN, F.G, F.bid);
            EpiProj E{F.PROJ, F.VT, (const float*)(F.ws + WS_PARTB), F.dry};
            pg8::gemm_phase<EpiProj, SchedProj, true, true>(F.lds, g, S, E);
        }
        SEAM(p0 + 1);
        if (EN(2) && IN(p0 + 2)) REPS(2) { FRAME(); phase_prep(F, args, l); }
        SEAM(p0 + 2);
        if (EN(3) && IN(p0 + 3)) REPS(3) { FRAME();
            pg8::Gemm g{D, 256, 256}; SchedLru S{(const char*)F.XC, (const char*)(WL(F) + WL_G), F.G, F.bid};
            EpiLru E{F.XC, F.PROJ + OFF_LX, PN, F.U, as_global(args.in[9]) + (size_t)l * D, as_global(args.in[11]) + (size_t)l * D, (const float*)(F.ws + WS_SPL)};
            if (SUB(0)) pg8::gemm_phase<EpiLru, SchedLru, true, true>(F.lds, g, S, E);
            if (SUB(1)) for (int it = F.bid; it < 256; it += F.G) gla::pass1_item(F, it);
        }
        SEAM(p0 + 3);
        if (EN(4) && IN(p0 + 4)) REPS(4) {
            if (SUB(0)) { REPS(13) { FRAME(); for (int it = F.bid; it < 256; it += F.G) gla::prefix_item(F, it); } }
            __syncthreads();
            if (SUB(1)) { REPS(14) { FRAME(); for (int it = F.bid; it < 256; it += F.G) lru_scan_a(F, it); } }
            __syncthreads();
            if (SUB(2)) { REPS(15) { FRAME(); for (int it = F.bid; it < 256; it += F.G) sb_attn_pair(F, as_global(args.in[13]) + (size_t)l * 128, as_global(args.in[14]) + (size_t)l * 128, it); } }
        }
        SEAM(p0 + 4);
        if (EN(5) && IN(p0 + 5)) REPS(5) { FRAME(); for (int it = F.bid; it < 256; it += F.G) lru_scan_b(F, it); __syncthreads(); for (int it = F.bid; it < 256; it += F.G) gla::pass2_item(F, as_global(args.in[5]) + (size_t)l * 256, it); }
        SEAM(p0 + 5);
        if (EN(6) && IN(p0 + 6)) REPS(6) { FRAME();
            pg8::Gemm g{PN, D, D}; SchedBranch S{(const char*)F.PROJ, (const char*)(WL(F) + WL_BR), F.G, F.bid};
            EpiBranch E{F.PROJ, as_global(args.in[18]) + (size_t)l * 3072, F.U};
            pg8::gemm_phase<EpiBranch, SchedBranch, true, true>(F.lds, g, S, E);
        }
        SEAM(p0 + 6);
        if (EN(7) && IN(p0 + 7)) REPS(7) { FRAME();
            pg8::Gemm g{D, D, D}; pg8::SchedStd S; S.init(F.U, WL(F) + WL_OUT, D, D, M, D, F.G, F.bid);
            pg8::EpiResF32 E{(l == 0) ? as_global(args.in[0]) : (const float*)F.out, F.out, D, F.dry, F.XN, (LAS float*)(F.lds + 131072)};
            pg8::gemm_phase<pg8::EpiResF32, pg8::SchedStd, false, true>(F.lds, g, S, E);
            ROW_PARTIALS(WS_PARTA);
        }
        SEAM(p0 + 7);
        if (EN(9) && IN(p0 + 9)) REPS(9) { FRAME();
            pg8::Gemm g{D, D, D}; pg8::SchedStd S; S.init(F.XN, WL(F) + WL_UP, D, D, M, FF, F.G, F.bid);
            pg8::EpiBf16<1> E{F.PROJ, FF, (const float*)(F.ws + WS_PARTA)};
            pg8::gemm_phase<pg8::EpiBf16<1>, pg8::SchedStd, true, true>(F.lds, g, S, E);
        }
        SEAM(p0 + 9);
        if (EN(10) && IN(p0 + 10)) REPS(10) { FRAME();
            pg8::Gemm g{FF, FF, FF}; pg8::SchedStd S; S.init(F.PROJ, WL(F) + WL_DN, FF, FF, M, D, F.G, F.bid);
            pg8::EpiResF32 E{F.out, F.out, D, F.dry, F.XN, (LAS float*)(F.lds + 131072)};
            pg8::gemm_phase<pg8::EpiResF32, pg8::SchedStd, false, true>(F.lds, g, S, E);
            ROW_PARTIALS(WS_PARTB);
        }
        SEAM(p0 + 10);
    }
#undef IN
#undef SEAM
}

extern "C" void kernel_launch(void* const* d_in, const int* in_sizes, int n_in, void* d_out, int out_size, void* d_ws, size_t ws_size, hipStream_t stream) {
    static int grid = 0;
    if (grid == 0) {
        if (n_in != 23 || out_size != M * D || ws_size < WS_END) { fprintf(stderr, "kernel_launch: unexpected shapes / workspace (n_in %d, out %d, ws %zu, need %zu)\n", n_in, out_size, ws_size, (size_t)WS_END); grid = -1; return; }
        int dev = 0, cus = 0, per_cu = 0;
        if (hipGetDevice(&dev) != hipSuccess || hipDeviceGetAttribute(&cus, hipDeviceAttributeMultiprocessorCount, dev) != hipSuccess) { grid = -1; return; }
        if (hipFuncSetAttribute((const void*)trunk_fwd, hipFuncAttributeMaxDynamicSharedMemorySize, LDS_BYTES) != hipSuccess) { grid = -1; return; }
        if (hipOccupancyMaxActiveBlocksPerMultiprocessor(&per_cu, (const void*)trunk_fwd, 512, LDS_BYTES) != hipSuccess || per_cu < 1) fprintf(stderr, "kernel_launch: occupancy query says %d\n", per_cu);
        (void)hipGetLastError();
        grid = cus;
    }
    if (grid < 0) return;
    (void)hipMemsetAsync((char*)d_ws + WS_CTL, 0, CTL_ZERO_BYTES, stream);
    Args a{};
    for (int i = 0; i < 23; ++i) a.in[i] = (const float*)d_in[i];
    a.out = (float*)d_out; a.ws = (unsigned char*)d_ws;
#if MK_ONE_LAUNCH
    a.ph_lo = 0; a.ph_hi = NPH;
    hipLaunchKernelGGL(trunk_fwd, dim3(grid), dim3(512), LDS_BYTES, stream, a);
#else
    for (int p = 0; p < NPH; ++p) { a.ph_lo = p; a.ph_hi = p + 1;
#ifdef PROBE_PHASE
        if (p >= 1 && (p - 1) % NP == PROBE_PHASE) { a.dry = 1; a.pad = PROBE_SUB; hipLaunchKernelGGL(trunk_fwd, dim3(grid), dim3(512), LDS_BYTES, stream, a); a.dry = 0; a.pad = 0; }
#endif
        if (p >= 1 && ((p - 1) % NP == 0 || (p - 1) % NP == 8)) continue;
        hipLaunchKernelGGL(trunk_fwd, dim3(grid), dim3(512), LDS_BYTES, stream, a); }
#endif
}
```

```cpp
#include <hip/hip_runtime.h>
#include <cstdio>

#ifndef PROBE_SUB
#define PROBE_SUB 0
#endif
#ifndef PROBE_BUILD
#define PROBE_BUILD 0
#endif
#ifndef MK_ONE_LAUNCH
#define MK_ONE_LAUNCH 1
#endif

#define LAS __attribute__((address_space(3)))
#define GAS __attribute__((address_space(1)))
typedef unsigned short bf16;
typedef unsigned v4u __attribute__((ext_vector_type(4)));
typedef unsigned v2u __attribute__((ext_vector_type(2)));
typedef float f32x4 __attribute__((ext_vector_type(4)));
typedef float f32x2 __attribute__((ext_vector_type(2)));
typedef short bf16x8 __attribute__((ext_vector_type(8)));

constexpr int D = 1024, BATCH = 8, T = 2048, M = BATCH * T, DEPTH = 4, FF = 4096;
constexpr int SRC_COLS = 11280;
constexpr int PN = 11264;
constexpr int OFF_GQ = 0, OFF_GK = 512, OFF_GV = 1024, OFF_GG = 2048, OFF_LX = 3072, OFF_LG = 4096, OFF_SQ = 5120, OFF_SK = 6144, OFF_SV = 7168, OFF_GATE = 8192;
constexpr int SRC_GDOWN = 3072;
constexpr float EPS = 1e-6f;
constexpr int NP = 11;
constexpr int NPH = 1 + DEPTH * NP;

constexpr size_t MiB = 1u << 20;
constexpr size_t WS_CTL = 0, CTL_ZERO_BYTES = 64 * 1024;
constexpr size_t WS_DECAY = 1 * MiB;
constexpr size_t WS_WDT = 1536 * 1024;
constexpr size_t WS_SSQ = 2 * MiB;
constexpr size_t WS_PARTA = 2 * MiB;
constexpr size_t WS_PARTB = 3 * MiB;
constexpr size_t WS_SPL = 512 * 1024;
constexpr size_t WS_W = 4 * MiB;
constexpr size_t WL_IN = 0, WL_BR = 22 * MiB, WL_OUT = 28 * MiB, WL_UP = 30 * MiB, WL_DN = 38 * MiB, WL_G = 46 * MiB, WL_STRIDE = 47 * MiB;
constexpr size_t WS_XN = 192 * MiB;
constexpr size_t WS_XC = 224 * MiB;
constexpr size_t WS_U = 256 * MiB;
constexpr size_t WS_KE = 288 * MiB;
constexpr size_t WS_VT = 304 * MiB;
constexpr size_t WS_PROJ = 336 * MiB;
constexpr size_t WS_END = WS_PROJ + (size_t)M * PN * 2;
static_assert(WS_W + DEPTH * WL_STRIDE <= WS_XN, "ws map");
constexpr int CW_BAR = 1024;

constexpr int RING_BYTES = 131072;
constexpr int MISC_OFF = 147456 - 256;
constexpr int LDS_BYTES = 147456;

template <class Tp> __device__ __forceinline__ Tp* as_global(Tp* p) {
#if defined(__HIP_DEVICE_COMPILE__)
    __builtin_assume(!__builtin_amdgcn_is_shared((const __attribute__((address_space(0))) void*)p) && !__builtin_amdgcn_is_private((const __attribute__((address_space(0))) void*)p));
#endif
    return p; }
__device__ __forceinline__ float bf2f(unsigned b) { return __uint_as_float(b << 16); }
__device__ __forceinline__ unsigned f2bf(float f) { unsigned u = __float_as_uint(f); return (u + 0x7fffu + ((u >> 16) & 1u)) >> 16; }
__device__ __forceinline__ unsigned pk2(float lo, float hi) { return f2bf(lo) | (f2bf(hi) << 16); }
__device__ __forceinline__ float blo(unsigned w) { return __uint_as_float(w << 16); }
__device__ __forceinline__ float bhi(unsigned w) { return __uint_as_float(w & 0xffff0000u); }
__device__ __forceinline__ float shx(float v, int o, int lane) { return __int_as_float(__builtin_amdgcn_ds_bpermute((lane ^ o) << 2, __float_as_int(v))); }
__device__ __forceinline__ float wave_sum(float v, int lane) {
#pragma unroll
    for (int o = 1; o < 64; o <<= 1) v += shx(v, o, lane);
    return v;
}
__device__ __forceinline__ float sigmoidf_(float x) { return 1.f / (1.f + __expf(-x)); }
__device__ __forceinline__ float logsigmoidf_(float x) { return fminf(x, 0.f) - log1pf(__expf(-fabsf(x))); }
#define LDS_WAIT() asm volatile("s_waitcnt lgkmcnt(0)" ::: "memory")
__device__ __forceinline__ int opaque_tid() { int t = threadIdx.x; asm volatile("" : "+v"(t)); return t; }

#define XB_TMO      128
#define XB_XCNT(j)  (256  + 64 * (j))
#define XB_XSUB(j)  (1280 + 64 * (j))
#define XB_XGEN(j)  (2304 + 64 * (j))
#define XB_TOP      3328
#define XB_TOPGEN   3392
#define XCD_BAR_WORDS 3456
#define XB_SPIN_CAP (1u << 18)
__device__ __forceinline__ unsigned xb_ld(unsigned* p)              { return __hip_atomic_load(p, __ATOMIC_RELAXED, __HIP_MEMORY_SCOPE_AGENT); }
__device__ __forceinline__ unsigned xb_add(unsigned* p, unsigned v) { return __hip_atomic_fetch_add(p, v, __ATOMIC_RELAXED, __HIP_MEMORY_SCOPE_AGENT); }
__device__ __forceinline__ unsigned xb_xcc_id() { return (unsigned)__builtin_amdgcn_s_getreg((3 << 11) | 20) & 0xFu; }
#define XB_SPIN(cond, bar) do { unsigned _sp = 0; while (cond) { __builtin_amdgcn_s_sleep(1); \
    if ((++_sp & 255u) == 0u) { if (xb_ld(&(bar)[XB_TMO])) break; if (_sp > XB_SPIN_CAP) { atomicAdd(&(bar)[XB_TMO], 1u); break; } } } } while (0)
struct XcdBarrier { unsigned* bar; unsigned x; volatile LAS unsigned* st; };
__device__ __forceinline__ XcdBarrier xcd_barrier_post(unsigned* bar, volatile LAS unsigned* st) {
    XcdBarrier b; b.bar = bar; b.x = xb_xcc_id(); b.st = st;
    if (threadIdx.x == 0) (void)xb_add(&bar[XB_XCNT(b.x)], 1u);
    return b;
}
__device__ __forceinline__ void xcd_barrier_complete(unsigned* bar, unsigned x, unsigned& nloc, unsigned& nx) {
    const unsigned G = gridDim.x * gridDim.y * gridDim.z;
    unsigned sum, cnt, mine, sp = 0u;
    for (;;) {
        sum = 0u; cnt = 0u; mine = 0u;
#pragma unroll
        for (unsigned j = 0; j < 16; ++j) { const unsigned c = xb_ld(&bar[XB_XCNT(j)]); sum += c; cnt += (c > 0u) ? 1u : 0u; mine = (j == x) ? c : mine; }
        if (sum == G) break;
        __builtin_amdgcn_s_sleep(1);
        if ((++sp & 255u) == 0u) { if (xb_ld(&bar[XB_TMO])) break; if (sp > XB_SPIN_CAP) { atomicAdd(&bar[XB_TMO], 1u); break; } }
    }
    nloc = mine > 0u ? mine : 1u; nx = cnt > 0u ? cnt : 1u;
}
__device__ __forceinline__ void xcd_barrier(const XcdBarrier& b) {
    asm volatile("s_waitcnt vmcnt(0)" ::: "memory");
    __syncthreads();
    if (threadIdx.x == 0) {
        unsigned* bar = b.bar; asm volatile("" : "+s"(bar));
        __builtin_amdgcn_s_waitcnt(0);
        unsigned nloc = b.st[0], nx = b.st[1];
        if (nloc == 0u) { xcd_barrier_complete(bar, b.x, nloc, nx); b.st[0] = nloc; b.st[1] = nx; }
        const unsigned old = xb_add(&bar[XB_XSUB(b.x)], 1u);
        const unsigned gen = old / nloc;
        if (old + 1u == (gen + 1u) * nloc) {
            __builtin_amdgcn_fence(__ATOMIC_RELEASE, "agent");
            asm volatile("s_waitcnt vmcnt(0)" ::: "memory");
            const unsigned og = xb_add(&bar[XB_TOP], 1u);
            const unsigned tg = og / nx;
            if (og + 1u == (tg + 1u) * nx) xb_add(&bar[XB_TOPGEN], 1u);
            else XB_SPIN(xb_ld(&bar[XB_TOPGEN]) == tg, bar);
            __builtin_amdgcn_fence(__ATOMIC_ACQUIRE, "agent");
            xb_add(&bar[XB_XGEN(b.x)], 1u);
            asm volatile("s_waitcnt vmcnt(0)" ::: "memory");
        } else {
            XB_SPIN(xb_ld(&bar[XB_XGEN(b.x)]) == gen, bar);
            __builtin_amdgcn_fence(__ATOMIC_ACQUIRE, "agent");
            asm volatile("s_waitcnt vmcnt(0)" ::: "memory");
        }
    }
    __syncthreads();
}

namespace pg8 {
constexpr int BM = 256, BK = 64, HALF = 128, HTB = HALF * BK * 2, STAGE_BYTES = 8 * HTB, NXCD = 8, WGM = 8;
__host__ __device__ __forceinline__ int lds_byte(int r, int c) { const int st = (r >> 4) * 2 + (c >> 5), rr = r & 15, cc = c & 31, ob = rr * 64 + cc * 2; return st * 1024 + (ob ^ (((ob >> 9) & 1) << 5)); }
__host__ __device__ __forceinline__ void stage_rc(int b, int& R, int& C) { const int st = b / 1024, sb = b % 1024, swz = sb ^ (((sb >> 9) & 1) << 5); R = (st >> 1) * 16 + swz / 64; C = (st & 1) * 32 + (swz % 64) / 2; }
__host__ __device__ __forceinline__ int perm32(int rho) { const int n = rho >> 4, i = rho & 15; return 8 * (i >> 2) + 4 * n + (i & 3); }
struct Unit { int pm, pn, aux; };
struct Gemm { int lda, ldb, K; };
__device__ __forceinline__ unsigned cvt_pk_bf16(float lo, float hi) { unsigned r; asm volatile("v_cvt_pk_bf16_f32 %0, %1, %2" : "=v"(r) : "v"(lo), "v"(hi)); return r; }

struct SchedStd {
    const char* A; const char* B; size_t tstepA, tstepB; int nM, nN, nwg, G, c;
    __device__ __forceinline__ void init(const void* A_, const void* B_, int lda, int ldb, int Mr, int Nc, int G_, int c_) { A = (const char*)A_; B = (const char*)B_; tstepA = (size_t)BM * lda * 2; tstepB = (size_t)BM * ldb * 2; nM = Mr / BM; nN = Nc / BM; nwg = nM * nN; G = G_; c = c_; }
    __device__ __forceinline__ bool next(int i, Unit& u) const {
        const long L = (long)i * G + c; if (L >= nwg) return false;
        int wgid = (int)L; { const int q = nwg / NXCD, r = nwg % NXCD, xcd = wgid % NXCD, off = wgid / NXCD; wgid = (xcd < r ? xcd * (q + 1) : r * (q + 1) + (xcd - r) * q) + off; }
        const int nig = WGM * nN, gid = wgid / nig, fm = gid * WGM, gsz = (nM - fm) < WGM ? (nM - fm) : WGM;
        u.pm = fm + ((wgid % nig) % gsz); u.pn = (wgid % nig) / gsz; u.aux = 0; return true;
    }
    __device__ __forceinline__ const char* abase(const Unit& u) const { return A + (size_t)u.pm * tstepA; }
    __device__ __forceinline__ const char* bbase(const Unit& u) const { return B + (size_t)u.pn * tstepB; }
};

template <class Epi, class Sched, bool ALIGN_EPI, bool SP2>
__device__ __forceinline__ void gemm_phase(LAS unsigned char* lds, const Gemm g, const Sched& S, const Epi& E) {
    const int tid = opaque_tid(), wid = __builtin_amdgcn_readfirstlane(tid >> 6), lane = tid & 63, wr = wid >> 2, wc = wid & 3, fr = lane & 15, fq = lane >> 4;
    const int K = g.K, nt = K / BK;
    unsigned voffA[2], voffB[2];
#pragma unroll
    for (int i = 0; i < 2; ++i) { int R, C; stage_rc(tid * 16 + i * 8192, R, C); const int Rb = Epi::PERM ? ((R & ~31) + perm32(R & 31)) : R;
        voffA[i] = (unsigned)(R * g.lda + C) * 2u; voffB[i] = (unsigned)(Rb * g.ldb + C) * 2u; }
    const size_t kstep = (size_t)(BK * 2);
    const size_t hstepA = (size_t)HALF * g.lda * 2, hstepB = (size_t)HALF * g.ldb * 2;
    const unsigned ldsw = (unsigned)wid * 1024u;
    const int aoff = lds_byte(wr * 64 + fr, fq * 8), boff = lds_byte(wc * 32 + fr, fq * 8);
#define PG8_SA(b, h) (((b) * 2 + (h)) * HTB)
#define PG8_SB(b, h) ((4 + (b) * 2 + (h)) * HTB)
#define PG8_STAGE(bufoff, gbase, voff) do { _Pragma("unroll") for (int _i = 0; _i < 2; ++_i) \
        __builtin_amdgcn_global_load_lds((const unsigned*)((const char*)(gbase) + (voff)[_i]), (LAS unsigned*)(lds + (bufoff) + ldsw + _i * 8192), 16, 0, 0); } while (0)
#define PG8_LDA(dst, b, h) do { _Pragma("unroll") for (int m = 0; m < 4; ++m) _Pragma("unroll") for (int k = 0; k < 2; ++k) dst[m][k] = *(const LAS bf16x8*)(lds + PG8_SA(b, h) + aoff + m * 2048 + k * 1024); } while (0)
#define PG8_LDB(dst, b, h) do { _Pragma("unroll") for (int n = 0; n < 2; ++n) _Pragma("unroll") for (int k = 0; k < 2; ++k) dst[n][k] = *(const LAS bf16x8*)(lds + PG8_SB(b, h) + boff + n * 2048 + k * 1024); } while (0)
#define PG8_MMA(ai, bj, At, Bt) do { __builtin_amdgcn_s_setprio(1); _Pragma("unroll") for (int m = 0; m < 4; ++m) _Pragma("unroll") for (int n = 0; n < 2; ++n) _Pragma("unroll") for (int k = 0; k < 2; ++k) \
        acc[ai][bj][m][n] = __builtin_amdgcn_mfma_f32_16x16x32_bf16(Bt[n][k], At[m][k], acc[ai][bj][m][n], 0, 0, 0); __builtin_amdgcn_s_setprio(0); } while (0)
#define PG8_WAIT_V(n) asm volatile("s_waitcnt vmcnt(" #n ")" ::: "memory")
#define PG8_WAIT_L(n) asm volatile("s_waitcnt lgkmcnt(" #n ")" ::: "memory")
#define PG8_BAR __builtin_amdgcn_s_barrier()
#define PG8_SCHED __builtin_amdgcn_sched_barrier(0)
    Unit cur, nxt; int ui = 0;
    if (!S.next(0, cur)) return;
    f32x4 acc[2][2][4][2];
#pragma unroll
    for (int a = 0; a < 2; ++a)
#pragma unroll
        for (int b = 0; b < 2; ++b)
#pragma unroll
            for (int m = 0; m < 4; ++m)
#pragma unroll
                for (int n = 0; n < 2; ++n) acc[a][b][m][n] = (f32x4){0.f, 0.f, 0.f, 0.f};
    bf16x8 At[4][2], B0[2][2], B1[2][2];
    const char* cA = S.abase(cur); const char* cB = S.bbase(cur);
    LAS float* const xrs = (LAS float*)(lds + 131072 + 4096);
    f32x4 rsreg = {0.f, 0.f, 0.f, 0.f};
    if constexpr (Epi::ROW_RS) { if (tid < 256) { rsreg = *(const f32x4*)(E.part + (size_t)(cur.pm * BM + tid) * 4); xrs[tid] = __builtin_amdgcn_rsqf(((rsreg.x + rsreg.y) + (rsreg.z + rsreg.w)) * (1.f / 1024.f) + 1e-6f); } }
    if constexpr (SP2) {
        PG8_STAGE(PG8_SB(0, 0), cB, voffB); PG8_STAGE(PG8_SB(0, 1), cB + hstepB, voffB); PG8_STAGE(PG8_SA(0, 0), cA, voffA); PG8_STAGE(PG8_SA(0, 1), cA + hstepA, voffA);
        if (wr == 1) PG8_BAR;
        PG8_WAIT_V(2); PG8_BAR;
        PG8_STAGE(PG8_SB(1, 0), cB + kstep, voffB); PG8_STAGE(PG8_SA(1, 0), cA + kstep, voffA); PG8_STAGE(PG8_SB(1, 1), cB + hstepB + kstep, voffB);
        PG8_WAIT_V(6); PG8_BAR;
    } else {
        PG8_STAGE(PG8_SB(0, 0), cB, voffB); PG8_STAGE(PG8_SA(0, 0), cA, voffA); PG8_STAGE(PG8_SB(0, 1), cB + hstepB, voffB); PG8_STAGE(PG8_SA(0, 1), cA + hstepA, voffA);
        if (wr == 1) PG8_BAR;
        PG8_WAIT_V(4); PG8_BAR;
        PG8_STAGE(PG8_SB(1, 0), cB + kstep, voffB); PG8_STAGE(PG8_SA(1, 0), cA + kstep, voffA); PG8_STAGE(PG8_SB(1, 1), cB + hstepB + kstep, voffB);
        PG8_WAIT_V(6); PG8_BAR;
    }
    for (;;) {
        const bool has_next = S.next(ui + 1, nxt);
        const char* nA = has_next ? S.abase(nxt) : cA; const char* nB = has_next ? S.bbase(nxt) : cB;
        if constexpr (Epi::ROW_RS) { if (has_next && tid < 256) rsreg = *(const f32x4*)(E.part + (size_t)(nxt.pm * BM + tid) * 4); }
#pragma nounroll
        for (int t = 0; t < nt; t += 2) {
            const bool last = (t == nt - 2);
            const char* a1 = cA + (size_t)(t + 1) * kstep;
            const char* a2 = last ? nA : cA + (size_t)(t + 2) * kstep; const char* b2 = last ? nB : cB + (size_t)(t + 2) * kstep;
            const char* a3 = a2 + kstep; const char* b3 = b2 + kstep;
            if constexpr (SP2) {
            PG8_LDB(B0, 0, 0); PG8_LDB(B1, 0, 1); PG8_SCHED; PG8_LDA(At, 0, 0); PG8_STAGE(PG8_SA(1, 1), a1 + hstepA, voffA);
            PG8_WAIT_V(8); PG8_WAIT_L(0); PG8_BAR; PG8_MMA(0, 0, At, B0); PG8_MMA(0, 1, At, B1); PG8_BAR; PG8_SCHED;
            PG8_LDA(At, 0, 1); PG8_STAGE(PG8_SB(0, 0), b2, voffB); PG8_STAGE(PG8_SB(0, 1), b2 + hstepB, voffB); PG8_STAGE(PG8_SA(0, 0), a2, voffA);
            PG8_WAIT_V(8); PG8_WAIT_L(0); PG8_BAR; PG8_MMA(1, 0, At, B0); PG8_MMA(1, 1, At, B1); PG8_BAR; PG8_SCHED;
            PG8_LDB(B0, 1, 0); PG8_LDB(B1, 1, 1); PG8_SCHED; PG8_LDA(At, 1, 0); PG8_STAGE(PG8_SA(0, 1), a2 + hstepA, voffA);
            PG8_WAIT_V(8); PG8_WAIT_L(0); PG8_BAR; PG8_MMA(0, 0, At, B0); PG8_MMA(0, 1, At, B1); PG8_BAR; PG8_SCHED;
            PG8_LDA(At, 1, 1); PG8_STAGE(PG8_SB(1, 0), b3, voffB); PG8_STAGE(PG8_SB(1, 1), b3 + hstepB, voffB); PG8_STAGE(PG8_SA(1, 0), a3, voffA);
            PG8_WAIT_V(8); PG8_WAIT_L(0); PG8_BAR; PG8_MMA(1, 0, At, B0); PG8_MMA(1, 1, At, B1); PG8_BAR; PG8_SCHED;
            } else {
            PG8_LDB(B0, 0, 0); PG8_SCHED; PG8_LDA(At, 0, 0); PG8_STAGE(PG8_SA(1, 1), a1 + hstepA, voffA);
            PG8_WAIT_L(8); PG8_BAR; PG8_WAIT_L(0); PG8_MMA(0, 0, At, B0); PG8_BAR; PG8_SCHED;
            PG8_LDB(B1, 0, 1); PG8_STAGE(PG8_SB(0, 0), b2, voffB);
            PG8_BAR; PG8_WAIT_L(0); PG8_MMA(0, 1, At, B1); PG8_BAR;
            PG8_LDA(At, 0, 1); PG8_STAGE(PG8_SA(0, 0), a2, voffA);
            PG8_BAR; PG8_WAIT_L(0); PG8_MMA(1, 0, At, B0); PG8_BAR; PG8_SCHED;
            PG8_STAGE(PG8_SB(0, 1), b2 + hstepB, voffB);
            PG8_WAIT_V(6); PG8_BAR; PG8_MMA(1, 1, At, B1); PG8_BAR;
            PG8_LDB(B0, 1, 0); PG8_SCHED; PG8_LDA(At, 1, 0); PG8_STAGE(PG8_SA(0, 1), a2 + hstepA, voffA);
            PG8_WAIT_L(8); PG8_BAR; PG8_WAIT_L(0); PG8_MMA(0, 0, At, B0); PG8_BAR; PG8_SCHED;
            PG8_LDB(B1, 1, 1); PG8_STAGE(PG8_SB(1, 0), b3, voffB);
            PG8_BAR; PG8_WAIT_L(0); PG8_MMA(0, 1, At, B1); PG8_BAR;
            PG8_LDA(At, 1, 1); PG8_STAGE(PG8_SA(1, 0), a3, voffA);
            PG8_BAR; PG8_WAIT_L(0); PG8_MMA(1, 0, At, B0); PG8_BAR; PG8_SCHED;
            PG8_STAGE(PG8_SB(1, 1), b3 + hstepB, voffB);
            PG8_WAIT_V(6); PG8_BAR; PG8_MMA(1, 1, At, B1); PG8_BAR;
            }
        }
        if constexpr (Epi::ROW_RS) { if (has_next && tid < 256) xrs[((ui + 1) & 1) * 256 + tid] = __builtin_amdgcn_rsqf(((rsreg.x + rsreg.y) + (rsreg.z + rsreg.w)) * (1.f / 1024.f) + 1e-6f); }
        if constexpr (ALIGN_EPI) { if (wr == 0) PG8_BAR; }
        const bool zero = E(acc, cur, wr, wc, fr, fq, xrs + (ui & 1) * 256);
        if (!has_next) break;
        if (zero) {
#pragma unroll
        for (int a = 0; a < 2; ++a)
#pragma unroll
            for (int b = 0; b < 2; ++b)
#pragma unroll
                for (int m = 0; m < 4; ++m)
#pragma unroll
                    for (int n = 0; n < 2; ++n) acc[a][b][m][n] = (f32x4){0.f, 0.f, 0.f, 0.f};
        }
        cur = nxt; cA = nA; cB = nB; ++ui;
        if constexpr (ALIGN_EPI) { if (wr == 1) PG8_BAR; }
    }
    PG8_WAIT_V(0);
    if constexpr (!ALIGN_EPI) { if (wr == 0) PG8_BAR; }
    PG8_BAR;
#undef PG8_SA
#undef PG8_SB
#undef PG8_STAGE
#undef PG8_LDA
#undef PG8_LDB
#undef PG8_MMA
#undef PG8_WAIT_V
#undef PG8_WAIT_L
#undef PG8_BAR
#undef PG8_SCHED
}

__device__ __forceinline__ float row_rs(const float* part, int row) {
    const f32x4 a = *(const f32x4*)(part + (size_t)row * 4);
    return __builtin_amdgcn_rsqf(((a.x + a.y) + (a.z + a.w)) * (1.f / 1024.f) + 1e-6f);
}
template <int ACT> struct EpiBf16 {
    static constexpr bool PERM = true, ROW_RS = true;
    bf16* O; int ldc; const float* part;
    __device__ __forceinline__ bool operator()(f32x4 (&acc)[2][2][4][2], const Unit& u, int wr, int wc, int fr, int fq, const LAS float* xrs) const {
        const int row0 = u.pm * BM + wr * 64 + fr, col0 = u.pn * BM + wc * 32 + 8 * fq;
        float rsv[8];
#pragma unroll
        for (int i = 0; i < 8; ++i) rsv[i] = xrs[wr * 64 + fr + (i >> 2) * HALF + (i & 3) * 16];
#pragma unroll
        for (int ai = 0; ai < 2; ++ai)
#pragma unroll
            for (int m = 0; m < 4; ++m) { bf16* rowp = O + (size_t)(row0 + ai * HALF + m * 16) * ldc + col0; const float rs = rsv[ai * 4 + m];
#pragma unroll
                for (int bj = 0; bj < 2; ++bj) { f32x4 v0 = acc[ai][bj][m][0] * rs, v1 = acc[ai][bj][m][1] * rs;
                    if (ACT == 1) {
#pragma unroll
                        for (int j = 0; j < 4; ++j) { const float a = fmaxf(v0[j], 0.f), b = fmaxf(v1[j], 0.f); v0[j] = a * a; v1[j] = b * b; } }
                    v4u w; w.x = cvt_pk_bf16(v0[0], v0[1]); w.y = cvt_pk_bf16(v0[2], v0[3]); w.z = cvt_pk_bf16(v1[0], v1[1]); w.w = cvt_pk_bf16(v1[2], v1[3]);
                    __builtin_nontemporal_store(w, (v4u*)(rowp + bj * HALF)); } }
        return true;
    }
};
struct EpiResF32 {
    static constexpr bool PERM = false, ROW_RS = false;
    const float* base; float* out; int ldc; bool dry; bf16* xb; LAS float* xs;
    __device__ __forceinline__ bool operator()(f32x4 (&acc)[2][2][4][2], const Unit& u, int wr, int wc, int fr, int fq, const LAS float* xrs) const {
        const int row0 = u.pm * BM + wr * 64 + fr, col0 = u.pn * BM + wc * 32 + 4 * fq;
        f32x4 bs[2][4];
#define RES_LOAD(slot, gi) do { const size_t off_ = (size_t)(row0 + ((gi) >> 2) * HALF + ((gi) & 3) * 16) * ldc + col0; \
        bs[slot][0] = *(const f32x4*)(base + off_); bs[slot][1] = *(const f32x4*)(base + off_ + 16); bs[slot][2] = *(const f32x4*)(base + off_ + HALF); bs[slot][3] = *(const f32x4*)(base + off_ + HALF + 16); } while (0)
        RES_LOAD(0, 0);
#pragma unroll
        for (int gi = 0; gi < 8; ++gi) { const int ai = gi >> 2, m = gi & 3;
            if (gi < 7) RES_LOAD((gi + 1) & 1, gi + 1);
            const int row = row0 + ai * HALF + m * 16; const size_t off = (size_t)row * ldc + col0; float ss = 0.f;
#pragma unroll
            for (int bj = 0; bj < 2; ++bj)
#pragma unroll
                for (int n = 0; n < 2; ++n) { const f32x4 v = bs[gi & 1][bj * 2 + n] + acc[ai][bj][m][n];
                    ss += (v.x * v.x + v.y * v.y) + (v.z * v.z + v.w * v.w);
                    if (!dry) { *(f32x4*)(out + off + bj * HALF + n * 16) = v; v2u w; w.x = cvt_pk_bf16(v.x, v.y); w.y = cvt_pk_bf16(v.z, v.w); *(v2u*)(xb + off + bj * HALF + n * 16) = w; } }
            ss += __shfl_xor(ss, 16); ss += __shfl_xor(ss, 32);
            if (fq == 0) xs[wc * 256 + (row - u.pm * BM)] = ss; }
#undef RES_LOAD
        return true;
    }
};
}

struct Args { const float* in[23]; float* out; unsigned char* ws; int ph_lo, ph_hi, dry, pad; };

struct Frame {
    LAS unsigned char* lds; unsigned char* ldsg;
    int tid, lane, wave, G, bid; bool dry;
    float* out; unsigned char* ws;
    bf16 *XN, *XC, *U, *KE, *VT, *PROJ; float *DECAY, *SSQ;
};

__device__ __forceinline__ void transpose_item(const float* W, int ldw, int nblk, bf16* WT, int K, int row_off, LAS float* scr, int item, int lane, const float* gk = nullptr) {
    const int kb = item / nblk, nb = item % nblk, k0 = 64 * kb, n0 = 32 * nb;
    float wv[32];
#pragma unroll
    for (int i = 0; i < 32; ++i) wv[i] = W[(size_t)(k0 + 2 * i + (lane >> 5)) * ldw + n0 + (lane & 31)];
#pragma unroll
    for (int i = 0; i < 32; ++i) { const int kk = 2 * i + (lane >> 5); scr[kk * 33 + (lane & 31)] = wv[i] * (gk ? gk[k0 + kk] : 1.0f); }
    LDS_WAIT(); asm volatile("" ::: "memory");
    const int c = lane & 7;
#pragma unroll
    for (int j = 0; j < 4; ++j) { const int n = (lane >> 3) + 8 * j; const LAS float* s = scr + (8 * c) * 33 + n;
        v4u o; o.x = pk2(s[0 * 33], s[1 * 33]); o.y = pk2(s[2 * 33], s[3 * 33]); o.z = pk2(s[4 * 33], s[5 * 33]); o.w = pk2(s[6 * 33], s[7 * 33]);
        *(v4u*)(WT + (size_t)(row_off + n0 + n) * K + k0 + 8 * c) = o; }
    LDS_WAIT(); asm volatile("" ::: "memory");
}
__device__ __forceinline__ void phase_convert(Frame& F, const Args& A) {
    F.tid = opaque_tid(); F.lane = F.tid & 63;
    { bf16* wdt = (bf16*)(F.ws + WS_WDT);
      for (int idx = F.bid * 512 + F.tid; idx < DEPTH * 16 * D; idx += F.G * 512) { const int l = idx >> 14, n = (idx >> 10) & 15, k = idx & 1023;
          wdt[idx] = (bf16)f2bf(as_global(A.in[2])[((size_t)l * D + k) * SRC_COLS + SRC_GDOWN + n] * as_global(A.in[1])[(size_t)l * D + k]); } }
    LAS float* scr = (LAS float*)(F.lds + F.wave * 16384);
    const int gw = F.bid * 8 + F.wave, NGW = F.G * 8;
    constexpr int PER_L = 1536 + 4096 + 1536 + 512 + 2048 + 2048 + 256;
    for (int it = gw; it < DEPTH * PER_L; it += NGW) {
        const int l = it / PER_L; int r = it % PER_L;
        unsigned char* wl = F.ws + WS_W + (size_t)l * WL_STRIDE;
        const float* win = as_global(A.in[2]) + (size_t)l * D * SRC_COLS;
        if (r < 1536) { transpose_item(win, SRC_COLS, 96, (bf16*)(wl + WL_IN), D, 0, scr, r, F.lane, as_global(A.in[1]) + (size_t)l * D); continue; } r -= 1536;
        if (r < 4096) { transpose_item(win + 3088, SRC_COLS, 256, (bf16*)(wl + WL_IN), D, 3072, scr, r, F.lane, as_global(A.in[1]) + (size_t)l * D); continue; } r -= 4096;
        if (r < 1536) { const int br = r / 512; const float* wb = br == 0 ? as_global(A.in[15]) : (br == 1 ? as_global(A.in[16]) : as_global(A.in[17])); transpose_item(wb + (size_t)l * D * D, D, 32, (bf16*)(wl + WL_BR), D, br * 1024, scr, r % 512, F.lane); continue; } r -= 1536;
        if (r < 512) { transpose_item(as_global(A.in[19]) + (size_t)l * D * D, D, 32, (bf16*)(wl + WL_OUT), D, 0, scr, r, F.lane); continue; } r -= 512;
        if (r < 2048) { transpose_item(as_global(A.in[21]) + (size_t)l * D * FF, FF, 128, (bf16*)(wl + WL_UP), D, 0, scr, r, F.lane, as_global(A.in[20]) + (size_t)l * D); continue; } r -= 2048;
        if (r < 2048) { transpose_item(as_global(A.in[22]) + (size_t)l * D * FF, D, 32, (bf16*)(wl + WL_DN), FF, 0, scr, r, F.lane); continue; } r -= 2048;
        { const int mtx = r / 32, rr = r % 32, blk = mtx >> 1, gate = mtx & 1, n0 = (rr % 8) * 32;
          const int row_off = (blk * 2 + (n0 >> 7)) * 256 + gate * 128 + (n0 & 127) - n0;
          const float* w = (gate ? as_global(A.in[10]) : as_global(A.in[8])) + (size_t)l * 262144 + (size_t)blk * 65536;
          transpose_item(w, 256, 8, (bf16*)(wl + WL_G), 256, row_off, scr, rr, F.lane); }
    }
}

__device__ __forceinline__ void phase_input_rows(Frame& F, const float* x) {
    const int gw = F.bid * 8 + F.wave, NGW = F.G * 8;
    float* part = (float*)(F.ws + WS_PARTB);
    for (int m = gw; m < M; m += NGW) {
        const f32x4* xr = (const f32x4*)(x + (size_t)m * D) + F.lane;
        f32x4 v[4]; float s = 0.f;
#pragma unroll
        for (int j = 0; j < 4; ++j) { v[j] = xr[64 * j]; s += (v[j].x * v[j].x + v[j].y * v[j].y) + (v[j].z * v[j].z + v[j].w * v[j].w); }
        s = wave_sum(s, F.lane);
        v2u* o8 = (v2u*)(F.XN + (size_t)m * D) + F.lane;
#pragma unroll
        for (int j = 0; j < 4; ++j) { v2u w; w.x = pk2(v[j].x, v[j].y); w.y = pk2(v[j].z, v[j].w); o8[64 * j] = w; }
        if (F.lane < 4) part[(size_t)m * 4 + F.lane] = F.lane == 0 ? s : 0.f;
    }
}

__device__ __forceinline__ void phase_rmsnorm(Frame& F, const float* x, const float* g, bf16* out) {
    F.tid = opaque_tid(); F.lane = F.tid & 63;
    const int gw = F.bid * 8 + F.wave, NGW = F.G * 8;
    f32x4 gv[4];
#pragma unroll
    for (int j = 0; j < 4; ++j) gv[j] = *((const f32x4*)g + F.lane + 64 * j);
    for (int m = gw; m < M; m += NGW) {
        const f32x4* xr = (const f32x4*)(x + (size_t)m * D) + F.lane;
        f32x4 v[4]; float s = 0.f;
#pragma unroll
        for (int j = 0; j < 4; ++j) { v[j] = xr[64 * j]; s += (v[j].x * v[j].x + v[j].y * v[j].y) + (v[j].z * v[j].z + v[j].w * v[j].w); }
        const float rs = 1.0f / sqrtf(wave_sum(s, F.lane) * (1.f / D) + EPS);
        v2u* o8 = (v2u*)(out + (size_t)m * D) + F.lane;
#pragma unroll
        for (int j = 0; j < 4; ++j) { v2u w; w.x = pk2(v[j].x * rs * gv[j].x, v[j].y * rs * gv[j].y); w.y = pk2(v[j].z * rs * gv[j].z, v[j].w * rs * gv[j].w); o8[64 * j] = w; }
    }
}

__device__ __forceinline__ void phase_prep(Frame& F, const Args& A, int l) {
#define PSUB(n) (!PROBE_BUILD || A.pad == 0 || ((A.pad >> (n)) & 1))
    F.tid = opaque_tid(); F.lane = F.tid & 63;
    const int gt = F.bid * 512 + F.tid, NGT = F.G * 512;
    if (PSUB(0)) {
        const float* cw = as_global(A.in[6]) + (size_t)l * 4 * D; const float* cb = as_global(A.in[7]) + (size_t)l * D;
        const bf16* __restrict__ lxp = F.PROJ; bf16* __restrict__ xcp = F.XC;
        for (int idx = gt; idx < (M / 8) * 128; idx += NGT) {
            const int c0 = (idx & 127) * 8, r0 = (idx >> 7) * 8, t0 = r0 & (T - 1);
            v4u xin[11];
#pragma unroll
            for (int i = 0; i < 11; ++i) xin[i] = (i >= 3 || t0 != 0) ? *(const v4u*)(lxp + (size_t)(r0 - 3 + i) * PN + OFF_LX + c0) : (v4u){0u, 0u, 0u, 0u};
            float w[4][8], bb[8];
#pragma unroll
            for (int j = 0; j < 8; ++j) { bb[j] = cb[c0 + j]; w[0][j] = cw[c0 + j]; w[1][j] = cw[D + c0 + j]; w[2][j] = cw[2 * D + c0 + j]; w[3][j] = cw[3 * D + c0 + j]; }
#pragma unroll
            for (int r = 0; r < 8; ++r) { float acc[8];
#pragma unroll
                for (int j = 0; j < 8; ++j) acc[j] = bb[j];
#pragma unroll
                for (int jj = 0; jj < 4; ++jj) { const v4u xv = xin[r + jj];
                    acc[0] += w[jj][0] * blo(xv.x); acc[1] += w[jj][1] * bhi(xv.x); acc[2] += w[jj][2] * blo(xv.y); acc[3] += w[jj][3] * bhi(xv.y);
                    acc[4] += w[jj][4] * blo(xv.z); acc[5] += w[jj][5] * bhi(xv.z); acc[6] += w[jj][6] * blo(xv.w); acc[7] += w[jj][7] * bhi(xv.w); }
                v4u o; o.x = pk2(acc[0], acc[1]); o.y = pk2(acc[2], acc[3]); o.z = pk2(acc[4], acc[5]); o.w = pk2(acc[6], acc[7]);
                *(v4u*)(xcp + (size_t)(r0 + r) * D + c0) = o; }
        }
    }
    if (F.bid == 0) { const float* lam = as_global(A.in[12]) + (size_t)l * D; float* spl = (float*)(F.ws + WS_SPL);
        for (int c = F.tid; c < D; c += 512) { const float nl = -lam[c]; spl[c] = fmaxf(nl, 0.f) + 0.6931471805599453f * __builtin_amdgcn_logf(1.0f + __builtin_amdgcn_exp2f(-1.4426950408889634f * fabsf(nl))); } }
    if (PSUB(3)) {
        LAS float* adp = (LAS float*)F.lds;
        LAS float* ad = adp + 2048;
        const bf16* wdt = (const bf16*)(F.ws + WS_WDT) + (size_t)l * 16 * D;
        const float* wup = as_global(A.in[3]) + (size_t)l * 16 * 512; const float* bal = as_global(A.in[4]) + (size_t)l * 512;
        for (int ch = F.bid; ch < M / 64; ch += F.G) {
            const int m0 = ch * 64;
            __syncthreads();
            { const int rg = F.wave & 3, kh = F.wave >> 2, l15 = F.lane & 15, q4 = F.lane >> 4;
              const bf16* ap = F.XN + (size_t)(m0 + 16 * rg + l15) * D + 512 * kh + 8 * q4; const bf16* bp = wdt + (size_t)l15 * D + 512 * kh + 8 * q4;
              f32x4 acc = {0.f, 0.f, 0.f, 0.f};
#pragma unroll 4
              for (int ks = 0; ks < 16; ++ks) acc = __builtin_amdgcn_mfma_f32_16x16x32_bf16(*reinterpret_cast<const bf16x8*>(ap + 32 * ks), *reinterpret_cast<const bf16x8*>(bp + 32 * ks), acc, 0, 0, 0);
#pragma unroll
              for (int r = 0; r < 4; ++r) adp[kh * 1024 + (16 * rg + 4 * q4 + r) * 16 + l15] = acc[r] * pg8::row_rs((const float*)(F.ws + WS_PARTB), m0 + 16 * rg + 4 * q4 + r); }
            __syncthreads();
            ad[F.tid] = adp[F.tid] + adp[1024 + F.tid]; ad[512 + F.tid] = adp[512 + F.tid] + adp[1536 + F.tid];
            __syncthreads();
            const int c = F.tid;
            float wu[16];
#pragma unroll
            for (int j = 0; j < 16; ++j) wu[j] = wup[j * 512 + c];
            const float ba = bal[c];
            float cum = 0.f;
            bf16 qA[8], kA[8], qB[8], kB[8];
#define GP_LOAD(Q, K, t8_) do { _Pragma("unroll") for (int tt = 0; tt < 8; ++tt) { Q[tt] = F.PROJ[(size_t)(m0 + (t8_) + tt) * PN + OFF_GQ + c]; K[tt] = F.PROJ[(size_t)(m0 + (t8_) + tt) * PN + OFF_GK + c]; } } while (0)
#define GP_STEP(Q, K, t8_) do { _Pragma("unroll") for (int tt = 0; tt < 8; ++tt) { const int t = (t8_) + tt; float lg = ba; \
                _Pragma("unroll") for (int j4 = 0; j4 < 4; ++j4) { const f32x4 a4 = *reinterpret_cast<const LAS f32x4*>(ad + t * 16 + 4 * j4); lg += a4.x * wu[4 * j4] + a4.y * wu[4 * j4 + 1] + a4.z * wu[4 * j4 + 2] + a4.w * wu[4 * j4 + 3]; } \
                const float ax = fabsf(lg) * 1.4426950408889634f; const float l2 = __builtin_amdgcn_logf(1.0f + __builtin_amdgcn_exp2f(-ax));     \
                cum += (fminf(lg, 0.f) * 1.4426950408889634f - l2) * (1.f / 16.f); \
                const float e = __builtin_amdgcn_exp2f(cum), ei = __builtin_amdgcn_rcpf(e); \
                if (!F.dry) { F.PROJ[(size_t)(m0 + t) * PN + OFF_GQ + c] = (bf16)f2bf(bf2f(Q[tt]) * 0.08838834764831845f * e); F.PROJ[(size_t)(m0 + t) * PN + OFF_GK + c] = (bf16)f2bf(bf2f(K[tt]) * ei); } } } while (0)
            GP_LOAD(qA, kA, 0);
#pragma nounroll
            for (int t16 = 0; t16 < 64; t16 += 16) {
                GP_LOAD(qB, kB, t16 + 8); GP_STEP(qA, kA, t16);
                if (t16 + 16 < 64) GP_LOAD(qA, kA, t16 + 16);
                GP_STEP(qB, kB, t16 + 8);
            }
#undef GP_LOAD
#undef GP_STEP
            F.DECAY[(size_t)ch * 512 + c] = __builtin_amdgcn_exp2f(cum);
        }
    }
}

struct SchedProj {
    pg8::SchedStd base;
    __device__ __forceinline__ bool next(int i, pg8::Unit& u) const { if (!base.next(i, u)) return false; u.aux = 0; return true; }
    __device__ __forceinline__ const char* abase(const pg8::Unit& u) const { return u.aux ? base.B + (size_t)u.pn * base.tstepB : base.A + (size_t)u.pm * base.tstepA; }
    __device__ __forceinline__ const char* bbase(const pg8::Unit& u) const { return u.aux ? base.A + (size_t)u.pm * base.tstepA : base.B + (size_t)u.pn * base.tstepB; }
};
struct EpiProj {
    static constexpr bool PERM = true, ROW_RS = true;
    bf16* O; bf16* VT; const float* part; bool dry;
    __device__ __forceinline__ bool operator()(f32x4 (&acc)[2][2][4][2], const pg8::Unit& u, int wr, int wc, int fr, int fq, const LAS float* xrs) const {
        bf16* base = u.aux ? VT : O; const size_t ldc = u.aux ? (size_t)M : (size_t)PN;
        const int row0 = (u.aux ? (u.pn - 4) : u.pm) * 256 + wr * 64 + fr, col0 = (u.aux ? u.pm : u.pn) * 256 + wc * 32 + 8 * fq;
        float rsv[8];
#pragma unroll
        for (int i = 0; i < 8; ++i) rsv[i] = xrs[wr * 64 + fr + (i >> 2) * 128 + (i & 3) * 16];
#pragma unroll
        for (int ai = 0; ai < 2; ++ai)
#pragma unroll
            for (int m = 0; m < 4; ++m) { bf16* rowp = base + (size_t)(row0 + ai * 128 + m * 16) * ldc + col0; const float rs = rsv[ai * 4 + m];
#pragma unroll
                for (int bj = 0; bj < 2; ++bj) { const f32x4 v0 = acc[ai][bj][m][0] * rs, v1 = acc[ai][bj][m][1] * rs;
                    v4u w; w.x = pg8::cvt_pk_bf16(v0[0], v0[1]); w.y = pg8::cvt_pk_bf16(v0[2], v0[3]); w.z = pg8::cvt_pk_bf16(v1[0], v1[1]); w.w = pg8::cvt_pk_bf16(v1[2], v1[3]);
                    if (!dry) __builtin_nontemporal_store(w, (v4u*)(rowp + bj * 128)); } }
        return true;
    }
};

struct SchedLru {
    const char* A; const char* B; int G, c;
    __device__ __forceinline__ bool next(int i, pg8::Unit& u) const { int L = i * G + c; if (L >= 512) return false; if ((G & 7) == 0) L = i * G + (c & 7) * (G >> 3) + (c >> 3); u.pm = L >> 3; u.pn = L & 7; u.aux = 0; return true; }
    __device__ __forceinline__ const char* abase(const pg8::Unit& u) const { return A + (size_t)u.pm * 256 * D * 2 + (size_t)(u.pn >> 1) * 256 * 2; }
    __device__ __forceinline__ const char* bbase(const pg8::Unit& u) const { return B + (size_t)u.pn * 256 * 256 * 2; }
};
struct EpiLru {
    static constexpr bool PERM = true, ROW_RS = false;
    const bf16* XC; bf16* OMA; int ld_oma; bf16* U; const float* ba; const float* bx; const float* lam;
    __device__ __forceinline__ bool operator()(f32x4 (&acc)[2][2][4][2], const pg8::Unit& u, int wr, int wc, int fr, int fq, const LAS float* xrs) const {
        const int row0 = u.pm * 256 + wr * 64 + fr, ch0 = (u.pn >> 1) * 256 + (u.pn & 1) * 128 + wc * 32 + 8 * fq;
#pragma unroll
        for (int n = 0; n < 2; ++n) {
            const int chn = ch0 + 4 * n;
            v2u xcv[8];
#pragma unroll
            for (int i = 0; i < 8; ++i) xcv[i] = *(const v2u*)(XC + (size_t)(row0 + (i >> 2) * 128 + (i & 3) * 16) * D + chn);
            const f32x4 b_a = *(const f32x4*)(ba + chn), b_x = *(const f32x4*)(bx + chn), sp = *(const f32x4*)(lam + chn) * (-8.0f * 1.4426950408889634f);
#pragma unroll
            for (int ai = 0; ai < 2; ++ai)
#pragma unroll
                for (int m = 0; m < 4; ++m) { const int row = row0 + ai * 128 + m * 16; const v2u xv = xcv[ai * 4 + m];
                    const float xc[4] = {blo(xv.x), bhi(xv.x), blo(xv.y), bhi(xv.y)};
                    float oa[4], uu[4];
#pragma unroll
                    for (int j = 0; j < 4; ++j) { const float pa = acc[ai][0][m][n][j] + b_a[j], px = acc[ai][1][m][n][j] + b_x[j];
                        const float r = __builtin_amdgcn_rcpf(1.0f + __builtin_amdgcn_exp2f(-1.4426950408889634f * pa)), ig = __builtin_amdgcn_rcpf(1.0f + __builtin_amdgcn_exp2f(-1.4426950408889634f * px));
                        const float a = __builtin_amdgcn_exp2f(r * sp[j]); const float om = 1.0f - a;
                        oa[j] = om; uu[j] = __builtin_amdgcn_sqrtf(om * (1.0f + a)) * ig * xc[j]; }
                    v2u w1; w1.x = pk2(oa[0], oa[1]); w1.y = pk2(oa[2], oa[3]);
                    v2u w2; w2.x = pk2(uu[0], uu[1]); w2.y = pk2(uu[2], uu[3]);
                    *(v2u*)(OMA + (size_t)row * ld_oma + chn) = w1; *(v2u*)(U + (size_t)row * D + chn) = w2; }
        }
        return true;
    }
};

struct SchedBranch {
    const char* P; const char* B; int G, c;
    __device__ __forceinline__ bool next(int i, pg8::Unit& u) const { int tile = (i / 3) * G + c; if (tile >= 256) return false; if ((G & 7) == 0) tile = (i / 3) * G + (c & 7) * (G >> 3) + (c >> 3);
        u.pm = tile >> 2; u.pn = tile & 3; u.aux = i % 3; return true; }
    __device__ __forceinline__ const char* abase(const pg8::Unit& u) const { const int off = u.aux == 0 ? OFF_GG : (u.aux == 1 ? OFF_LG : OFF_SQ); return P + ((size_t)u.pm * 256 * PN + off) * 2; }
    __device__ __forceinline__ const char* bbase(const pg8::Unit& u) const { return B + (size_t)(u.aux * 1024 + u.pn * 256) * D * 2; }
};
struct EpiBranch {
    static constexpr bool PERM = true, ROW_RS = false, WIDE = false;
    const bf16* PROJ; const float* bg; bf16* O;
    __device__ __forceinline__ bool operator()(f32x4 (&acc)[2][2][4][2], const pg8::Unit& u, int wr, int wc, int fr, int fq, const LAS float* xrs) const {
        const int row0 = u.pm * 256 + wr * 64 + fr, col0 = u.pn * 256 + wc * 32 + 8 * fq, br = u.aux;
#pragma unroll
        for (int bj = 0; bj < 2; ++bj) {
            const int c = col0 + bj * 128;
            float b0[8], b1[8];
#pragma unroll
            for (int j = 0; j < 8; ++j) { b0[j] = bg[br * 1024 + c + j] * -1.4426950408889634f; b1[j] = br < 2 ? bg[(br + 1) * 1024 + c + j] * -1.4426950408889634f : 0.f; }
#pragma unroll
            for (int ai = 0; ai < 2; ++ai) {
                v4u l0[4], l1[4];
#pragma unroll
                for (int m = 0; m < 4; ++m) { const bf16* gp = PROJ + (size_t)(row0 + ai * 128 + m * 16) * PN + OFF_GATE + br * 1024 + c; l0[m] = *(const v4u*)gp; l1[m] = br < 2 ? *(const v4u*)(gp + 1024) : l0[m]; }
#pragma unroll
                for (int m = 0; m < 4; ++m) { const int row = row0 + ai * 128 + m * 16; const v4u a0 = l0[m], a1 = l1[m];
                    const float x0[8] = {blo(a0.x), bhi(a0.x), blo(a0.y), bhi(a0.y), blo(a0.z), bhi(a0.z), blo(a0.w), bhi(a0.w)};
                    const float x1[8] = {blo(a1.x), bhi(a1.x), blo(a1.y), bhi(a1.y), blo(a1.z), bhi(a1.z), blo(a1.w), bhi(a1.w)};
#pragma unroll
                    for (int j = 0; j < 8; ++j) { const float r0 = __builtin_amdgcn_rcpf(1.0f + __builtin_amdgcn_exp2f(x0[j] * -1.4426950408889634f + b0[j]));
                        const float f = br < 2 ? (1.0f + __builtin_amdgcn_exp2f(x1[j] * -1.4426950408889634f + b1[j])) * r0 : r0;
                        acc[ai][bj][m][j >> 2][j & 3] *= f; }
                    if (br == 2) { const f32x4 v0 = acc[ai][bj][m][0], v1 = acc[ai][bj][m][1];
                        v4u w; w.x = pg8::cvt_pk_bf16(v0[0], v0[1]); w.y = pg8::cvt_pk_bf16(v0[2], v0[3]); w.z = pg8::cvt_pk_bf16(v1[0], v1[1]); w.w = pg8::cvt_pk_bf16(v1[2], v1[3]);
                        *(v4u*)(O + (size_t)row * D + c) = w; } }
            }
        }
        return br == 2;
    }
};

namespace gla {
typedef float f32x16 __attribute__((ext_vector_type(16)));
typedef short s16x4 __attribute__((ext_vector_type(4)));
constexpr int BUF = 65536, T_QD = 0, T_KI = 16384, T_V = 32768, X_SSQ = 131072, X_DW = 131072 + 2048;
__device__ __forceinline__ int crow(int r, int hi) { return (r & 3) + 8 * (r >> 2) + 4 * hi; }
__device__ __forceinline__ unsigned cvtpk(float lo, float hi) { unsigned r; asm volatile("v_cvt_pk_bf16_f32 %0, %1, %2" : "=v"(r) : "v"(lo), "v"(hi)); return r; }
__device__ __forceinline__ bf16x8 acc_frag(const f32x16& X, int s) { v4u w = {cvtpk(X[8 * s], X[8 * s + 1]), cvtpk(X[8 * s + 2], X[8 * s + 3]), cvtpk(X[8 * s + 4], X[8 * s + 5]), cvtpk(X[8 * s + 6], X[8 * s + 7])}; return *reinterpret_cast<bf16x8*>(&w); }
__device__ __forceinline__ int offb(int row, int ch) { return 256 * row + 16 * (ch ^ (((row & 3) << 2) | ((row >> 2) & 3))); }
__device__ __forceinline__ bf16x8 rowrd(const LAS unsigned char* tile, int lane, int rb, int s) { return *reinterpret_cast<const LAS bf16x8*>(tile + offb((lane & 31) + 32 * rb, 2 * s + (lane >> 5))); }
__device__ __forceinline__ v2u rd8(const LAS unsigned char* tile, int row, int ch, int half) { return *reinterpret_cast<const LAS v2u*>(tile + offb(row, ch) + 8 * half); }
__device__ __forceinline__ s16x4 trr(unsigned addr) { s16x4 r; asm volatile("ds_read_b64_tr_b16 %0, %1" : "=&v"(r) : "v"(addr) : "memory"); return r; }
__device__ __forceinline__ unsigned tr_addr(unsigned base, int lane, int c, int row0) { const int blk = (lane >> 4) & 1, q = (lane & 15) >> 2, p = lane & 3; return base + offb(row0 + q, 4 * c + 2 * blk + (p >> 1)) + 8 * (p & 1); }
struct TrPair { s16x4 a, b; };
__device__ __forceinline__ TrPair tr_nat(unsigned base, int lane, int c, int ks) { const int h = lane >> 5; TrPair p; p.a = trr(tr_addr(base, lane, c, 16 * ks + 8 * h)); p.b = trr(tr_addr(base, lane, c, 16 * ks + 8 * h + 4)); return p; }
__device__ __forceinline__ TrPair tr_perm(unsigned base, int lane, int c, int ks) { const int h = lane >> 5; TrPair p; p.a = trr(tr_addr(base, lane, c, 16 * ks + 4 * h)); p.b = trr(tr_addr(base, lane, c, 16 * ks + 8 + 4 * h)); return p; }
__device__ __forceinline__ bf16x8 tr_frag(const TrPair& p) { return (bf16x8){p.a[0], p.a[1], p.a[2], p.a[3], p.b[0], p.b[1], p.b[2], p.b[3]}; }
#define LDS_TR_WAIT() do { asm volatile("s_waitcnt lgkmcnt(0)" ::: "memory"); __builtin_amdgcn_sched_barrier(0); } while (0)
__device__ __forceinline__ void dma_tile(LAS unsigned char* img, const bf16* grow0  , int wid, int lane) {
#pragma unroll
    for (int i = 0; i < 2; ++i) { const int L = (wid + 8 * i) * 64 + lane, row = L >> 4, ch = (L & 15) ^ (((row & 3) << 2) | ((row >> 2) & 3));
        __builtin_amdgcn_global_load_lds((const unsigned*)(grow0 + (size_t)row * PN + ch * 8), (LAS unsigned*)(img + (wid + 8 * i) * 1024), 16, 0, 0); }
}
__device__ __forceinline__ void dma_chunk(LAS unsigned char* lds, int buf, const bf16* proj_row0  , int h, bool with_q, int wid, int lane) {
    LAS unsigned char* b = lds + buf * BUF;
    if (with_q) dma_tile(b + T_QD, proj_row0 + OFF_GQ + h * 128, wid, lane);
    dma_tile(b + T_KI, proj_row0 + OFF_GK + h * 128, wid, lane);
    dma_tile(b + T_V, proj_row0 + OFF_GV + h * 256, wid, lane);
    dma_tile(b + T_V + 16384, proj_row0 + OFF_GV + h * 256 + 128, wid, lane);
}
__device__ __forceinline__ void s_update(f32x16 (&S)[4], const LAS unsigned char* b, unsigned bi, const float* dec, int wid, int lane, int hi) {
    const unsigned vimg = bi + T_V + (wid >> 2) * 16384, kimg = bi + T_KI;
#pragma unroll
    for (int ks = 0; ks < 4; ++ks) { const TrPair pv = tr_nat(vimg, lane, wid & 3, ks); TrPair pk[4];
#pragma unroll
        for (int db = 0; db < 4; ++db) pk[db] = tr_nat(kimg, lane, db, ks);
        LDS_TR_WAIT();
        const bf16x8 bv = tr_frag(pv);
#pragma unroll
        for (int db = 0; db < 4; ++db) S[db] = __builtin_amdgcn_mfma_f32_32x32x16_bf16(tr_frag(pk[db]), bv, S[db], 0, 0, 0); }
#pragma unroll
    for (int db = 0; db < 4; ++db)
#pragma unroll
        for (int g = 0; g < 4; ++g) { const f32x4 d = *reinterpret_cast<const f32x4*>(dec + 32 * db + 8 * g + 4 * hi);
#pragma unroll
            for (int i = 0; i < 4; ++i) S[db][4 * g + i] *= d[i]; }
}
__device__ __forceinline__ void pass1_item(Frame& F, int it) {
    const int tid = opaque_tid(), wid = __builtin_amdgcn_readfirstlane(tid >> 6), lane = tid & 63, hi = lane >> 5;
    const int b = it >> 5, h = (it >> 3) & 3, g = it & 7;
    const float* decb = F.DECAY + (size_t)(b * 32) * 512 + h * 128;
    const unsigned lbase = (unsigned)(uintptr_t)F.ldsg;
    f32x16 S[4];
#pragma unroll
    for (int db = 0; db < 4; ++db) S[db] = f32x16{};
    __syncthreads();
    dma_chunk(F.lds, 0, F.PROJ + (size_t)(b * T + (4 * g) * 64) * PN, h, false, wid, lane);
    asm volatile("s_waitcnt vmcnt(0)" ::: "memory"); __syncthreads();
#pragma nounroll
    for (int n = 0; n < 4; ++n) { const int ch = 4 * g + n;
        if (n < 3) dma_chunk(F.lds, (n + 1) & 1, F.PROJ + (size_t)(b * T + (ch + 1) * 64) * PN, h, false, wid, lane);
        int ln = lane; asm volatile("" : "+v"(ln));
        s_update(S, F.lds + (n & 1) * BUF, lbase + (n & 1) * BUF, decb + (size_t)ch * 512, wid, ln, ln >> 5);
        asm volatile("s_waitcnt vmcnt(0)" ::: "memory"); __syncthreads();
    }
    float* sl = (float*)(F.ws + WS_VT) + (size_t)it * 32768 + wid * 4096;
#pragma unroll
    for (int db = 0; db < 4; ++db)
#pragma unroll
        for (int g4 = 0; g4 < 4; ++g4) *reinterpret_cast<f32x4*>(sl + ((db * 4 + g4) * 64 + lane) * 4) = (f32x4){S[db][4 * g4], S[db][4 * g4 + 1], S[db][4 * g4 + 2], S[db][4 * g4 + 3]};
}
__device__ __forceinline__ void prefix_item(Frame& F, int it) {
    const int tid = opaque_tid(), b = it >> 5, h = (it >> 3) & 3, e = it & 7;
    const float* sl = (const float*)(F.ws + WS_VT) + (size_t)(it - e) * 32768 + e * 4096;
    float* cin = (float*)(F.ws + WS_XC) + (size_t)(it - e) * 32768 + e * 4096;
    const float* decb = F.DECAY + (size_t)(b * 32) * 512 + h * 128;
#pragma unroll
    for (int j = 0; j < 2; ++j) { const int q = tid + 512 * j, dk = 32 * (q >> 8) + 8 * ((q >> 6) & 3) + 4 * ((q & 63) >> 5);
        f32x4 sv[8], dv[8];
#pragma unroll
        for (int g = 0; g < 8; ++g) { sv[g] = *(const f32x4*)(sl + (size_t)g * 32768 + 4 * q);
            const float* dp = decb + (size_t)(4 * g) * 512 + dk; dv[g] = (*(const f32x4*)dp * *(const f32x4*)(dp + 512)) * (*(const f32x4*)(dp + 1024) * *(const f32x4*)(dp + 1536)); }
        f32x4 C = {0.f, 0.f, 0.f, 0.f};
#pragma unroll
        for (int g = 0; g < 8; ++g) { *(f32x4*)(cin + (size_t)g * 32768 + 4 * q) = C; C = dv[g] * C + sv[g]; }
    }
}
__device__ __forceinline__ void pass2_item(Frame& F, const float* norm_g, int it) {
    const int tid = opaque_tid(), wid = __builtin_amdgcn_readfirstlane(tid >> 6), lane = tid & 63, r32 = lane & 31, hi = lane >> 5;
    const int b = it >> 5, h = (it >> 3) & 3, g = it & 7;
    const float* decb = F.DECAY + (size_t)(b * 32) * 512 + h * 128;
    const unsigned lbase = (unsigned)(uintptr_t)F.ldsg;
    LAS float* ssqx = (LAS float*)(F.lds + X_SSQ);
    __syncthreads();
    dma_chunk(F.lds, 0, F.PROJ + (size_t)(b * T + (4 * g) * 64) * PN, h, true, wid, lane);
    f32x16 S[4];
    { const float* ci = (const float*)(F.ws + WS_XC) + (size_t)it * 32768 + wid * 4096;
#pragma unroll
      for (int db = 0; db < 4; ++db)
#pragma unroll
          for (int g4 = 0; g4 < 4; ++g4) { const f32x4 sv = *reinterpret_cast<const f32x4*>(ci + ((db * 4 + g4) * 64 + lane) * 4);
#pragma unroll
              for (int i = 0; i < 4; ++i) S[db][4 * g4 + i] = sv[i]; } }
    float ng[16];
#pragma unroll
    for (int r = 0; r < 16; ++r) ng[r] = norm_g[32 * wid + crow(r, hi)];
    asm volatile("s_waitcnt vmcnt(0)" ::: "memory"); __syncthreads();
#pragma nounroll
    for (int n = 0; n < 4; ++n) { const int ch = 4 * g + n; const size_t m0 = (size_t)(b * T + ch * 64);
        if (n < 3) dma_chunk(F.lds, (n + 1) & 1, F.PROJ + (m0 + 64) * PN, h, true, wid, lane);
        int ln = lane; asm volatile("" : "+v"(ln));
        const int lane = ln, r32 = ln & 31, hi = ln >> 5;
        const LAS unsigned char* bq = F.lds + (n & 1) * BUF + T_QD; const LAS unsigned char* bk = F.lds + (n & 1) * BUF + T_KI;
        const unsigned bi = lbase + (n & 1) * BUF, vimg = bi + T_V + (wid >> 2) * 16384;
        f32x16 a00 = f32x16{}, a01 = f32x16{}, a11 = f32x16{};
#pragma unroll
        for (int d0 = 0; d0 < 8; ++d0) { const bf16x8 k0 = rowrd(bk, lane, 0, d0), k1 = rowrd(bk, lane, 1, d0), q0 = rowrd(bq, lane, 0, d0), q1 = rowrd(bq, lane, 1, d0);
            a00 = __builtin_amdgcn_mfma_f32_32x32x16_bf16(k0, q0, a00, 0, 0, 0);
            a01 = __builtin_amdgcn_mfma_f32_32x32x16_bf16(k0, q1, a01, 0, 0, 0);
            a11 = __builtin_amdgcn_mfma_f32_32x32x16_bf16(k1, q1, a11, 0, 0, 0); }
#pragma unroll
        for (int r = 0; r < 16; ++r) { const bool vis = crow(r, hi) <= r32; a00[r] = vis ? a00[r] : 0.f; a11[r] = vis ? a11[r] : 0.f; }
        f32x16 o0 = f32x16{}, o1 = f32x16{};
        { TrPair pva[2], pvb[2];
#pragma unroll
          for (int ks = 0; ks < 2; ++ks) { pva[ks] = tr_perm(vimg, lane, wid & 3, ks); pvb[ks] = tr_perm(vimg, lane, wid & 3, 2 + ks); }
          LDS_TR_WAIT();
#pragma unroll
          for (int ks = 0; ks < 2; ++ks) { const bf16x8 va = tr_frag(pva[ks]), vb = tr_frag(pvb[ks]);
            o0 = __builtin_amdgcn_mfma_f32_32x32x16_bf16(va, acc_frag(a00, ks), o0, 0, 0, 0);
            o1 = __builtin_amdgcn_mfma_f32_32x32x16_bf16(va, acc_frag(a01, ks), o1, 0, 0, 0);
            o1 = __builtin_amdgcn_mfma_f32_32x32x16_bf16(vb, acc_frag(a11, ks), o1, 0, 0, 0); } }
#pragma unroll
        for (int db = 0; db < 4; ++db)
#pragma unroll
            for (int ks = 0; ks < 2; ++ks) { const bf16x8 sa = acc_frag(S[db], ks);
                const v2u x0 = rd8(bq, r32, 4 * db + 2 * ks, hi), x1 = rd8(bq, r32, 4 * db + 2 * ks + 1, hi), y0 = rd8(bq, 32 + r32, 4 * db + 2 * ks, hi), y1 = rd8(bq, 32 + r32, 4 * db + 2 * ks + 1, hi);
                v4u wx = {x0.x, x0.y, x1.x, x1.y}, wy = {y0.x, y0.y, y1.x, y1.y};
                o0 = __builtin_amdgcn_mfma_f32_32x32x16_bf16(sa, *reinterpret_cast<bf16x8*>(&wx), o0, 0, 0, 0);
                o1 = __builtin_amdgcn_mfma_f32_32x32x16_bf16(sa, *reinterpret_cast<bf16x8*>(&wy), o1, 0, 0, 0); }
        float s0 = 0.f, s1 = 0.f;
#pragma unroll
        for (int r = 0; r < 16; ++r) { s0 += o0[r] * o0[r]; s1 += o1[r] * o1[r]; }
        { auto rr = __builtin_amdgcn_permlane32_swap(__float_as_uint(s0), __float_as_uint(s0), false, false); s0 = __uint_as_float(rr[0]) + __uint_as_float(rr[1]); }
        { auto rr = __builtin_amdgcn_permlane32_swap(__float_as_uint(s1), __float_as_uint(s1), false, false); s1 = __uint_as_float(rr[0]) + __uint_as_float(rr[1]); }
        if (hi == 0) { ssqx[wid * 64 + r32] = s0; ssqx[wid * 64 + 32 + r32] = s1; }
        const bf16* gp = F.PROJ + (m0 + r32) * PN + OFF_GG + h * 256 + 32 * wid + 4 * hi;
        v2u gg0[4], gg1[4];
#pragma unroll
        for (int g4 = 0; g4 < 4; ++g4) { gg0[g4] = *reinterpret_cast<const v2u*>(gp + 8 * g4); gg1[g4] = *reinterpret_cast<const v2u*>(gp + (size_t)32 * PN + 8 * g4); }
        __syncthreads();
        float t0s = 0.f, t1s = 0.f;
#pragma unroll
        for (int w2 = 0; w2 < 8; ++w2) { t0s += ssqx[w2 * 64 + r32]; t1s += ssqx[w2 * 64 + 32 + r32]; }
        const float rs0 = 1.0f / sqrtf(t0s * (1.f / 256.f) + EPS), rs1 = 1.0f / sqrtf(t1s * (1.f / 256.f) + EPS);
#pragma unroll
        for (int g4 = 0; g4 < 4; ++g4) {
            const float ga[4] = {blo(gg0[g4].x), bhi(gg0[g4].x), blo(gg0[g4].y), bhi(gg0[g4].y)}, gb[4] = {blo(gg1[g4].x), bhi(gg1[g4].x), blo(gg1[g4].y), bhi(gg1[g4].y)};
            float ya[4], yb[4];
#pragma unroll
            for (int i = 0; i < 4; ++i) { ya[i] = o0[4 * g4 + i] * rs0 * ng[4 * g4 + i] * (ga[i] * __builtin_amdgcn_rcpf(1.0f + __builtin_amdgcn_exp2f(-1.4426950408889634f * ga[i])));
                                          yb[i] = o1[4 * g4 + i] * rs1 * ng[4 * g4 + i] * (gb[i] * __builtin_amdgcn_rcpf(1.0f + __builtin_amdgcn_exp2f(-1.4426950408889634f * gb[i]))); }
            v2u w0 = {cvtpk(ya[0], ya[1]), cvtpk(ya[2], ya[3])}, w1 = {cvtpk(yb[0], yb[1]), cvtpk(yb[2], yb[3])};
            if (!F.dry) { *reinterpret_cast<v2u*>(const_cast<bf16*>(gp) + 8 * g4) = w0; *reinterpret_cast<v2u*>(const_cast<bf16*>(gp) + (size_t)32 * PN + 8 * g4) = w1; }
        }
        if (n < 3) s_update(S, F.lds + (n & 1) * BUF, bi, decb + (size_t)ch * 512, wid, lane, hi);
        asm volatile("s_waitcnt vmcnt(0)" ::: "memory"); __syncthreads();
    }
}
}
__device__ __forceinline__ void phase_gla_fix(Frame& F, const Args& A, int l) {
    F.tid = opaque_tid(); F.lane = F.tid & 63;
    const int gt = F.bid * 512 + F.tid, NGT = F.G * 512;
    const float* ng = as_global(A.in[5]) + (size_t)l * 256;
    for (int idx = gt; idx < M * 128; idx += NGT) {
        const int m = idx >> 7, c0 = (idx & 127) * 8, h = c0 >> 8;
        const float* sp = F.SSQ + (size_t)m * 32 + h * 8;
        const float ss = ((sp[0] + sp[1]) + (sp[2] + sp[3])) + ((sp[4] + sp[5]) + (sp[6] + sp[7]));
        const float rs = 1.0f / sqrtf(ss * (1.f / 256.f) + EPS);
        const v4u ov = *(const v4u*)(F.PROJ + (size_t)m * PN + OFF_GV + c0);
        bf16* gp = F.PROJ + (size_t)m * PN + OFF_GG + c0;
        const v4u gv = *(const v4u*)gp;
        const float o[8] = {blo(ov.x), bhi(ov.x), blo(ov.y), bhi(ov.y), blo(ov.z), bhi(ov.z), blo(ov.w), bhi(ov.w)};
        const float g[8] = {blo(gv.x), bhi(gv.x), blo(gv.y), bhi(gv.y), blo(gv.z), bhi(gv.z), blo(gv.w), bhi(gv.w)};
        float r[8];
#pragma unroll
        for (int j = 0; j < 8; ++j) r[j] = o[j] * rs * ng[(c0 & 255) + j] * (g[j] * sigmoidf_(g[j]));
        v4u w; w.x = pk2(r[0], r[1]); w.y = pk2(r[2], r[3]); w.z = pk2(r[4], r[5]); w.w = pk2(r[6], r[7]);
        if (!F.dry) *(v4u*)gp = w;
    }
}

__device__ __forceinline__ float gelu_tanh(float x) { const float y = 0.7978845608028654f * (x + 0.044715f * x * x * x); const float e = __expf(2.0f * y); const float th = 1.0f - 2.0f / (e + 1.0f); return 0.5f * x * (1.0f + th); }
constexpr size_t WS_LSUM = WS_KE;
constexpr size_t WS_WSUM = WS_KE + 4 * MiB;
__device__ __forceinline__ void lru_scan_a(Frame& F, int it) {
    const int tid = opaque_tid(), wid = __builtin_amdgcn_readfirstlane(tid >> 6), lane = tid & 63;
    const int b = it >> 5, cg = (it >> 3) & 3, tb = it & 7, ch = cg * 256 + lane * 4, m0 = b * T + tb * 256 + wid * 32, quad = cg * 64 + lane;
    LAS float* xs = (LAS float*)F.lds;
    f32x4 h = {0.f, 0.f, 0.f, 0.f}, P = {1.f, 1.f, 1.f, 1.f};
#pragma unroll
    for (int i16 = 0; i16 < 32; i16 += 16) {
        v2u om[16], uu[16];
#pragma unroll
        for (int i = 0; i < 16; ++i) { om[i] = *(const v2u*)(F.PROJ + (size_t)(m0 + i16 + i) * PN + OFF_LX + ch); uu[i] = *(const v2u*)(F.U + (size_t)(m0 + i16 + i) * D + ch); }
#pragma unroll
        for (int i = 0; i < 16; ++i) { const f32x4 a = {1.f - blo(om[i].x), 1.f - bhi(om[i].x), 1.f - blo(om[i].y), 1.f - bhi(om[i].y)}, u = {blo(uu[i].x), bhi(uu[i].x), blo(uu[i].y), bhi(uu[i].y)};
            h = a * h + u; P = P * a; }
    }
    float* ls = (float*)(F.ws + WS_LSUM) + ((size_t)(b * 64 + tb * 8 + wid) * 256 + quad) * 8;
    *(f32x4*)ls = P; *(f32x4*)(ls + 4) = h;
    __syncthreads();
    *(LAS f32x4*)(xs + (wid * 64 + lane) * 8) = P; *(LAS f32x4*)(xs + (wid * 64 + lane) * 8 + 4) = h;
    __syncthreads();
    if (wid == 0) { f32x4 Pt = {1.f, 1.f, 1.f, 1.f}, Ht = {0.f, 0.f, 0.f, 0.f};
#pragma unroll
        for (int w2 = 0; w2 < 8; ++w2) { const f32x4 p = *(const LAS f32x4*)(xs + (w2 * 64 + lane) * 8), hh = *(const LAS f32x4*)(xs + (w2 * 64 + lane) * 8 + 4); Ht = p * Ht + hh; Pt = Pt * p; }
        float* wsm = (float*)(F.ws + WS_WSUM) + ((size_t)(b * 8 + tb) * 256 + quad) * 8;
        *(f32x4*)wsm = Pt; *(f32x4*)(wsm + 4) = Ht; }
}
__device__ __forceinline__ void lru_scan_b(Frame& F, int it) {
    const int tid = opaque_tid(), wid = __builtin_amdgcn_readfirstlane(tid >> 6), lane = tid & 63;
    const int b = it >> 5, cg = (it >> 3) & 3, tb = it & 7, ch = cg * 256 + lane * 4, m0 = b * T + tb * 256 + wid * 32, quad = cg * 64 + lane;
    f32x4 h = {0.f, 0.f, 0.f, 0.f};
    { const float* wsm = (const float*)(F.ws + WS_WSUM) + ((size_t)(b * 8) * 256 + quad) * 8;
      f32x4 pp[7], hh[7];
#pragma unroll
      for (int j = 0; j < 7; ++j) { pp[j] = *(const f32x4*)(wsm + (size_t)j * 2048); hh[j] = *(const f32x4*)(wsm + (size_t)j * 2048 + 4); }
#pragma unroll
      for (int j = 0; j < 7; ++j) if (j < tb) h = pp[j] * h + hh[j]; }
    { const float* ls = (const float*)(F.ws + WS_LSUM) + ((size_t)(b * 64 + tb * 8) * 256 + quad) * 8;
      f32x4 pp[7], hh[7];
#pragma unroll
      for (int j = 0; j < 7; ++j) { pp[j] = *(const f32x4*)(ls + (size_t)j * 2048); hh[j] = *(const f32x4*)(ls + (size_t)j * 2048 + 4); }
#pragma unroll
      for (int j = 0; j < 7; ++j) if (j < wid) h = pp[j] * h + hh[j]; }
#pragma nounroll
    for (int i8 = 0; i8 < 32; i8 += 8) {
        v2u om[8], uu[8], gv[8];
#pragma unroll
        for (int i = 0; i < 8; ++i) { om[i] = *(const v2u*)(F.PROJ + (size_t)(m0 + i8 + i) * PN + OFF_LX + ch); uu[i] = *(const v2u*)(F.U + (size_t)(m0 + i8 + i) * D + ch);
            gv[i] = *(const v2u*)(F.PROJ + (size_t)(m0 + i8 + i) * PN + OFF_LG + ch); }
#pragma unroll
        for (int i = 0; i < 8; ++i) {
            const f32x4 a = {1.f - blo(om[i].x), 1.f - bhi(om[i].x), 1.f - blo(om[i].y), 1.f - bhi(om[i].y)}, u = {blo(uu[i].x), bhi(uu[i].x), blo(uu[i].y), bhi(uu[i].y)};
            const float g[4] = {blo(gv[i].x), bhi(gv[i].x), blo(gv[i].y), bhi(gv[i].y)};
            h = a * h + u;
            v2u w; w.x = pk2(h.x * gelu_tanh(g[0]), h.y * gelu_tanh(g[1])); w.y = pk2(h.z * gelu_tanh(g[2]), h.w * gelu_tanh(g[3]));
            if (!F.dry) *(v2u*)(F.PROJ + (size_t)(m0 + i8 + i) * PN + OFF_LG + ch) = w;
        }
    }
}

namespace sba {
typedef float f32x16 __attribute__((ext_vector_type(16)));
typedef short s16x4 __attribute__((ext_vector_type(4)));
constexpr int SHM_V = 64 * 128 * 2, SHM_K = 64 * 128 * 2;
#define SBA_KSWZ(row, colB) ((row) * 256 + ((colB) ^ (((row) & 7) << 4)))
#define SBA_SBAR() __builtin_amdgcn_sched_barrier(0)
__device__ __forceinline__ int crow(int r, int hi) { return (r & 3) + 8 * (r >> 2) + 4 * hi; }
__device__ __forceinline__ unsigned cvtpk(float lo, float hi) { unsigned r; asm volatile("v_cvt_pk_bf16_f32 %0, %1, %2" : "=v"(r) : "v"(lo), "v"(hi)); return r; }
__device__ __forceinline__ void qkt(f32x16& p0, f32x16& p1, const char* Ks, const bf16x8* qr, int r32, int hi) {
    p0 = f32x16{}; p1 = f32x16{};
#pragma unroll
    for (int d0 = 0; d0 < 8; ++d0) { const int cb = (d0 * 16 + hi * 8) * 2;
        const bf16x8 b0 = *reinterpret_cast<const bf16x8*>(Ks + SBA_KSWZ(r32, cb));
        const bf16x8 b1 = *reinterpret_cast<const bf16x8*>(Ks + SBA_KSWZ(32 + r32, cb));
        p0 = __builtin_amdgcn_mfma_f32_32x32x16_bf16(b0, qr[d0], p0, 0, 0, 0);
        p1 = __builtin_amdgcn_mfma_f32_32x32x16_bf16(b1, qr[d0], p1, 0, 0, 0); }
}
__device__ __forceinline__ void sig_part(f32x16& p0, f32x16& p1, bool partial, int krel, int hi) {
#pragma unroll
    for (int r = 0; r < 16; ++r) { p0[r] = __builtin_amdgcn_rcpf(1.0f + __builtin_amdgcn_exp2f(p0[r])); p1[r] = __builtin_amdgcn_rcpf(1.0f + __builtin_amdgcn_exp2f(p1[r])); }
    if (partial) {
#pragma unroll
        for (int r = 0; r < 16; ++r) { const int kk = krel + crow(r, hi); p0[r] = (kk < 0) ? p0[r] : 1.0f; p1[r] = (kk + 32 < 0) ? p1[r] : 1.0f; }
    }
}
__device__ __forceinline__ void finish(f32x16& p0, f32x16& p1, float& R, int hi, bf16x8& pa0, bf16x8& pa1, bf16x8& pa2, bf16x8& pa3) {
    float lo[8], hv[8];
#pragma unroll
    for (int g = 0; g < 4; ++g) {
        const float ga = (p0[4 * g] * p0[4 * g + 1]) * (p0[4 * g + 2] * p0[4 * g + 3]), gb = (p1[4 * g] * p1[4 * g + 1]) * (p1[4 * g + 2] * p1[4 * g + 3]);
        { auto rr = __builtin_amdgcn_permlane32_swap(__float_as_uint(ga), __float_as_uint(ga), false, false); lo[g] = __uint_as_float(rr[0]); hv[g] = __uint_as_float(rr[1]); }
        { auto rr = __builtin_amdgcn_permlane32_swap(__float_as_uint(gb), __float_as_uint(gb), false, false); lo[4 + g] = __uint_as_float(rr[0]); hv[4 + g] = __uint_as_float(rr[1]); }
    }
    float ps = R;
#pragma unroll
    for (int g = 7; g >= 0; --g) {
        float run = ps * (hi == 0 ? hv[g] : 1.0f);
#pragma unroll
        for (int i = 3; i >= 0; --i) {
            if (g >= 4) { const float k = p1[4 * (g - 4) + i]; p1[4 * (g - 4) + i] = (1.0f - k) * run; run *= k; }
            else        { const float k = p0[4 * g + i];       p0[4 * g + i]       = (1.0f - k) * run; run *= k; }
        }
        ps = ps * (lo[g] * hv[g]);
    }
    R = ps;
#define SBA_PK4(P, BASE, OUT) do { unsigned a0 = cvtpk(P[BASE + 0], P[BASE + 1]), a1 = cvtpk(P[BASE + 2], P[BASE + 3]);   \
    unsigned b0 = cvtpk(P[BASE + 4], P[BASE + 5]), b1 = cvtpk(P[BASE + 6], P[BASE + 7]);                              \
    auto r0 = __builtin_amdgcn_permlane32_swap(a0, b0, false, false); auto r1 = __builtin_amdgcn_permlane32_swap(a1, b1, false, false); \
    v4u w = {r0[0], r1[0], r0[1], r1[1]}; OUT = *reinterpret_cast<bf16x8*>(&w); } while (0)
    SBA_PK4(p0, 0, pa0); SBA_PK4(p0, 8, pa1); SBA_PK4(p1, 0, pa2); SBA_PK4(p1, 8, pa3);
#undef SBA_PK4
}
__device__ __forceinline__ int v_st(int k, int c) { const int kk = (k & ~0xC) | ((k & 4) << 1) | ((k & 8) >> 1); return ((kk >> 3) * 4 + (c >> 5)) * 512 + ((kk & 7) * 32 + (c & 31)) * 2; }
__device__ __forceinline__ int v_rd_base(int lane) { return ((lane & 3) << 3) | (((lane >> 2) & 3) << 6) | (((lane >> 4) & 1) << 5) | (((lane >> 5) & 1) << 8); }
constexpr int v_rd_off(int d0, int ks, int half) { return d0 * 512 + ks * 4096 + half * 2048; }
template <int OFF> __device__ __forceinline__ s16x4 tr_read(int vb) { s16x4 r; asm volatile("ds_read_b64_tr_b16 %0, %1 offset:%2" : "=&v"(r) : "v"(vb), "i"(OFF) : "memory"); return r; }
template <int D0> __device__ __forceinline__ void pv_one(f32x16& od, int vb, bf16x8 pa0, bf16x8 pa1, bf16x8 pa2, bf16x8 pa3) {
    const s16x4 l0 = tr_read<v_rd_off(D0, 0, 0)>(vb), h0 = tr_read<v_rd_off(D0, 0, 1)>(vb), l1 = tr_read<v_rd_off(D0, 1, 0)>(vb), h1 = tr_read<v_rd_off(D0, 1, 1)>(vb);
    const s16x4 l2 = tr_read<v_rd_off(D0, 2, 0)>(vb), h2 = tr_read<v_rd_off(D0, 2, 1)>(vb), l3 = tr_read<v_rd_off(D0, 3, 0)>(vb), h3 = tr_read<v_rd_off(D0, 3, 1)>(vb);
    asm volatile("s_waitcnt lgkmcnt(0)" ::: "memory"); SBA_SBAR();
#define SBA_PK(L, H) (bf16x8){L[0], L[1], L[2], L[3], H[0], H[1], H[2], H[3]}
    od = __builtin_amdgcn_mfma_f32_32x32x16_bf16(pa0, SBA_PK(l0, h0), od, 0, 0, 0);
    od = __builtin_amdgcn_mfma_f32_32x32x16_bf16(pa1, SBA_PK(l1, h1), od, 0, 0, 0);
    od = __builtin_amdgcn_mfma_f32_32x32x16_bf16(pa2, SBA_PK(l2, h2), od, 0, 0, 0);
    od = __builtin_amdgcn_mfma_f32_32x32x16_bf16(pa3, SBA_PK(l3, h3), od, 0, 0, 0);
#undef SBA_PK
}
__device__ __forceinline__ void pv_d0(f32x16* o, int vb, bf16x8 pa0, bf16x8 pa1, bf16x8 pa2, bf16x8 pa3) {
    pv_one<0>(o[0], vb, pa0, pa1, pa2, pa3); pv_one<1>(o[1], vb, pa0, pa1, pa2, pa3); pv_one<2>(o[2], vb, pa0, pa1, pa2, pa3); pv_one<3>(o[3], vb, pa0, pa1, pa2, pa3);
}
__device__ __forceinline__ void unit(const bf16* Qb, const bf16* __restrict__ Kh, const bf16* __restrict__ Vh, bf16* Ob, int qb, char* lds, int tid, bool dry, const float* qg, const float* kg) {
    const int wid = __builtin_amdgcn_readfirstlane(tid >> 6), lane = tid & 63, r32 = lane & 31, hi = lane >> 5;
    char* V_lds = lds; char* K_lds = lds + 2 * SHM_V;
    f32x16 o[4] = {}; bf16x8 qr[8]; float R = 1.0f;
    const bf16* Qw = Qb + (size_t)(wid * 32 + r32) * PN + hi * 8;
#pragma unroll
    for (int d0 = 0; d0 < 8; ++d0) qr[d0] = *reinterpret_cast<const bf16x8*>(Qw + d0 * 16);
    { float ss = 0.f;
#pragma unroll
      for (int d0 = 0; d0 < 8; ++d0) { const v4u w = *reinterpret_cast<const v4u*>(&qr[d0]); const float e[8] = {blo(w.x), bhi(w.x), blo(w.y), bhi(w.y), blo(w.z), bhi(w.z), blo(w.w), bhi(w.w)};
#pragma unroll
          for (int j = 0; j < 8; ++j) ss += e[j] * e[j]; }
      { auto rr = __builtin_amdgcn_permlane32_swap(__float_as_uint(ss), __float_as_uint(ss), false, false); ss = __uint_as_float(rr[0]) + __uint_as_float(rr[1]); }
      const float rs = __builtin_amdgcn_rsqf(ss * (1.f / 128.f) + EPS) * (0.08838834764831845f * 1.4426950408889634f);
#pragma unroll
      for (int d0 = 0; d0 < 8; ++d0) { const v4u w = *reinterpret_cast<const v4u*>(&qr[d0]); const float e[8] = {blo(w.x), bhi(w.x), blo(w.y), bhi(w.y), blo(w.z), bhi(w.z), blo(w.w), bhi(w.w)};
          const f32x4 g0 = *reinterpret_cast<const f32x4*>(qg + 16 * d0 + 8 * hi), g1 = *reinterpret_cast<const f32x4*>(qg + 16 * d0 + 8 * hi + 4);
          v4u o; o.x = cvtpk(e[0] * rs * g0.x, e[1] * rs * g0.y); o.y = cvtpk(e[2] * rs * g0.z, e[3] * rs * g0.w); o.z = cvtpk(e[4] * rs * g1.x, e[5] * rs * g1.y); o.w = cvtpk(e[6] * rs * g1.z, e[7] * rs * g1.w);
          qr[d0] = *reinterpret_cast<bf16x8*>(&o); } }
    const f32x4 kg0 = *reinterpret_cast<const f32x4*>(kg + (tid & 15) * 8), kg1 = *reinterpret_cast<const f32x4*>(kg + (tid & 15) * 8 + 4);
#define SBA_KNORM(X) do { const v4u w_ = *reinterpret_cast<const v4u*>(&(X)); const float e_[8] = {blo(w_.x), bhi(w_.x), blo(w_.y), bhi(w_.y), blo(w_.z), bhi(w_.z), blo(w_.w), bhi(w_.w)}; \
        float s_ = 0.f; _Pragma("unroll") for (int j_ = 0; j_ < 8; ++j_) s_ += e_[j_] * e_[j_]; \
        s_ += shx(s_, 1, lane); s_ += shx(s_, 2, lane); s_ += shx(s_, 4, lane); s_ += shx(s_, 8, lane); \
        const float r_ = __builtin_amdgcn_rsqf(s_ * (1.f / 128.f) + EPS); \
        v4u o_; o_.x = cvtpk(e_[0] * r_ * kg0.x, e_[1] * r_ * kg0.y); o_.y = cvtpk(e_[2] * r_ * kg0.z, e_[3] * r_ * kg0.w); o_.z = cvtpk(e_[4] * r_ * kg1.x, e_[5] * r_ * kg1.y); o_.w = cvtpk(e_[6] * r_ * kg1.z, e_[7] * r_ * kg1.w); \
        (X) = *reinterpret_cast<bf16x8*>(&o_); } while (0)
    const int sr = tid >> 4, sc = (tid & 15) * 8, vst0 = v_st(sr, sc), vst1 = v_st(32 + sr, sc);
    const int vb0 = (int)(uintptr_t)V_lds + v_rd_base(lane);
    bf16x8 vsA0, vsA1, ksA0, ksA1, vsB0, vsB1, ksB0, ksB1;
#define SBA_SLOAD(S, k0) do { vs##S##0 = *reinterpret_cast<const bf16x8*>(&Vh[(size_t)((k0) + sr) * PN + sc]); vs##S##1 = *reinterpret_cast<const bf16x8*>(&Vh[(size_t)((k0) + 32 + sr) * PN + sc]); \
    ks##S##0 = *reinterpret_cast<const bf16x8*>(&Kh[(size_t)((k0) + sr) * PN + sc]); ks##S##1 = *reinterpret_cast<const bf16x8*>(&Kh[(size_t)((k0) + 32 + sr) * PN + sc]); } while (0)
#define SBA_SWRITE(S, bo) do { SBA_KNORM(ks##S##0); SBA_KNORM(ks##S##1); *(bf16x8*)(V_lds + (bo) + vst0) = vs##S##0; *(bf16x8*)(V_lds + (bo) + vst1) = vs##S##1; const int kc = sc * 2; \
    *(bf16x8*)(K_lds + (bo) + SBA_KSWZ(sr, kc)) = ks##S##0; *(bf16x8*)(K_lds + (bo) + SBA_KSWZ(32 + sr, kc)) = ks##S##1; } while (0)
#define SBA_WAIT(more) do { if (more) asm volatile("s_waitcnt vmcnt(4)" ::: "memory"); else asm volatile("s_waitcnt vmcnt(0)" ::: "memory"); } while (0)
    const int NT = 4 * (qb + 1);
    const int qrel = wid * 32 + r32;
#define SBA_TILE(i) ((NT - 1 - (i)) * 64)
#define SBA_STEP(i, bo) do { const bool alive_ = __any(R != 0.0f); \
        if (alive_ && (((i) >= 4) || (64 * (3 - (i)) < 32 * wid + 31))) { f32x16 p0, p1; bf16x8 pa0, pa1, pa2, pa3; \
            qkt(p0, p1, K_lds + (bo), qr, r32, hi); \
            sig_part(p0, p1, ((i) < 4) && (64 * (3 - (i)) + 63 >= 32 * wid), 64 * (3 - (i)) - qrel, hi); \
            finish(p0, p1, R, hi, pa0, pa1, pa2, pa3); SBA_SBAR(); \
            pv_d0(o, vb0 + (bo), pa0, pa1, pa2, pa3); } SBA_SBAR(); } while (0)
    SBA_SLOAD(A, SBA_TILE(0)); SBA_WAIT(false); SBA_SWRITE(A, 0); __syncthreads();
    SBA_SLOAD(B, SBA_TILE(1)); SBA_SLOAD(A, SBA_TILE(2));
    for (int i = 0; i < NT; i += 2) {
        SBA_STEP(i, 0);
        SBA_WAIT(i + 2 < NT); SBA_SWRITE(B, SHM_V);
        if (i + 3 < NT) SBA_SLOAD(B, SBA_TILE(i + 3));
        if (!__syncthreads_or((int)(i < 3 || __any(R != 0.0f)))) break;
        SBA_STEP(i + 1, SHM_V);
        if (i + 2 < NT) { SBA_WAIT(i + 3 < NT); SBA_SWRITE(A, 0); }
        if (i + 4 < NT) SBA_SLOAD(A, SBA_TILE(i + 4));
        if (!__syncthreads_or((int)(i + 1 < 3 || __any(R != 0.0f)))) break;
    }
    asm volatile("s_waitcnt vmcnt(0)" ::: "memory");
#undef SBA_STEP
#undef SBA_TILE
#undef SBA_WAIT
#undef SBA_KNORM
    bf16* Ow = Ob + (size_t)(wid * 32) * PN;
#pragma unroll
    for (int r = 0; r < 16; ++r) { const int orow = crow(r, hi);
#pragma unroll
        for (int d0 = 0; d0 < 4; ++d0) if (!dry) Ow[(size_t)orow * PN + d0 * 32 + r32] = (bf16)f2bf(o[d0][r]); }
    __syncthreads();
#undef SBA_SLOAD
#undef SBA_SWRITE
}
}
__device__ __forceinline__ void sb_attn_pair(Frame& F, const float* qg, const float* kg, int item) {
    const int tid = opaque_tid();
    const int bh = item >> 2, p = item & 3, b = bh >> 3, h = bh & 7;
    const bf16* Kh = F.PROJ + (size_t)(b * T) * PN + OFF_SK + h * 128; const bf16* Vh = F.PROJ + (size_t)(b * T) * PN + OFF_SV + h * 128;
    bf16* Qh = F.PROJ + (size_t)(b * T) * PN + OFF_SQ + h * 128;
#pragma nounroll
    for (int u = 0; u < 2; ++u) { const int qb = u ? p : 7 - p; sba::unit(Qh + (size_t)(qb * 256) * PN, Kh, Vh, Qh + (size_t)(qb * 256) * PN, qb, (char*)F.ldsg, tid, F.dry, qg, kg); }
}

__device__ __forceinline__ Frame make_frame(const Args& args, LAS unsigned char* lds, unsigned char* ldsg) {
    Frame F; unsigned char* ws = args.ws; float* out = args.out;
    { size_t z = 0; asm volatile("" : "+s"(z)); ws += z; out += z; }
    F.lds = lds; F.ldsg = ldsg; F.tid = opaque_tid(); F.lane = F.tid & 63; F.wave = __builtin_amdgcn_readfirstlane(F.tid >> 6);
    F.G = gridDim.x; F.bid = blockIdx.x; F.out = out; F.ws = ws; F.dry = false;
    F.XN = (bf16*)(ws + WS_XN); F.XC = (bf16*)(ws + WS_XC); F.U = (bf16*)(ws + WS_U); F.KE = (bf16*)(ws + WS_KE); F.VT = (bf16*)(ws + WS_VT); F.PROJ = (bf16*)(ws + WS_PROJ);
    F.DECAY = (float*)(ws + WS_DECAY); F.SSQ = (float*)(ws + WS_SSQ);
    return F;
}
__global__ void __launch_bounds__(512, 2) trunk_fwd(Args args) {
    extern __shared__ __attribute__((aligned(16))) unsigned char lds_raw[];
    LAS unsigned char* const lds = (LAS unsigned char*)lds_raw;
    volatile LAS unsigned* MISC = (volatile LAS unsigned*)(lds + MISC_OFF);
    if (threadIdx.x < 32) MISC[threadIdx.x] = 0u;
    __syncthreads();
    const int lo = args.ph_lo, hi = args.ph_hi;
    XcdBarrier bar; bar.bar = (unsigned*)(args.ws + WS_CTL) + CW_BAR; bar.x = 0; bar.st = MISC + 8;
    if (hi - lo > 1) bar = xcd_barrier_post((unsigned*)(args.ws + WS_CTL) + CW_BAR, MISC + 8);
#ifndef PH_MASK
#define PH_MASK 0xfff
#endif
#define IN(k) (lo <= (k) && (k) < hi)
#define EN(k) ((PH_MASK >> (k)) & 1)
#define SEAM(k) do { if (IN(k) && IN((k) + 1)) { xcd_barrier(bar); if ((PROBE_MASK >> 12) & 1) xcd_barrier(bar); } } while (0)
#define PROBE_MASK 0
#ifndef PROBE_MASK
#define PROBE_MASK 0
#endif
#define SUB(n) (!PROBE_BUILD || args.pad == 0 || ((args.pad >> (n)) & 1))
#define FRAME() Frame F = make_frame(args, lds, lds_raw); F.dry = PROBE_BUILD && (((PROBE_MASK != 0) && (rep == 0) && (args.ph_hi < (1 << 30))) || (args.dry != 0))
#define REPS(k) _Pragma("unroll") for (int rep = ((PROBE_MASK >> (k)) & 1) ? 0 : 1; rep < 2; ++rep)
#define WL(F) ((F).ws + WS_W + (size_t)l * WL_STRIDE)
#define ROW_PARTIALS(WSOFF) do { __syncthreads(); pg8::Unit u_; if (S.next(0, u_) && F.tid < 256 && !F.dry) { const LAS float* xs_ = (const LAS float*)(F.lds + 131072); \
    ((float*)(F.ws + (WSOFF)))[(size_t)(u_.pm * 256 + F.tid) * 4 + u_.pn] = (xs_[F.tid] + xs_[256 + F.tid]) + (xs_[512 + F.tid] + xs_[768 + F.tid]); } __syncthreads(); } while (0)

    if (IN(0)) REPS(11) { FRAME(); phase_convert(F, args); phase_input_rows(F, as_global(args.in[0])); }
    SEAM(0);
    for (int l = 0; l < DEPTH; ++l) {
        const int p0 = 1 + l * NP;
        if (EN(1) && IN(p0 + 1)) REPS(1) { FRAME();
            pg8::Gemm g{D, D, D}; SchedProj S; S.base.init(F.XN, WL(F) + WL_IN, D, D, M, PN, F.G, F.bid);
            EpiProj E{F.PROJ, F.VT, (const float*)(F.ws + WS_PARTB), F.dry};
            pg8::gemm_phase<EpiProj, SchedProj, true, true>(F.lds, g, S, E);
        }
        SEAM(p0 + 1);
        if (EN(2) && IN(p0 + 2)) REPS(2) { FRAME(); phase_prep(F, args, l); }
        SEAM(p0 + 2);
        if (EN(3) && IN(p0 + 3)) REPS(3) { FRAME();
            pg8::Gemm g{D, 256, 256}; SchedLru S{(const char*)F.XC, (const char*)(WL(F) + WL_G), F.G, F.bid};
            EpiLru E{F.XC, F.PROJ + OFF_LX, PN, F.U, as_global(args.in[9]) + (size_t)l * D, as_global(args.in[11]) + (size_t)l * D, (const float*)(F.ws + WS_SPL)};
            if (SUB(0)) pg8::gemm_phase<EpiLru, SchedLru, true, true>(F.lds, g, S, E);
            if (SUB(1)) for (int it = F.bid; it < 256; it += F.G) gla::pass1_item(F, it);
        }
        SEAM(p0 + 3);
        if (EN(4) && IN(p0 + 4)) REPS(4) {
            if (SUB(0)) { REPS(13) { FRAME(); for (int it = F.bid; it < 256; it += F.G) gla::prefix_item(F, it); } }
            __syncthreads();
            if (SUB(1)) { REPS(14) { FRAME(); for (int it = F.bid; it < 256; it += F.G) lru_scan_a(F, it); } }
            __syncthreads();
            if (SUB(2)) { REPS(15) { FRAME(); for (int it = F.bid; it < 256; it += F.G) sb_attn_pair(F, as_global(args.in[13]) + (size_t)l * 128, as_global(args.in[14]) + (size_t)l * 128, it); } }
        }
        SEAM(p0 + 4);
        if (EN(5) && IN(p0 + 5)) REPS(5) { FRAME(); for (int it = F.bid; it < 256; it += F.G) lru_scan_b(F, it); __syncthreads(); for (int it = F.bid; it < 256; it += F.G) gla::pass2_item(F, as_global(args.in[5]) + (size_t)l * 256, it); }
        SEAM(p0 + 5);
        if (EN(6) && IN(p0 + 6)) REPS(6) { FRAME();
            pg8::Gemm g{PN, D, D}; SchedBranch S{(const char*)F.PROJ, (const char*)(WL(F) + WL_BR), F.G, F.bid};
            EpiBranch E{F.PROJ, as_global(args.in[18]) + (size_t)l * 3072, F.U};
            pg8::gemm_phase<EpiBranch, SchedBranch, true, true>(F.lds, g, S, E);
        }
        SEAM(p0 + 6);
        if (EN(7) && IN(p0 + 7)) REPS(7) { FRAME();
            pg8::Gemm g{D, D, D}; pg8::SchedStd S; S.init(F.U, WL(F) + WL_OUT, D, D, M, D, F.G, F.bid);
            pg8::EpiResF32 E{(l == 0) ? as_global(args.in[0]) : (const float*)F.out, F.out, D, F.dry, F.XN, (LAS float*)(F.lds + 131072)};
            pg8::gemm_phase<pg8::EpiResF32, pg8::SchedStd, false, true>(F.lds, g, S, E);
            ROW_PARTIALS(WS_PARTA);
        }
        SEAM(p0 + 7);
        if (EN(9) && IN(p0 + 9)) REPS(9) { FRAME();
            pg8::Gemm g{D, D, D}; pg8::SchedStd S; S.init(F.XN, WL(F) + WL_UP, D, D, M, FF, F.G, F.bid);
            pg8::EpiBf16<1> E{F.PROJ, FF, (const float*)(F.ws + WS_PARTA)};
            pg8::gemm_phase<pg8::EpiBf16<1>, pg8::SchedStd, true, true>(F.lds, g, S, E);
        }
        SEAM(p0 + 9);
        if (EN(10) && IN(p0 + 10)) REPS(10) { FRAME();
            pg8::Gemm g{FF, FF, FF}; pg8::SchedStd S; S.init(F.PROJ, WL(F) + WL_DN, FF, FF, M, D, F.G, F.bid);
            pg8::EpiResF32 E{F.out, F.out, D, F.dry, F.XN, (LAS float*)(F.lds + 131072)};
            pg8::gemm_phase<pg8::EpiResF32, pg8::SchedStd, false, true>(F.lds, g, S, E);
            ROW_PARTIALS(WS_PARTB);
        }
        SEAM(p0 + 10);
    }
#undef IN
#undef SEAM
}

extern "C" void kernel_launch(void* const* d_in, const int* in_sizes, int n_in, void* d_out, int out_size, void* d_ws, size_t ws_size, hipStream_t stream) {
    static int grid = 0;
    if (grid == 0) {
        if (n_in != 23 || out_size != M * D || ws_size < WS_END) { fprintf(stderr, "kernel_launch: unexpected shapes / workspace (n_in %d, out %d, ws %zu, need %zu)\n", n_in, out_size, ws_size, (size_t)WS_END); grid = -1; return; }
        int dev = 0, cus = 0, per_cu = 0;
        if (hipGetDevice(&dev) != hipSuccess || hipDeviceGetAttribute(&cus, hipDeviceAttributeMultiprocessorCount, dev) != hipSuccess) { grid = -1; return; }
        if (hipFuncSetAttribute((const void*)trunk_fwd, hipFuncAttributeMaxDynamicSharedMemorySize, LDS_BYTES) != hipSuccess) { grid = -1; return; }
        if (hipOccupancyMaxActiveBlocksPerMultiprocessor(&per_cu, (const void*)trunk_fwd, 512, LDS_BYTES) != hipSuccess || per_cu < 1) fprintf(stderr, "kernel_launch: occupancy query says %d\n", per_cu);
        (void)hipGetLastError();
        grid = cus;
    }
    if (grid < 0) return;
    (void)hipMemsetAsync((char*)d_ws + WS_CTL, 0, CTL_ZERO_BYTES, stream);
    Args a{};
    for (int i = 0; i < 23; ++i) a.in[i] = (const float*)d_in[i];
    a.out = (float*)d_out; a.ws = (unsigned char*)d_ws;
#if MK_ONE_LAUNCH
    a.ph_lo = 0; a.ph_hi = NPH;
    hipLaunchKernelGGL(trunk_fwd, dim3(grid), dim3(512), LDS_BYTES, stream, a);
#else
    for (int p = 0; p < NPH; ++p) { a.ph_lo = p; a.ph_hi = p + 1;
#ifdef PROBE_PHASE
        if (p >= 1 && (p - 1) % NP == PROBE_PHASE) { a.dry = 1; a.pad = PROBE_SUB; hipLaunchKernelGGL(trunk_fwd, dim3(grid), dim3(512), LDS_BYTES, stream, a); a.dry = 0; a.pad = 0; }
#endif
        if (p >= 1 && ((p - 1) % NP == 0 || (p - 1) % NP == 8)) continue;
        hipLaunchKernelGGL(trunk_fwd, dim3(grid), dim3(512), LDS_BYTES, stream, a); }
#endif
}
```

```cpp
#include <hip/hip_runtime.h>
#include <cstdio>

#ifndef PROBE_SUB
#define PROBE_SUB 0
#endif
#ifndef PROBE_BUILD
#define PROBE_BUILD 0
#endif
#ifndef MK_ONE_LAUNCH
#define MK_ONE_LAUNCH 1
#endif

#define LAS __attribute__((address_space(3)))
#define GAS __attribute__((address_space(1)))
typedef unsigned short bf16;
typedef unsigned v4u __attribute__((ext_vector_type(4)));
typedef unsigned v2u __attribute__((ext_vector_type(2)));
typedef float f32x4 __attribute__((ext_vector_type(4)));
typedef float f32x2 __attribute__((ext_vector_type(2)));
typedef short bf16x8 __attribute__((ext_vector_type(8)));

constexpr int D = 1024, BATCH = 8, T = 2048, M = BATCH * T, DEPTH = 4, FF = 4096;
constexpr int SRC_COLS = 11280;
constexpr int PN = 11264;
constexpr int OFF_GQ = 0, OFF_GK = 512, OFF_GV = 1024, OFF_GG = 2048, OFF_LX = 3072, OFF_LG = 4096, OFF_SQ = 5120, OFF_SK = 6144, OFF_SV = 7168, OFF_GATE = 8192;
constexpr int SRC_GDOWN = 3072;
constexpr float EPS = 1e-6f;
constexpr int NP = 11;
constexpr int NPH = 1 + DEPTH * NP;

constexpr size_t MiB = 1u << 20;
constexpr size_t WS_CTL = 0, CTL_ZERO_BYTES = 64 * 1024;
constexpr size_t WS_DECAY = 1 * MiB;
constexpr size_t WS_WDT = 1536 * 1024;
constexpr size_t WS_SSQ = 2 * MiB;
constexpr size_t WS_PARTA = 2 * MiB;
constexpr size_t WS_PARTB = 3 * MiB;
constexpr size_t WS_SPL = 512 * 1024;
constexpr size_t WS_W = 4 * MiB;
constexpr size_t WL_IN = 0, WL_BR = 22 * MiB, WL_OUT = 28 * MiB, WL_UP = 30 * MiB, WL_DN = 38 * MiB, WL_G = 46 * MiB, WL_STRIDE = 47 * MiB;
constexpr size_t WS_XN = 192 * MiB;
constexpr size_t WS_XC = 224 * MiB;
constexpr size_t WS_U = 256 * MiB;
constexpr size_t WS_KE = 288 * MiB;
constexpr size_t WS_VT = 304 * MiB;
constexpr size_t WS_PROJ = 336 * MiB;
constexpr size_t WS_END = WS_PROJ + (size_t)M * PN * 2;
static_assert(WS_W + DEPTH * WL_STRIDE <= WS_XN, "ws map");
constexpr int CW_BAR = 1024;

constexpr int RING_BYTES = 131072;
constexpr int MISC_OFF = 147456 - 256;
constexpr int LDS_BYTES = 147456;

template <class Tp> __device__ __forceinline__ Tp* as_global(Tp* p) {
#if defined(__HIP_DEVICE_COMPILE__)
    __builtin_assume(!__builtin_amdgcn_is_shared((const __attribute__((address_space(0))) void*)p) && !__builtin_amdgcn_is_private((const __attribute__((address_space(0))) void*)p));
#endif
    return p; }
__device__ __forceinline__ float bf2f(unsigned b) { return __uint_as_float(b << 16); }
__device__ __forceinline__ unsigned f2bf(float f) { unsigned u = __float_as_uint(f); return (u + 0x7fffu + ((u >> 16) & 1u)) >> 16; }
__device__ __forceinline__ unsigned pk2(float lo, float hi) { return f2bf(lo) | (f2bf(hi) << 16); }
__device__ __forceinline__ float blo(unsigned w) { return __uint_as_float(w << 16); }
__device__ __forceinline__ float bhi(unsigned w) { return __uint_as_float(w & 0xffff0000u); }
__device__ __forceinline__ float shx(float v, int o, int lane) { return __int_as_float(__builtin_amdgcn_ds_bpermute((lane ^ o) << 2, __float_as_int(v))); }
__device__ __forceinline__ float wave_sum(float v, int lane) {
#pragma unroll
    for (int o = 1; o < 64; o <<= 1) v += shx(v, o, lane);
    return v;
}
__device__ __forceinline__ float sigmoidf_(float x) { return 1.f / (1.f + __expf(-x)); }
__device__ __forceinline__ float logsigmoidf_(float x) { return fminf(x, 0.f) - log1pf(__expf(-fabsf(x))); }
#define LDS_WAIT() asm volatile("s_waitcnt lgkmcnt(0)" ::: "memory")
__device__ __forceinline__ int opaque_tid() { int t = threadIdx.x; asm volatile("" : "+v"(t)); return t; }

#define XB_TMO      128
#define XB_XCNT(j)  (256  + 64 * (j))
#define XB_XSUB(j)  (1280 + 64 * (j))
#define XB_XGEN(j)  (2304 + 64 * (j))
#define XB_TOP      3328
#define XB_TOPGEN   3392
#define XCD_BAR_WORDS 3456
#define XB_SPIN_CAP (1u << 18)
__device__ __forceinline__ unsigned xb_ld(unsigned* p)              { return __hip_atomic_load(p, __ATOMIC_RELAXED, __HIP_MEMORY_SCOPE_AGENT); }
__device__ __forceinline__ unsigned xb_add(unsigned* p, unsigned v) { return __hip_atomic_fetch_add(p, v, __ATOMIC_RELAXED, __HIP_MEMORY_SCOPE_AGENT); }
__device__ __forceinline__ unsigned xb_xcc_id() { return (unsigned)__builtin_amdgcn_s_getreg((3 << 11) | 20) & 0xFu; }
#define XB_SPIN(cond, bar) do { unsigned _sp = 0; while (cond) { __builtin_amdgcn_s_sleep(1); \
    if ((++_sp & 255u) == 0u) { if (xb_ld(&(bar)[XB_TMO])) break; if (_sp > XB_SPIN_CAP) { atomicAdd(&(bar)[XB_TMO], 1u); break; } } } } while (0)
struct XcdBarrier { unsigned* bar; unsigned x; volatile LAS unsigned* st; };
__device__ __forceinline__ XcdBarrier xcd_barrier_post(unsigned* bar, volatile LAS unsigned* st) {
    XcdBarrier b; b.bar = bar; b.x = xb_xcc_id(); b.st = st;
    if (threadIdx.x == 0) (void)xb_add(&bar[XB_XCNT(b.x)], 1u);
    return b;
}
__device__ __forceinline__ void xcd_barrier_complete(unsigned* bar, unsigned x, unsigned& nloc, unsigned& nx) {
    const unsigned G = gridDim.x * gridDim.y * gridDim.z;
    unsigned sum, cnt, mine, sp = 0u;
    for (;;) {
        sum = 0u; cnt = 0u; mine = 0u;
#pragma unroll
        for (unsigned j = 0; j < 16; ++j) { const unsigned c = xb_ld(&bar[XB_XCNT(j)]); sum += c; cnt += (c > 0u) ? 1u : 0u; mine = (j == x) ? c : mine; }
        if (sum == G) break;
        __builtin_amdgcn_s_sleep(1);
        if ((++sp & 255u) == 0u) { if (xb_ld(&bar[XB_TMO])) break; if (sp > XB_SPIN_CAP) { atomicAdd(&bar[XB_TMO], 1u); break; } }
    }
    nloc = mine > 0u ? mine : 1u; nx = cnt > 0u ? cnt : 1u;
}
__device__ __forceinline__ void xcd_barrier(const XcdBarrier& b) {
    asm volatile("s_waitcnt vmcnt(0)" ::: "memory");
    __syncthreads();
    if (threadIdx.x == 0) {
        unsigned* bar = b.bar; asm volatile("" : "+s"(bar));
        __builtin_amdgcn_s_waitcnt(0);
        unsigned nloc = b.st[0], nx = b.st[1];
        if (nloc == 0u) { xcd_barrier_complete(bar, b.x, nloc, nx); b.st[0] = nloc; b.st[1] = nx; }
        const unsigned old = xb_add(&bar[XB_XSUB(b.x)], 1u);
        const unsigned gen = old / nloc;
        if (old + 1u == (gen + 1u) * nloc) {
            __builtin_amdgcn_fence(__ATOMIC_RELEASE, "agent");
            asm volatile("s_waitcnt vmcnt(0)" ::: "memory");
            const unsigned og = xb_add(&bar[XB_TOP], 1u);
            const unsigned tg = og / nx;
            if (og + 1u == (tg + 1u) * nx) xb_add(&bar[XB_TOPGEN], 1u);
            else XB_SPIN(xb_ld(&bar[XB_TOPGEN]) == tg, bar);
            __builtin_amdgcn_fence(__ATOMIC_ACQUIRE, "agent");
            xb_add(&bar[XB_XGEN(b.x)], 1u);
            asm volatile("s_waitcnt vmcnt(0)" ::: "memory");
        } else {
            XB_SPIN(xb_ld(&bar[XB_XGEN(b.x)]) == gen, bar);
            __builtin_amdgcn_fence(__ATOMIC_ACQUIRE, "agent");
            asm volatile("s_waitcnt vmcnt(0)" ::: "memory");
        }
    }
    __syncthreads();
}

namespace pg8 {
constexpr int BM = 256, BK = 64, HALF = 128, HTB = HALF * BK * 2, STAGE_BYTES = 8 * HTB, NXCD = 8, WGM = 8;
__host__ __device__ __forceinline__ int lds_byte(int r, int c) { const int st = (r >> 4) * 2 + (c >> 5), rr = r & 15, cc = c & 31, ob = rr * 64 + cc * 2; return st * 1024 + (ob ^ (((ob >> 9) & 1) << 5)); }
__host__ __device__ __forceinline__ void stage_rc(int b, int& R, int& C) { const int st = b / 1024, sb = b % 1024, swz = sb ^ (((sb >> 9) & 1) << 5); R = (st >> 1) * 16 + swz / 64; C = (st & 1) * 32 + (swz % 64) / 2; }
__host__ __device__ __forceinline__ int perm32(int rho) { const int n = rho >> 4, i = rho & 15; return 8 * (i >> 2) + 4 * n + (i & 3); }
struct Unit { int pm, pn, aux; };
struct Gemm { int lda, ldb, K; };
__device__ __forceinline__ unsigned cvt_pk_bf16(float lo, float hi) { unsigned r; asm volatile("v_cvt_pk_bf16_f32 %0, %1, %2" : "=v"(r) : "v"(lo), "v"(hi)); return r; }

struct SchedStd {
    const char* A; const char* B; size_t tstepA, tstepB; int nM, nN, nwg, G, c;
    __device__ __forceinline__ void init(const void* A_, const void* B_, int lda, int ldb, int Mr, int Nc, int G_, int c_) { A = (const char*)A_; B = (const char*)B_; tstepA = (size_t)BM * lda * 2; tstepB = (size_t)BM * ldb * 2; nM = Mr / BM; nN = Nc / BM; nwg = nM * nN; G = G_; c = c_; }
    __device__ __forceinline__ bool next(int i, Unit& u) const {
        const long L = (long)i * G + c; if (L >= nwg) return false;
        int wgid = (int)L; { const int q = nwg / NXCD, r = nwg % NXCD, xcd = wgid % NXCD, off = wgid / NXCD; wgid = (xcd < r ? xcd * (q + 1) : r * (q + 1) + (xcd - r) * q) + off; }
        const int nig = WGM * nN, gid = wgid / nig, fm = gid * WGM, gsz = (nM - fm) < WGM ? (nM - fm) : WGM;
        u.pm = fm + ((wgid % nig) % gsz); u.pn = (wgid % nig) / gsz; u.aux = 0; return true;
    }
    __device__ __forceinline__ const char* abase(const Unit& u) const { return A + (size_t)u.pm * tstepA; }
    __device__ __forceinline__ const char* bbase(const Unit& u) const { return B + (size_t)u.pn * tstepB; }
};

template <class Epi, class Sched, bool ALIGN_EPI, bool SP2>
__device__ __forceinline__ void gemm_phase(LAS unsigned char* lds, const Gemm g, const Sched& S, const Epi& E) {
    const int tid = opaque_tid(), wid = __builtin_amdgcn_readfirstlane(tid >> 6), lane = tid & 63, wr = wid >> 2, wc = wid & 3, fr = lane & 15, fq = lane >> 4;
    const int K = g.K, nt = K / BK;
    unsigned voffA[2], voffB[2];
#pragma unroll
    for (int i = 0; i < 2; ++i) { int R, C; stage_rc(tid * 16 + i * 8192, R, C); const int Rb = Epi::PERM ? ((R & ~31) + perm32(R & 31)) : R;
        voffA[i] = (unsigned)(R * g.lda + C) * 2u; voffB[i] = (unsigned)(Rb * g.ldb + C) * 2u; }
    const size_t kstep = (size_t)(BK * 2);
    const size_t hstepA = (size_t)HALF * g.lda * 2, hstepB = (size_t)HALF * g.ldb * 2;
    const unsigned ldsw = (unsigned)wid * 1024u;
    const int aoff = lds_byte(wr * 64 + fr, fq * 8), boff = lds_byte(wc * 32 + fr, fq * 8);
#define PG8_SA(b, h) (((b) * 2 + (h)) * HTB)
#define PG8_SB(b, h) ((4 + (b) * 2 + (h)) * HTB)
#define PG8_STAGE(bufoff, gbase, voff) do { _Pragma("unroll") for (int _i = 0; _i < 2; ++_i) \
        __builtin_amdgcn_global_load_lds((const unsigned*)((const char*)(gbase) + (voff)[_i]), (LAS unsigned*)(lds + (bufoff) + ldsw + _i * 8192), 16, 0, 0); } while (0)
#define PG8_LDA(dst, b, h) do { _Pragma("unroll") for (int m = 0; m < 4; ++m) _Pragma("unroll") for (int k = 0; k < 2; ++k) dst[m][k] = *(const LAS bf16x8*)(lds + PG8_SA(b, h) + aoff + m * 2048 + k * 1024); } while (0)
#define PG8_LDB(dst, b, h) do { _Pragma("unroll") for (int n = 0; n < 2; ++n) _Pragma("unroll") for (int k = 0; k < 2; ++k) dst[n][k] = *(const LAS bf16x8*)(lds + PG8_SB(b, h) + boff + n * 2048 + k * 1024); } while (0)
#define PG8_MMA(ai, bj, At, Bt) do { __builtin_amdgcn_s_setprio(1); _Pragma("unroll") for (int m = 0; m < 4; ++m) _Pragma("unroll") for (int n = 0; n < 2; ++n) _Pragma("unroll") for (int k = 0; k < 2; ++k) \
        acc[ai][bj][m][n] = __builtin_amdgcn_mfma_f32_16x16x32_bf16(Bt[n][k], At[m][k], acc[ai][bj][m][n], 0, 0, 0); __builtin_amdgcn_s_setprio(0); } while (0)
#define PG8_WAIT_V(n) asm volatile("s_waitcnt vmcnt(" #n ")" ::: "memory")
#define PG8_WAIT_L(n) asm volatile("s_waitcnt lgkmcnt(" #n ")" ::: "memory")
#define PG8_BAR __builtin_amdgcn_s_barrier()
#define PG8_SCHED __builtin_amdgcn_sched_barrier(0)
    Unit cur, nxt; int ui = 0;
    if (!S.next(0, cur)) return;
    f32x4 acc[2][2][4][2];
#pragma unroll
    for (int a = 0; a < 2; ++a)
#pragma unroll
        for (int b = 0; b < 2; ++b)
#pragma unroll
            for (int m = 0; m < 4; ++m)
#pragma unroll
                for (int n = 0; n < 2; ++n) acc[a][b][m][n] = (f32x4){0.f, 0.f, 0.f, 0.f};
    bf16x8 At[4][2], B0[2][2], B1[2][2];
    const char* cA = S.abase(cur); const char* cB = S.bbase(cur);
    LAS float* const xrs = (LAS float*)(lds + 131072 + 4096);
    f32x4 rsreg = {0.f, 0.f, 0.f, 0.f};
    if constexpr (Epi::ROW_RS) { if (tid < 256) { rsreg = *(const f32x4*)(E.part + (size_t)(cur.pm * BM + tid) * 4); xrs[tid] = __builtin_amdgcn_rsqf(((rsreg.x + rsreg.y) + (rsreg.z + rsreg.w)) * (1.f / 1024.f) + 1e-6f); } }
    if constexpr (SP2) {
        PG8_STAGE(PG8_SB(0, 0), cB, voffB); PG8_STAGE(PG8_SB(0, 1), cB + hstepB, voffB); PG8_STAGE(PG8_SA(0, 0), cA, voffA); PG8_STAGE(PG8_SA(0, 1), cA + hstepA, voffA);
        if (wr == 1) PG8_BAR;
        PG8_WAIT_V(2); PG8_BAR;
        PG8_STAGE(PG8_SB(1, 0), cB + kstep, voffB); PG8_STAGE(PG8_SA(1, 0), cA + kstep, voffA); PG8_STAGE(PG8_SB(1, 1), cB + hstepB + kstep, voffB);
        PG8_WAIT_V(6); PG8_BAR;
    } else {
        PG8_STAGE(PG8_SB(0, 0), cB, voffB); PG8_STAGE(PG8_SA(0, 0), cA, voffA); PG8_STAGE(PG8_SB(0, 1), cB + hstepB, voffB); PG8_STAGE(PG8_SA(0, 1), cA + hstepA, voffA);
        if (wr == 1) PG8_BAR;
        PG8_WAIT_V(4); PG8_BAR;
        PG8_STAGE(PG8_SB(1, 0), cB + kstep, voffB); PG8_STAGE(PG8_SA(1, 0), cA + kstep, voffA); PG8_STAGE(PG8_SB(1, 1), cB + hstepB + kstep, voffB);
        PG8_WAIT_V(6); PG8_BAR;
    }
    for (;;) {
        const bool has_next = S.next(ui + 1, nxt);
        const char* nA = has_next ? S.abase(nxt) : cA; const char* nB = has_next ? S.bbase(nxt) : cB;
        if constexpr (Epi::ROW_RS) { if (has_next && tid < 256) rsreg = *(const f32x4*)(E.part + (size_t)(nxt.pm * BM + tid) * 4); }
#pragma nounroll
        for (int t = 0; t < nt; t += 2) {
            const bool last = (t == nt - 2);
            const char* a1 = cA + (size_t)(t + 1) * kstep;
            const char* a2 = last ? nA : cA + (size_t)(t + 2) * kstep; const char* b2 = last ? nB : cB + (size_t)(t + 2) * kstep;
            const char* a3 = a2 + kstep; const char* b3 = b2 + kstep;
            if constexpr (SP2) {
            PG8_LDB(B0, 0, 0); PG8_LDB(B1, 0, 1); PG8_SCHED; PG8_LDA(At, 0, 0); PG8_STAGE(PG8_SA(1, 1), a1 + hstepA, voffA);
            PG8_WAIT_V(8); PG8_WAIT_L(0); PG8_BAR; PG8_MMA(0, 0, At, B0); PG8_MMA(0, 1, At, B1); PG8_BAR; PG8_SCHED;
            PG8_LDA(At, 0, 1); PG8_STAGE(PG8_SB(0, 0), b2, voffB); PG8_STAGE(PG8_SB(0, 1), b2 + hstepB, voffB); PG8_STAGE(PG8_SA(0, 0), a2, voffA);
            PG8_WAIT_V(8); PG8_WAIT_L(0); PG8_BAR; PG8_MMA(1, 0, At, B0); PG8_MMA(1, 1, At, B1); PG8_BAR; PG8_SCHED;
            PG8_LDB(B0, 1, 0); PG8_LDB(B1, 1, 1); PG8_SCHED; PG8_LDA(At, 1, 0); PG8_STAGE(PG8_SA(0, 1), a2 + hstepA, voffA);
            PG8_WAIT_V(8); PG8_WAIT_L(0); PG8_BAR; PG8_MMA(0, 0, At, B0); PG8_MMA(0, 1, At, B1); PG8_BAR; PG8_SCHED;
            PG8_LDA(At, 1, 1); PG8_STAGE(PG8_SB(1, 0), b3, voffB); PG8_STAGE(PG8_SB(1, 1), b3 + hstepB, voffB); PG8_STAGE(PG8_SA(1, 0), a3, voffA);
            PG8_WAIT_V(8); PG8_WAIT_L(0); PG8_BAR; PG8_MMA(1, 0, At, B0); PG8_MMA(1, 1, At, B1); PG8_BAR; PG8_SCHED;
            } else {
            PG8_LDB(B0, 0, 0); PG8_SCHED; PG8_LDA(At, 0, 0); PG8_STAGE(PG8_SA(1, 1), a1 + hstepA, voffA);
            PG8_WAIT_L(8); PG8_BAR; PG8_WAIT_L(0); PG8_MMA(0, 0, At, B0); PG8_BAR; PG8_SCHED;
            PG8_LDB(B1, 0, 1); PG8_STAGE(PG8_SB(0, 0), b2, voffB);
            PG8_BAR; PG8_WAIT_L(0); PG8_MMA(0, 1, At, B1); PG8_BAR;
            PG8_LDA(At, 0, 1); PG8_STAGE(PG8_SA(0, 0), a2, voffA);
            PG8_BAR; PG8_WAIT_L(0); PG8_MMA(1, 0, At, B0); PG8_BAR; PG8_SCHED;
            PG8_STAGE(PG8_SB(0, 1), b2 + hstepB, voffB);
            PG8_WAIT_V(6); PG8_BAR; PG8_MMA(1, 1, At, B1); PG8_BAR;
            PG8_LDB(B0, 1, 0); PG8_SCHED; PG8_LDA(At, 1, 0); PG8_STAGE(PG8_SA(0, 1), a2 + hstepA, voffA);
            PG8_WAIT_L(8); PG8_BAR; PG8_WAIT_L(0); PG8_MMA(0, 0, At, B0); PG8_BAR; PG8_SCHED;
            PG8_LDB(B1, 1, 1); PG8_STAGE(PG8_SB(1, 0), b3, voffB);
            PG8_BAR; PG8_WAIT_L(0); PG8_MMA(0, 1, At, B1); PG8_BAR;
            PG8_LDA(At, 1, 1); PG8_STAGE(PG8_SA(1, 0), a3, voffA);
            PG8_BAR; PG8_WAIT_L(0); PG8_MMA(1, 0, At, B0); PG8_BAR; PG8_SCHED;
            PG8_STAGE(PG8_SB(1, 1), b3 + hstepB, voffB);
            PG8_WAIT_V(6); PG8_BAR; PG8_MMA(1, 1, At, B1); PG8_BAR;
            }
        }
        if constexpr (Epi::ROW_RS) { if (has_next && tid < 256) xrs[((ui + 1) & 1) * 256 + tid] = __builtin_amdgcn_rsqf(((rsreg.x + rsreg.y) + (rsreg.z + rsreg.w)) * (1.f / 1024.f) + 1e-6f); }
        if constexpr (ALIGN_EPI) { if (wr == 0) PG8_BAR; }
        const bool zero = E(acc, cur, wr, wc, fr, fq, xrs + (ui & 1) * 256);
        if (!has_next) break;
        if (zero) {
#pragma unroll
        for (int a = 0; a < 2; ++a)
#pragma unroll
            for (int b = 0; b < 2; ++b)
#pragma unroll
                for (int m = 0; m < 4; ++m)
#pragma unroll
                    for (int n = 0; n < 2; ++n) acc[a][b][m][n] = (f32x4){0.f, 0.f, 0.f, 0.f};
        }
        cur = nxt; cA = nA; cB = nB; ++ui;
        if constexpr (ALIGN_EPI) { if (wr == 1) PG8_BAR; }
    }
    PG8_WAIT_V(0);
    if constexpr (!ALIGN_EPI) { if (wr == 0) PG8_BAR; }
    PG8_BAR;
#undef PG8_SA
#undef PG8_SB
#undef PG8_STAGE
#undef PG8_LDA
#undef PG8_LDB
#undef PG8_MMA
#undef PG8_WAIT_V
#undef PG8_WAIT_L
#undef PG8_BAR
#undef PG8_SCHED
}

__device__ __forceinline__ float row_rs(const float* part, int row) {
    const f32x4 a = *(const f32x4*)(part + (size_t)row * 4);
    return __builtin_amdgcn_rsqf(((a.x + a.y) + (a.z + a.w)) * (1.f / 1024.f) + 1e-6f);
}
template <int ACT> struct EpiBf16 {
    static constexpr bool PERM = true, ROW_RS = true;
    bf16* O; int ldc; const float* part;
    __device__ __forceinline__ bool operator()(f32x4 (&acc)[2][2][4][2], const Unit& u, int wr, int wc, int fr, int fq, const LAS float* xrs) const {
        const int row0 = u.pm * BM + wr * 64 + fr, col0 = u.pn * BM + wc * 32 + 8 * fq;
        float rsv[8];
#pragma unroll
        for (int i = 0; i < 8; ++i) rsv[i] = xrs[wr * 64 + fr + (i >> 2) * HALF + (i & 3) * 16];
#pragma unroll
        for (int ai = 0; ai < 2; ++ai)
#pragma unroll
            for (int m = 0; m < 4; ++m) { bf16* rowp = O + (size_t)(row0 + ai * HALF + m * 16) * ldc + col0; const float rs = rsv[ai * 4 + m];
#pragma unroll
                for (int bj = 0; bj < 2; ++bj) { f32x4 v0 = acc[ai][bj][m][0] * rs, v1 = acc[ai][bj][m][1] * rs;
                    if (ACT == 1) {
#pragma unroll
                        for (int j = 0; j < 4; ++j) { const float a = fmaxf(v0[j], 0.f), b = fmaxf(v1[j], 0.f); v0[j] = a * a; v1[j] = b * b; } }
                    v4u w; w.x = cvt_pk_bf16(v0[0], v0[1]); w.y = cvt_pk_bf16(v0[2], v0[3]); w.z = cvt_pk_bf16(v1[0], v1[1]); w.w = cvt_pk_bf16(v1[2], v1[3]);
                    __builtin_nontemporal_store(w, (v4u*)(rowp + bj * HALF)); } }
        return true;
    }
};
struct EpiResF32 {
    static constexpr bool PERM = false, ROW_RS = false;
    const float* base; float* out; int ldc; bool dry; bf16* xb; LAS float* xs;
    __device__ __forceinline__ bool operator()(f32x4 (&acc)[2][2][4][2], const Unit& u, int wr, int wc, int fr, int fq, const LAS float* xrs) const {
        const int row0 = u.pm * BM + wr * 64 + fr, col0 = u.pn * BM + wc * 32 + 4 * fq;
        f32x4 bs[2][4];
#define RES_LOAD(slot, gi) do { const size_t off_ = (size_t)(row0 + ((gi) >> 2) * HALF + ((gi) & 3) * 16) * ldc + col0; \
        bs[slot][0] = *(const f32x4*)(base + off_); bs[slot][1] = *(const f32x4*)(base + off_ + 16); bs[slot][2] = *(const f32x4*)(base + off_ + HALF); bs[slot][3] = *(const f32x4*)(base + off_ + HALF + 16); } while (0)
        RES_LOAD(0, 0);
#pragma unroll
        for (int gi = 0; gi < 8; ++gi) { const int ai = gi >> 2, m = gi & 3;
            if (gi < 7) RES_LOAD((gi + 1) & 1, gi + 1);
            const int row = row0 + ai * HALF + m * 16; const size_t off = (size_t)row * ldc + col0; float ss = 0.f;
#pragma unroll
            for (int bj = 0; bj < 2; ++bj)
#pragma unroll
                for (int n = 0; n < 2; ++n) { const f32x4 v = bs[gi & 1][bj * 2 + n] + acc[ai][bj][m][n];
                    ss += (v.x * v.x + v.y * v.y) + (v.z * v.z + v.w * v.w);
                    if (!dry) { *(f32x4*)(out + off + bj * HALF + n * 16) = v; v2u w; w.x = cvt_pk_bf16(v.x, v.y); w.y = cvt_pk_bf16(v.z, v.w); *(v2u*)(xb + off + bj * HALF + n * 16) = w; } }
            ss += __shfl_xor(ss, 16); ss += __shfl_xor(ss, 32);
            if (fq == 0) xs[wc * 256 + (row - u.pm * BM)] = ss; }
#undef RES_LOAD
        return true;
    }
};
}

struct Args { const float* in[23]; float* out; unsigned char* ws; int ph_lo, ph_hi, dry, pad; };

struct Frame {
    LAS unsigned char* lds; unsigned char* ldsg;
    int tid, lane, wave, G, bid; bool dry;
    float* out; unsigned char* ws;
    bf16 *XN, *XC, *U, *KE, *VT, *PROJ; float *DECAY, *SSQ;
};

__device__ __forceinline__ void transpose_item(const float* W, int ldw, int nblk, bf16* WT, int K, int row_off, LAS float* scr, int item, int lane, const float* gk = nullptr) {
    const int kb = item / nblk, nb = item % nblk, k0 = 64 * kb, n0 = 32 * nb;
    float wv[32];
#pragma unroll
    for (int i = 0; i < 32; ++i) wv[i] = W[(size_t)(k0 + 2 * i + (lane >> 5)) * ldw + n0 + (lane & 31)];
#pragma unroll
    for (int i = 0; i < 32; ++i) { const int kk = 2 * i + (lane >> 5); scr[kk * 33 + (lane & 31)] = wv[i] * (gk ? gk[k0 + kk] : 1.0f); }
    LDS_WAIT(); asm volatile("" ::: "memory");
    const int c = lane & 7;
#pragma unroll
    for (int j = 0; j < 4; ++j) { const int n = (lane >> 3) + 8 * j; const LAS float* s = scr + (8 * c) * 33 + n;
        v4u o; o.x = pk2(s[0 * 33], s[1 * 33]); o.y = pk2(s[2 * 33], s[3 * 33]); o.z = pk2(s[4 * 33], s[5 * 33]); o.w = pk2(s[6 * 33], s[7 * 33]);
        *(v4u*)(WT + (size_t)(row_off + n0 + n) * K + k0 + 8 * c) = o; }
    LDS_WAIT(); asm volatile("" ::: "memory");
}
__device__ __forceinline__ void phase_convert(Frame& F, const Args& A) {
    F.tid = opaque_tid(); F.lane = F.tid & 63;
    { bf16* wdt = (bf16*)(F.ws + WS_WDT);
      for (int idx = F.bid * 512 + F.tid; idx < DEPTH * 16 * D; idx += F.G * 512) { const int l = idx >> 14, n = (idx >> 10) & 15, k = idx & 1023;
          wdt[idx] = (bf16)f2bf(as_global(A.in[2])[((size_t)l * D + k) * SRC_COLS + SRC_GDOWN + n] * as_global(A.in[1])[(size_t)l * D + k]); } }
    LAS float* scr = (LAS float*)(F.lds + F.wave * 16384);
    const int gw = F.bid * 8 + F.wave, NGW = F.G * 8;
    constexpr int PER_L = 1536 + 4096 + 1536 + 512 + 2048 + 2048 + 256;
    for (int it = gw; it < DEPTH * PER_L; it += NGW) {
        const int l = it / PER_L; int r = it % PER_L;
        unsigned char* wl = F.ws + WS_W + (size_t)l * WL_STRIDE;
        const float* win = as_global(A.in[2]) + (size_t)l * D * SRC_COLS;
        if (r < 1536) { transpose_item(win, SRC_COLS, 96, (bf16*)(wl + WL_IN), D, 0, scr, r, F.lane, as_global(A.in[1]) + (size_t)l * D); continue; } r -= 1536;
        if (r < 4096) { transpose_item(win + 3088, SRC_COLS, 256, (bf16*)(wl + WL_IN), D, 3072, scr, r, F.lane, as_global(A.in[1]) + (size_t)l * D); continue; } r -= 4096;
        if (r < 1536) { const int br = r / 512; const float* wb = br == 0 ? as_global(A.in[15]) : (br == 1 ? as_global(A.in[16]) : as_global(A.in[17])); transpose_item(wb + (size_t)l * D * D, D, 32, (bf16*)(wl + WL_BR), D, br * 1024, scr, r % 512, F.lane); continue; } r -= 1536;
        if (r < 512) { transpose_item(as_global(A.in[19]) + (size_t)l * D * D, D, 32, (bf16*)(wl + WL_OUT), D, 0, scr, r, F.lane); continue; } r -= 512;
        if (r < 2048) { transpose_item(as_global(A.in[21]) + (size_t)l * D * FF, FF, 128, (bf16*)(wl + WL_UP), D, 0, scr, r, F.lane, as_global(A.in[20]) + (size_t)l * D); continue; } r -= 2048;
        if (r < 2048) { transpose_item(as_global(A.in[22]) + (size_t)l * D * FF, D, 32, (bf16*)(wl + WL_DN), FF, 0, scr, r, F.lane); continue; } r -= 2048;
        { const int mtx = r / 32, rr = r % 32, blk = mtx >> 1, gate = mtx & 1, n0 = (rr % 8) * 32;
          const int row_off = (blk * 2 + (n0 >> 7)) * 256 + gate * 128 + (n0 & 127) - n0;
          const float* w = (gate ? as_global(A.in[10]) : as_global(A.in[8])) + (size_t)l * 262144 + (size_t)blk * 65536;
          transpose_item(w, 256, 8, (bf16*)(wl + WL_G), 256, row_off, scr, rr, F.lane); }
    }
}

__device__ __forceinline__ void phase_input_rows(Frame& F, const float* x) {
    const int gw = F.bid * 8 + F.wave, NGW = F.G * 8;
    float* part = (float*)(F.ws + WS_PARTB);
    for (int m = gw; m < M; m += NGW) {
        const f32x4* xr = (const f32x4*)(x + (size_t)m * D) + F.lane;
        f32x4 v[4]; float s = 0.f;
#pragma unroll
        for (int j = 0; j < 4; ++j) { v[j] = xr[64 * j]; s += (v[j].x * v[j].x + v[j].y * v[j].y) + (v[j].z * v[j].z + v[j].w * v[j].w); }
        s = wave_sum(s, F.lane);
        v2u* o8 = (v2u*)(F.XN + (size_t)m * D) + F.lane;
#pragma unroll
        for (int j = 0; j < 4; ++j) { v2u w; w.x = pk2(v[j].x, v[j].y); w.y = pk2(v[j].z, v[j].w); o8[64 * j] = w; }
        if (F.lane < 4) part[(size_t)m * 4 + F.lane] = F.lane == 0 ? s : 0.f;
    }
}

__device__ __forceinline__ void phase_rmsnorm(Frame& F, const float* x, const float* g, bf16* out) {
    F.tid = opaque_tid(); F.lane = F.tid & 63;
    const int gw = F.bid * 8 + F.wave, NGW = F.G * 8;
    f32x4 gv[4];
#pragma unroll
    for (int j = 0; j < 4; ++j) gv[j] = *((const f32x4*)g + F.lane + 64 * j);
    for (int m = gw; m < M; m += NGW) {
        const f32x4* xr = (const f32x4*)(x + (size_t)m * D) + F.lane;
        f32x4 v[4]; float s = 0.f;
#pragma unroll
        for (int j = 0; j < 4; ++j) { v[j] = xr[64 * j]; s += (v[j].x * v[j].x + v[j].y * v[j].y) + (v[j].z * v[j].z + v[j].w * v[j].w); }
        const float rs = 1.0f / sqrtf(wave_sum(s, F.lane) * (1.f / D) + EPS);
        v2u* o8 = (v2u*)(out + (size_t)m * D) + F.lane;
#pragma unroll
        for (int j = 0; j < 4; ++j) { v2u w; w.x = pk2(v[j].x * rs * gv[j].x, v[j].y * rs * gv[j].y); w.y = pk2(v[j].z * rs * gv[j].z, v[j].w * rs * gv[j].w); o8[64 * j] = w; }
    }
}

__device__ __forceinline__ void phase_prep(Frame& F, const Args& A, int l) {
#define PSUB(n) (!PROBE_BUILD || A.pad == 0 || ((A.pad >> (n)) & 1))
    F.tid = opaque_tid(); F.lane = F.tid & 63;
    const int gt = F.bid * 512 + F.tid, NGT = F.G * 512;
    if (PSUB(0)) {
        const float* cw = as_global(A.in[6]) + (size_t)l * 4 * D; const float* cb = as_global(A.in[7]) + (size_t)l * D;
        const bf16* __restrict__ lxp = F.PROJ; bf16* __restrict__ xcp = F.XC;
        for (int idx = gt; idx < (M / 8) * 128; idx += NGT) {
            const int c0 = (idx & 127) * 8, r0 = (idx >> 7) * 8, t0 = r0 & (T - 1);
            v4u xin[11];
#pragma unroll
            for (int i = 0; i < 11; ++i) xin[i] = (i >= 3 || t0 != 0) ? *(const v4u*)(lxp + (size_t)(r0 - 3 + i) * PN + OFF_LX + c0) : (v4u){0u, 0u, 0u, 0u};
            float w[4][8], bb[8];
#pragma unroll
            for (int j = 0; j < 8; ++j) { bb[j] = cb[c0 + j]; w[0][j] = cw[c0 + j]; w[1][j] = cw[D + c0 + j]; w[2][j] = cw[2 * D + c0 + j]; w[3][j] = cw[3 * D + c0 + j]; }
#pragma unroll
            for (int r = 0; r < 8; ++r) { float acc[8];
#pragma unroll
                for (int j = 0; j < 8; ++j) acc[j] = bb[j];
#pragma unroll
                for (int jj = 0; jj < 4; ++jj) { const v4u xv = xin[r + jj];
                    acc[0] += w[jj][0] * blo(xv.x); acc[1] += w[jj][1] * bhi(xv.x); acc[2] += w[jj][2] * blo(xv.y); acc[3] += w[jj][3] * bhi(xv.y);
                    acc[4] += w[jj][4] * blo(xv.z); acc[5] += w[jj][5] * bhi(xv.z); acc[6] += w[jj][6] * blo(xv.w); acc[7] += w[jj][7] * bhi(xv.w); }
                v4u o; o.x = pk2(acc[0], acc[1]); o.y = pk2(acc[2], acc[3]); o.z = pk2(acc[4], acc[5]); o.w = pk2(acc[6], acc[7]);
                *(v4u*)(xcp + (size_t)(r0 + r) * D + c0) = o; }
        }
    }
    if (F.bid == 0) { const float* lam = as_global(A.in[12]) + (size_t)l * D; float* spl = (float*)(F.ws + WS_SPL);
        for (int c = F.tid; c < D; c += 512) { const float nl = -lam[c]; spl[c] = fmaxf(nl, 0.f) + 0.6931471805599453f * __builtin_amdgcn_logf(1.0f + __builtin_amdgcn_exp2f(-1.4426950408889634f * fabsf(nl))); } }
    if (PSUB(3)) {
        LAS float* adp = (LAS float*)F.lds;
        LAS float* ad = adp + 2048;
        const bf16* wdt = (const bf16*)(F.ws + WS_WDT) + (size_t)l * 16 * D;
        const float* wup = as_global(A.in[3]) + (size_t)l * 16 * 512; const float* bal = as_global(A.in[4]) + (size_t)l * 512;
        for (int ch = F.bid; ch < M / 64; ch += F.G) {
            const int m0 = ch * 64;
            __syncthreads();
            { const int rg = F.wave & 3, kh = F.wave >> 2, l15 = F.lane & 15, q4 = F.lane >> 4;
              const bf16* ap = F.XN + (size_t)(m0 + 16 * rg + l15) * D + 512 * kh + 8 * q4; const bf16* bp = wdt + (size_t)l15 * D + 512 * kh + 8 * q4;
              f32x4 acc = {0.f, 0.f, 0.f, 0.f};
#pragma unroll 4
              for (int ks = 0; ks < 16; ++ks) acc = __builtin_amdgcn_mfma_f32_16x16x32_bf16(*reinterpret_cast<const bf16x8*>(ap + 32 * ks), *reinterpret_cast<const bf16x8*>(bp + 32 * ks), acc, 0, 0, 0);
#pragma unroll
              for (int r = 0; r < 4; ++r) adp[kh * 1024 + (16 * rg + 4 * q4 + r) * 16 + l15] = acc[r] * pg8::row_rs((const float*)(F.ws + WS_PARTB), m0 + 16 * rg + 4 * q4 + r); }
            __syncthreads();
            ad[F.tid] = adp[F.tid] + adp[1024 + F.tid]; ad[512 + F.tid] = adp[512 + F.tid] + adp[1536 + F.tid];
            __syncthreads();
            const int c = F.tid;
            float wu[16];
#pragma unroll
            for (int j = 0; j < 16; ++j) wu[j] = wup[j * 512 + c];
            const float ba = bal[c];
            float cum = 0.f;
            bf16 qA[8], kA[8], qB[8], kB[8];
#define GP_LOAD(Q, K, t8_) do { _Pragma("unroll") for (int tt = 0; tt < 8; ++tt) { Q[tt] = F.PROJ[(size_t)(m0 + (t8_) + tt) * PN + OFF_GQ + c]; K[tt] = F.PROJ[(size_t)(m0 + (t8_) + tt) * PN + OFF_GK + c]; } } while (0)
#define GP_STEP(Q, K, t8_) do { _Pragma("unroll") for (int tt = 0; tt < 8; ++tt) { const int t = (t8_) + tt; float lg = ba; \
                _Pragma("unroll") for (int j4 = 0; j4 < 4; ++j4) { const f32x4 a4 = *reinterpret_cast<const LAS f32x4*>(ad + t * 16 + 4 * j4); lg += a4.x * wu[4 * j4] + a4.y * wu[4 * j4 + 1] + a4.z * wu[4 * j4 + 2] + a4.w * wu[4 * j4 + 3]; } \
                const float ax = fabsf(lg) * 1.4426950408889634f; const float l2 = __builtin_amdgcn_logf(1.0f + __builtin_amdgcn_exp2f(-ax));     \
                cum += (fminf(lg, 0.f) * 1.4426950408889634f - l2) * (1.f / 16.f); \
                const float e = __builtin_amdgcn_exp2f(cum), ei = __builtin_amdgcn_rcpf(e); \
                if (!F.dry) { F.PROJ[(size_t)(m0 + t) * PN + OFF_GQ + c] = (bf16)f2bf(bf2f(Q[tt]) * 0.08838834764831845f * e); F.PROJ[(size_t)(m0 + t) * PN + OFF_GK + c] = (bf16)f2bf(bf2f(K[tt]) * ei); } } } while (0)
            GP_LOAD(qA, kA, 0);
#pragma nounroll
            for (int t16 = 0; t16 < 64; t16 += 16) {
                GP_LOAD(qB, kB, t16 + 8); GP_STEP(qA, kA, t16);
                if (t16 + 16 < 64) GP_LOAD(qA, kA, t16 + 16);
                GP_STEP(qB, kB, t16 + 8);
            }
#undef GP_LOAD
#undef GP_STEP
            F.DECAY[(size_t)ch * 512 + c] = __builtin_amdgcn_exp2f(cum);
        }
    }
}

struct SchedProj {
    pg8::SchedStd base;
    __device__ __forceinline__ bool next(int i, pg8::Unit& u) const { if (!base.next(i, u)) return false; u.aux = 0; return true; }
    __device__ __forceinline__ const char* abase(const pg8::Unit& u) const { return u.aux ? base.B + (size_t)u.pn * base.tstepB : base.A + (size_t)u.pm * base.tstepA; }
    __device__ __forceinline__ const char* bbase(const pg8::Unit& u) const { return u.aux ? base.A + (size_t)u.pm * base.tstepA : base.B + (size_t)u.pn * base.tstepB; }
};
struct EpiProj {
    static constexpr bool PERM = true, ROW_RS = true;
    bf16* O; bf16* VT; const float* part; bool dry;
    __device__ __forceinline__ bool operator()(f32x4 (&acc)[2][2][4][2], const pg8::Unit& u, int wr, int wc, int fr, int fq, const LAS float* xrs) const {
        bf16* base = u.aux ? VT : O; const size_t ldc = u.aux ? (size_t)M : (size_t)PN;
        const int row0 = (u.aux ? (u.pn - 4) : u.pm) * 256 + wr * 64 + fr, col0 = (u.aux ? u.pm : u.pn) * 256 + wc * 32 + 8 * fq;
        float rsv[8];
#pragma unroll
        for (int i = 0; i < 8; ++i) rsv[i] = xrs[wr * 64 + fr + (i >> 2) * 128 + (i & 3) * 16];
#pragma unroll
        for (int ai = 0; ai < 2; ++ai)
#pragma unroll
            for (int m = 0; m < 4; ++m) { bf16* rowp = base + (size_t)(row0 + ai * 128 + m * 16) * ldc + col0; const float rs = rsv[ai * 4 + m];
#pragma unroll
                for (int bj = 0; bj < 2; ++bj) { const f32x4 v0 = acc[ai][bj][m][0] * rs, v1 = acc[ai][bj][m][1] * rs;
                    v4u w; w.x = pg8::cvt_pk_bf16(v0[0], v0[1]); w.y = pg8::cvt_pk_bf16(v0[2], v0[3]); w.z = pg8::cvt_pk_bf16(v1[0], v1[1]); w.w = pg8::cvt_pk_bf16(v1[2], v1[3]);
                    if (!dry) __builtin_nontemporal_store(w, (v4u*)(rowp + bj * 128)); } }
        return true;
    }
};

struct SchedLru {
    const char* A; const char* B; int G, c;
    __device__ __forceinline__ bool next(int i, pg8::Unit& u) const { int L = i * G + c; if (L >= 512) return false; if ((G & 7) == 0) L = i * G + (c & 7) * (G >> 3) + (c >> 3); u.pm = L >> 3; u.pn = L & 7; u.aux = 0; return true; }
    __device__ __forceinline__ const char* abase(const pg8::Unit& u) const { return A + (size_t)u.pm * 256 * D * 2 + (size_t)(u.pn >> 1) * 256 * 2; }
    __device__ __forceinline__ const char* bbase(const pg8::Unit& u) const { return B + (size_t)u.pn * 256 * 256 * 2; }
};
struct EpiLru {
    static constexpr bool PERM = true, ROW_RS = false;
    const bf16* XC; bf16* OMA; int ld_oma; bf16* U; const float* ba; const float* bx; const float* lam;
    __device__ __forceinline__ bool operator()(f32x4 (&acc)[2][2][4][2], const pg8::Unit& u, int wr, int wc, int fr, int fq, const LAS float* xrs) const {
        const int row0 = u.pm * 256 + wr * 64 + fr, ch0 = (u.pn >> 1) * 256 + (u.pn & 1) * 128 + wc * 32 + 8 * fq;
#pragma unroll
        for (int n = 0; n < 2; ++n) {
            const int chn = ch0 + 4 * n;
            v2u xcv[8];
#pragma unroll
            for (int i = 0; i < 8; ++i) xcv[i] = *(const v2u*)(XC + (size_t)(row0 + (i >> 2) * 128 + (i & 3) * 16) * D + chn);
            const f32x4 b_a = *(const f32x4*)(ba + chn), b_x = *(const f32x4*)(bx + chn), sp = *(const f32x4*)(lam + chn) * (-8.0f * 1.4426950408889634f);
#pragma unroll
            for (int ai = 0; ai < 2; ++ai)
#pragma unroll
                for (int m = 0; m < 4; ++m) { const int row = row0 + ai * 128 + m * 16; const v2u xv = xcv[ai * 4 + m];
                    const float xc[4] = {blo(xv.x), bhi(xv.x), blo(xv.y), bhi(xv.y)};
                    float oa[4], uu[4];
#pragma unroll
                    for (int j = 0; j < 4; ++j) { const float pa = acc[ai][0][m][n][j] + b_a[j], px = acc[ai][1][m][n][j] + b_x[j];
                        const float r = __builtin_amdgcn_rcpf(1.0f + __builtin_amdgcn_exp2f(-1.4426950408889634f * pa)), ig = __builtin_amdgcn_rcpf(1.0f + __builtin_amdgcn_exp2f(-1.4426950408889634f * px));
                        const float a = __builtin_amdgcn_exp2f(r * sp[j]); const float om = 1.0f - a;
                        oa[j] = om; uu[j] = __builtin_amdgcn_sqrtf(om * (1.0f + a)) * ig * xc[j]; }
                    v2u w1; w1.x = pk2(oa[0], oa[1]); w1.y = pk2(oa[2], oa[3]);
                    v2u w2; w2.x = pk2(uu[0], uu[1]); w2.y = pk2(uu[2], uu[3]);
                    *(v2u*)(OMA + (size_t)row * ld_oma + chn) = w1; *(v2u*)(U + (size_t)row * D + chn) = w2; }
        }
        return true;
    }
};

struct SchedBranch {
    const char* P; const char* B; int G, c;
    __device__ __forceinline__ bool next(int i, pg8::Unit& u) const { int tile = (i / 3) * G + c; if (tile >= 256) return false; if ((G & 7) == 0) tile = (i / 3) * G + (c & 7) * (G >> 3) + (c >> 3);
        u.pm = tile >> 2; u.pn = tile & 3; u.aux = i % 3; return true; }
    __device__ __forceinline__ const char* abase(const pg8::Unit& u) const { const int off = u.aux == 0 ? OFF_GG : (u.aux == 1 ? OFF_LG : OFF_SQ); return P + ((size_t)u.pm * 256 * PN + off) * 2; }
    __device__ __forceinline__ const char* bbase(const pg8::Unit& u) const { return B + (size_t)(u.aux * 1024 + u.pn * 256) * D * 2; }
};
struct EpiBranch {
    static constexpr bool PERM = true, ROW_RS = false, WIDE = false;
    const bf16* PROJ; const float* bg; bf16* O;
    __device__ __forceinline__ bool operator()(f32x4 (&acc)[2][2][4][2], const pg8::Unit& u, int wr, int wc, int fr, int fq, const LAS float* xrs) const {
        const int row0 = u.pm * 256 + wr * 64 + fr, col0 = u.pn * 256 + wc * 32 + 8 * fq, br = u.aux;
#pragma unroll
        for (int bj = 0; bj < 2; ++bj) {
            const int c = col0 + bj * 128;
            float b0[8], b1[8];
#pragma unroll
            for (int j = 0; j < 8; ++j) { b0[j] = bg[br * 1024 + c + j] * -1.4426950408889634f; b1[j] = br < 2 ? bg[(br + 1) * 1024 + c + j] * -1.4426950408889634f : 0.f; }
#pragma unroll
            for (int ai = 0; ai < 2; ++ai) {
                v4u l0[4], l1[4];
#pragma unroll
                for (int m = 0; m < 4; ++m) { const bf16* gp = PROJ + (size_t)(row0 + ai * 128 + m * 16) * PN + OFF_GATE + br * 1024 + c; l0[m] = *(const v4u*)gp; l1[m] = br < 2 ? *(const v4u*)(gp + 1024) : l0[m]; }
#pragma unroll
                for (int m = 0; m < 4; ++m) { const int row = row0 + ai * 128 + m * 16; const v4u a0 = l0[m], a1 = l1[m];
                    const float x0[8] = {blo(a0.x), bhi(a0.x), blo(a0.y), bhi(a0.y), blo(a0.z), bhi(a0.z), blo(a0.w), bhi(a0.w)};
                    const float x1[8] = {blo(a1.x), bhi(a1.x), blo(a1.y), bhi(a1.y), blo(a1.z), bhi(a1.z), blo(a1.w), bhi(a1.w)};
#pragma unroll
                    for (int j = 0; j < 8; ++j) { const float r0 = __builtin_amdgcn_rcpf(1.0f + __builtin_amdgcn_exp2f(x0[j] * -1.4426950408889634f + b0[j]));
                        const float f = br < 2 ? (1.0f + __builtin_amdgcn_exp2f(x1[j] * -1.4426950408889634f + b1[j])) * r0 : r0;
                        acc[ai][bj][m][j >> 2][j & 3] *= f; }
                    if (br == 2) { const f32x4 v0 = acc[ai][bj][m][0], v1 = acc[ai][bj][m][1];
                        v4u w; w.x = pg8::cvt_pk_bf16(v0[0], v0[1]); w.y = pg8::cvt_pk_bf16(v0[2], v0[3]); w.z = pg8::cvt_pk_bf16(v1[0], v1[1]); w.w = pg8::cvt_pk_bf16(v1[2], v1[3]);
                        *(v4u*)(O + (size_t)row * D + c) = w; } }
            }
        }
        return br == 2;
    }
};

namespace gla {
typedef float f32x16 __attribute__((ext_vector_type(16)));
typedef short s16x4 __attribute__((ext_vector_type(4)));
constexpr int BUF = 65536, T_QD = 0, T_KI = 16384, T_V = 32768, X_SSQ = 131072  , X_DEC = 131072 + 4096  ;
__device__ __forceinline__ int crow(int r, int hi) { return (r & 3) + 8 * (r >> 2) + 4 * hi; }
__device__ __forceinline__ unsigned cvtpk(float lo, float hi) { unsigned r; asm volatile("v_cvt_pk_bf16_f32 %0, %1, %2" : "=v"(r) : "v"(lo), "v"(hi)); return r; }
__device__ __forceinline__ bf16x8 acc_frag(const f32x16& X, int s) { v4u w = {cvtpk(X[8 * s], X[8 * s + 1]), cvtpk(X[8 * s + 2], X[8 * s + 3]), cvtpk(X[8 * s + 4], X[8 * s + 5]), cvtpk(X[8 * s + 6], X[8 * s + 7])}; return *reinterpret_cast<bf16x8*>(&w); }
__device__ __forceinline__ int offb(int row, int ch) { return 256 * row + 16 * (ch ^ (((row & 3) << 2) | ((row >> 2) & 3))); }
__device__ __forceinline__ bf16x8 rowrd(const LAS unsigned char* tile, int lane, int rb, int s) { return *reinterpret_cast<const LAS bf16x8*>(tile + offb((lane & 31) + 32 * rb, 2 * s + (lane >> 5))); }
__device__ __forceinline__ v2u rd8(const LAS unsigned char* tile, int row, int ch, int half) { return *reinterpret_cast<const LAS v2u*>(tile + offb(row, ch) + 8 * half); }
__device__ __forceinline__ s16x4 trr(unsigned addr) { s16x4 r; asm volatile("ds_read_b64_tr_b16 %0, %1" : "=&v"(r) : "v"(addr) : "memory"); return r; }
__device__ __forceinline__ unsigned tr_addr(unsigned base, int lane, int c, int row0) { const int blk = (lane >> 4) & 1, q = (lane & 15) >> 2, p = lane & 3; return base + offb(row0 + q, 4 * c + 2 * blk + (p >> 1)) + 8 * (p & 1); }
struct TrPair { s16x4 a, b; };
__device__ __forceinline__ TrPair tr_nat(unsigned base, int lane, int c, int ks) { const int h = lane >> 5; TrPair p; p.a = trr(tr_addr(base, lane, c, 16 * ks + 8 * h)); p.b = trr(tr_addr(base, lane, c, 16 * ks + 8 * h + 4)); return p; }
__device__ __forceinline__ TrPair tr_perm(unsigned base, int lane, int c, int ks) { const int h = lane >> 5; TrPair p; p.a = trr(tr_addr(base, lane, c, 16 * ks + 4 * h)); p.b = trr(tr_addr(base, lane, c, 16 * ks + 8 + 4 * h)); return p; }
__device__ __forceinline__ bf16x8 tr_frag(const TrPair& p) { return (bf16x8){p.a[0], p.a[1], p.a[2], p.a[3], p.b[0], p.b[1], p.b[2], p.b[3]}; }
#define LDS_TR_WAIT() do { asm volatile("s_waitcnt lgkmcnt(0)" ::: "memory"); __builtin_amdgcn_sched_barrier(0); } while (0)
__device__ __forceinline__ void dma_tile(LAS unsigned char* img, const bf16* grow0  , int wid, int lane) {
#pragma unroll
    for (int i = 0; i < 2; ++i) { const int L = (wid + 8 * i) * 64 + lane, row = L >> 4, ch = (L & 15) ^ (((row & 3) << 2) | ((row >> 2) & 3));
        __builtin_amdgcn_global_load_lds((const unsigned*)(grow0 + (size_t)row * PN + ch * 8), (LAS unsigned*)(img + (wid + 8 * i) * 1024), 16, 0, 0); }
}
__device__ __forceinline__ void dma_chunk(LAS unsigned char* lds, int buf, const bf16* proj_row0  , int h, bool with_q, int wid, int lane) {
    LAS unsigned char* b = lds + buf * BUF;
    if (with_q) dma_tile(b + T_QD, proj_row0 + OFF_GQ + h * 128, wid, lane);
    dma_tile(b + T_KI, proj_row0 + OFF_GK + h * 128, wid, lane);
    dma_tile(b + T_V, proj_row0 + OFF_GV + h * 256, wid, lane);
    dma_tile(b + T_V + 16384, proj_row0 + OFF_GV + h * 256 + 128, wid, lane);
}
__device__ __forceinline__ void s_update(f32x16 (&S)[4], const LAS unsigned char* b, unsigned bi, const LAS float* dec, int wid, int lane, int hi) {
    const unsigned vimg = bi + T_V + (wid >> 2) * 16384, kimg = bi + T_KI;
#pragma unroll
    for (int ks = 0; ks < 4; ++ks) { const TrPair pv = tr_nat(vimg, lane, wid & 3, ks); TrPair pk[4];
#pragma unroll
        for (int db = 0; db < 4; ++db) pk[db] = tr_nat(kimg, lane, db, ks);
        LDS_TR_WAIT();
        const bf16x8 bv = tr_frag(pv);
#pragma unroll
        for (int db = 0; db < 4; ++db) S[db] = __builtin_amdgcn_mfma_f32_32x32x16_bf16(tr_frag(pk[db]), bv, S[db], 0, 0, 0); }
#pragma unroll
    for (int db = 0; db < 4; ++db)
#pragma unroll
        for (int g = 0; g < 4; ++g) { const f32x4 d = *reinterpret_cast<const LAS f32x4*>(dec + 32 * db + 8 * g + 4 * hi);
#pragma unroll
            for (int i = 0; i < 4; ++i) S[db][4 * g + i] *= d[i]; }
}
__device__ __forceinline__ void pass1_item(Frame& F, int it) {
    const int tid = opaque_tid(), wid = __builtin_amdgcn_readfirstlane(tid >> 6), lane = tid & 63, hi = lane >> 5;
    const int b = it >> 5, h = (it >> 3) & 3, g = it & 7;
    const float* decb = F.DECAY + (size_t)(b * 32) * 512 + h * 128;
    const unsigned lbase = (unsigned)(uintptr_t)F.ldsg;
    f32x16 S[4];
#pragma unroll
    for (int db = 0; db < 4; ++db) S[db] = f32x16{};
    LAS float* decl = (LAS float*)(F.lds + X_DEC);
    __syncthreads();
    dma_chunk(F.lds, 0, F.PROJ + (size_t)(b * T + (4 * g) * 64) * PN, h, false, wid, lane);
    decl[tid] = decb[(size_t)(4 * g + (tid >> 7)) * 512 + (tid & 127)];
    asm volatile("s_waitcnt vmcnt(0)" ::: "memory"); __syncthreads();
#pragma nounroll
    for (int n = 0; n < 4; ++n) { const int ch = 4 * g + n;
        if (n < 3) dma_chunk(F.lds, (n + 1) & 1, F.PROJ + (size_t)(b * T + (ch + 1) * 64) * PN, h, false, wid, lane);
        int ln = lane; asm volatile("" : "+v"(ln));
        s_update(S, F.lds + (n & 1) * BUF, lbase + (n & 1) * BUF, decl + n * 128, wid, ln, ln >> 5);
        asm volatile("s_waitcnt vmcnt(0)" ::: "memory"); __syncthreads();
    }
    float* sl = (float*)(F.ws + WS_VT) + (size_t)it * 32768 + wid * 4096;
#pragma unroll
    for (int db = 0; db < 4; ++db)
#pragma unroll
        for (int g4 = 0; g4 < 4; ++g4) *reinterpret_cast<f32x4*>(sl + ((db * 4 + g4) * 64 + lane) * 4) = (f32x4){S[db][4 * g4], S[db][4 * g4 + 1], S[db][4 * g4 + 2], S[db][4 * g4 + 3]};
}
__device__ __forceinline__ void prefix_item(Frame& F, int it) {
    const int tid = opaque_tid(), b = it >> 5, h = (it >> 3) & 3, e = it & 7;
    const float* sl = (const float*)(F.ws + WS_VT) + (size_t)(it - e) * 32768 + e * 4096;
    float* cin = (float*)(F.ws + WS_XC) + (size_t)(it - e) * 32768 + e * 4096;
    const float* decb = F.DECAY + (size_t)(b * 32) * 512 + h * 128;
#pragma unroll
    for (int j = 0; j < 2; ++j) { const int q = tid + 512 * j, dk = 32 * (q >> 8) + 8 * ((q >> 6) & 3) + 4 * ((q & 63) >> 5);
        f32x4 sv[8], dv[8];
#pragma unroll
        for (int g = 0; g < 8; ++g) { sv[g] = *(const f32x4*)(sl + (size_t)g * 32768 + 4 * q);
            const float* dp = decb + (size_t)(4 * g) * 512 + dk; dv[g] = (*(const f32x4*)dp * *(const f32x4*)(dp + 512)) * (*(const f32x4*)(dp + 1024) * *(const f32x4*)(dp + 1536)); }
        f32x4 C = {0.f, 0.f, 0.f, 0.f};
#pragma unroll
        for (int g = 0; g < 8; ++g) { *(f32x4*)(cin + (size_t)g * 32768 + 4 * q) = C; C = dv[g] * C + sv[g]; }
    }
}
__device__ __forceinline__ void pass2_item(Frame& F, const float* norm_g, int it) {
    const int tid = opaque_tid(), wid = __builtin_amdgcn_readfirstlane(tid >> 6), lane = tid & 63, r32 = lane & 31, hi = lane >> 5;
    const int b = it >> 5, h = (it >> 3) & 3, g = it & 7;
    const float* decb = F.DECAY + (size_t)(b * 32) * 512 + h * 128;
    const unsigned lbase = (unsigned)(uintptr_t)F.ldsg;
    LAS float* ssqx = (LAS float*)(F.lds + X_SSQ);
    LAS float* decl = (LAS float*)(F.lds + X_DEC);
    __syncthreads();
    dma_chunk(F.lds, 0, F.PROJ + (size_t)(b * T + (4 * g) * 64) * PN, h, true, wid, lane);
    decl[tid] = decb[(size_t)(4 * g + (tid >> 7)) * 512 + (tid & 127)];
    f32x16 S[4];
    { const float* ci = (const float*)(F.ws + WS_XC) + (size_t)it * 32768 + wid * 4096;
#pragma unroll
      for (int db = 0; db < 4; ++db)
#pragma unroll
          for (int g4 = 0; g4 < 4; ++g4) { const f32x4 sv = *reinterpret_cast<const f32x4*>(ci + ((db * 4 + g4) * 64 + lane) * 4);
#pragma unroll
              for (int i = 0; i < 4; ++i) S[db][4 * g4 + i] = sv[i]; } }
    float ng[16];
#pragma unroll
    for (int r = 0; r < 16; ++r) ng[r] = norm_g[32 * wid + crow(r, hi)];
    asm volatile("s_waitcnt vmcnt(0)" ::: "memory"); __syncthreads();
#pragma nounroll
    for (int n = 0; n < 4; ++n) { const int ch = 4 * g + n; const size_t m0 = (size_t)(b * T + ch * 64);
        if (n < 3) dma_chunk(F.lds, (n + 1) & 1, F.PROJ + (m0 + 64) * PN, h, true, wid, lane);
        int ln = lane; asm volatile("" : "+v"(ln));
        const int lane = ln, r32 = ln & 31, hi = ln >> 5;
        const LAS unsigned char* bq = F.lds + (n & 1) * BUF + T_QD; const LAS unsigned char* bk = F.lds + (n & 1) * BUF + T_KI;
        const unsigned bi = lbase + (n & 1) * BUF, vimg = bi + T_V + (wid >> 2) * 16384;
        f32x16 a00 = f32x16{}, a01 = f32x16{}, a11 = f32x16{};
#pragma unroll
        for (int d0 = 0; d0 < 8; ++d0) { const bf16x8 k0 = rowrd(bk, lane, 0, d0), k1 = rowrd(bk, lane, 1, d0), q0 = rowrd(bq, lane, 0, d0), q1 = rowrd(bq, lane, 1, d0);
            a00 = __builtin_amdgcn_mfma_f32_32x32x16_bf16(k0, q0, a00, 0, 0, 0);
            a01 = __builtin_amdgcn_mfma_f32_32x32x16_bf16(k0, q1, a01, 0, 0, 0);
            a11 = __builtin_amdgcn_mfma_f32_32x32x16_bf16(k1, q1, a11, 0, 0, 0); }
#pragma unroll
        for (int r = 0; r < 16; ++r) { const bool vis = crow(r, hi) <= r32; a00[r] = vis ? a00[r] : 0.f; a11[r] = vis ? a11[r] : 0.f; }
        f32x16 o0 = f32x16{}, o1 = f32x16{};
        { TrPair pva[2], pvb[2];
#pragma unroll
          for (int ks = 0; ks < 2; ++ks) { pva[ks] = tr_perm(vimg, lane, wid & 3, ks); pvb[ks] = tr_perm(vimg, lane, wid & 3, 2 + ks); }
          LDS_TR_WAIT();
#pragma unroll
          for (int ks = 0; ks < 2; ++ks) { const bf16x8 va = tr_frag(pva[ks]), vb = tr_frag(pvb[ks]);
            o0 = __builtin_amdgcn_mfma_f32_32x32x16_bf16(va, acc_frag(a00, ks), o0, 0, 0, 0);
            o1 = __builtin_amdgcn_mfma_f32_32x32x16_bf16(va, acc_frag(a01, ks), o1, 0, 0, 0);
            o1 = __builtin_amdgcn_mfma_f32_32x32x16_bf16(vb, acc_frag(a11, ks), o1, 0, 0, 0); } }
#pragma unroll
        for (int db = 0; db < 4; ++db)
#pragma unroll
            for (int ks = 0; ks < 2; ++ks) { const bf16x8 sa = acc_frag(S[db], ks);
                const v2u x0 = rd8(bq, r32, 4 * db + 2 * ks, hi), x1 = rd8(bq, r32, 4 * db + 2 * ks + 1, hi), y0 = rd8(bq, 32 + r32, 4 * db + 2 * ks, hi), y1 = rd8(bq, 32 + r32, 4 * db + 2 * ks + 1, hi);
                v4u wx = {x0.x, x0.y, x1.x, x1.y}, wy = {y0.x, y0.y, y1.x, y1.y};
                o0 = __builtin_amdgcn_mfma_f32_32x32x16_bf16(sa, *reinterpret_cast<bf16x8*>(&wx), o0, 0, 0, 0);
                o1 = __builtin_amdgcn_mfma_f32_32x32x16_bf16(sa, *reinterpret_cast<bf16x8*>(&wy), o1, 0, 0, 0); }
        float s0 = 0.f, s1 = 0.f;
#pragma unroll
        for (int r = 0; r < 16; ++r) { s0 += o0[r] * o0[r]; s1 += o1[r] * o1[r]; }
        { auto rr = __builtin_amdgcn_permlane32_swap(__float_as_uint(s0), __float_as_uint(s0), false, false); s0 = __uint_as_float(rr[0]) + __uint_as_float(rr[1]); }
        { auto rr = __builtin_amdgcn_permlane32_swap(__float_as_uint(s1), __float_as_uint(s1), false, false); s1 = __uint_as_float(rr[0]) + __uint_as_float(rr[1]); }
        LAS float* sq = ssqx + (n & 1) * 512;
        if (hi == 0) { sq[wid * 64 + r32] = s0; sq[wid * 64 + 32 + r32] = s1; }
        const bf16* gp = F.PROJ + (m0 + r32) * PN + OFF_GG + h * 256 + 32 * wid + 4 * hi;
        v2u gg0[4], gg1[4];
#pragma unroll
        for (int g4 = 0; g4 < 4; ++g4) { gg0[g4] = *reinterpret_cast<const v2u*>(gp + 8 * g4); gg1[g4] = *reinterpret_cast<const v2u*>(gp + (size_t)32 * PN + 8 * g4); }
        if (n < 3) s_update(S, F.lds + (n & 1) * BUF, bi, decl + n * 128, wid, lane, hi);
        asm volatile("s_waitcnt vmcnt(0)" ::: "memory"); __syncthreads();
        float t0s = 0.f, t1s = 0.f;
#pragma unroll
        for (int w2 = 0; w2 < 8; ++w2) { t0s += sq[w2 * 64 + r32]; t1s += sq[w2 * 64 + 32 + r32]; }
        const float rs0 = __builtin_amdgcn_rsqf(t0s * (1.f / 256.f) + EPS), rs1 = __builtin_amdgcn_rsqf(t1s * (1.f / 256.f) + EPS);
#pragma unroll
        for (int g4 = 0; g4 < 4; ++g4) {
            const float ga[4] = {blo(gg0[g4].x), bhi(gg0[g4].x), blo(gg0[g4].y), bhi(gg0[g4].y)}, gb[4] = {blo(gg1[g4].x), bhi(gg1[g4].x), blo(gg1[g4].y), bhi(gg1[g4].y)};
            float ya[4], yb[4];
#pragma unroll
            for (int i = 0; i < 4; ++i) { ya[i] = o0[4 * g4 + i] * rs0 * ng[4 * g4 + i] * (ga[i] * __builtin_amdgcn_rcpf(1.0f + __builtin_amdgcn_exp2f(-1.4426950408889634f * ga[i])));
                                          yb[i] = o1[4 * g4 + i] * rs1 * ng[4 * g4 + i] * (gb[i] * __builtin_amdgcn_rcpf(1.0f + __builtin_amdgcn_exp2f(-1.4426950408889634f * gb[i]))); }
            v2u w0 = {cvtpk(ya[0], ya[1]), cvtpk(ya[2], ya[3])}, w1 = {cvtpk(yb[0], yb[1]), cvtpk(yb[2], yb[3])};
            if (!F.dry) { *reinterpret_cast<v2u*>(const_cast<bf16*>(gp) + 8 * g4) = w0; *reinterpret_cast<v2u*>(const_cast<bf16*>(gp) + (size_t)32 * PN + 8 * g4) = w1; }
        }
    }
}
}
__device__ __forceinline__ void phase_gla_fix(Frame& F, const Args& A, int l) {
    F.tid = opaque_tid(); F.lane = F.tid & 63;
    const int gt = F.bid * 512 + F.tid, NGT = F.G * 512;
    const float* ng = as_global(A.in[5]) + (size_t)l * 256;
    for (int idx = gt; idx < M * 128; idx += NGT) {
        const int m = idx >> 7, c0 = (idx & 127) * 8, h = c0 >> 8;
        const float* sp = F.SSQ + (size_t)m * 32 + h * 8;
        const float ss = ((sp[0] + sp[1]) + (sp[2] + sp[3])) + ((sp[4] + sp[5]) + (sp[6] + sp[7]));
        const float rs = 1.0f / sqrtf(ss * (1.f / 256.f) + EPS);
        const v4u ov = *(const v4u*)(F.PROJ + (size_t)m * PN + OFF_GV + c0);
        bf16* gp = F.PROJ + (size_t)m * PN + OFF_GG + c0;
        const v4u gv = *(const v4u*)gp;
        const float o[8] = {blo(ov.x), bhi(ov.x), blo(ov.y), bhi(ov.y), blo(ov.z), bhi(ov.z), blo(ov.w), bhi(ov.w)};
        const float g[8] = {blo(gv.x), bhi(gv.x), blo(gv.y), bhi(gv.y), blo(gv.z), bhi(gv.z), blo(gv.w), bhi(gv.w)};
        float r[8];
#pragma unroll
        for (int j = 0; j < 8; ++j) r[j] = o[j] * rs * ng[(c0 & 255) + j] * (g[j] * sigmoidf_(g[j]));
        v4u w; w.x = pk2(r[0], r[1]); w.y = pk2(r[2], r[3]); w.z = pk2(r[4], r[5]); w.w = pk2(r[6], r[7]);
        if (!F.dry) *(v4u*)gp = w;
    }
}

__device__ __forceinline__ float gelu_tanh(float x) { const float y = 0.7978845608028654f * (x + 0.044715f * x * x * x); const float e = __expf(2.0f * y); const float th = 1.0f - 2.0f / (e + 1.0f); return 0.5f * x * (1.0f + th); }
constexpr size_t WS_LSUM = WS_KE;
constexpr size_t WS_WSUM = WS_KE + 4 * MiB;
__device__ __forceinline__ void lru_scan_a(Frame& F, int it) {
    const int tid = opaque_tid(), wid = __builtin_amdgcn_readfirstlane(tid >> 6), lane = tid & 63;
    const int b = it >> 5, cg = (it >> 3) & 3, tb = it & 7, ch = cg * 256 + lane * 4, m0 = b * T + tb * 256 + wid * 32, quad = cg * 64 + lane;
    LAS float* xs = (LAS float*)F.lds;
    f32x4 h = {0.f, 0.f, 0.f, 0.f}, P = {1.f, 1.f, 1.f, 1.f};
#pragma unroll
    for (int i16 = 0; i16 < 32; i16 += 16) {
        v2u om[16], uu[16];
#pragma unroll
        for (int i = 0; i < 16; ++i) { om[i] = *(const v2u*)(F.PROJ + (size_t)(m0 + i16 + i) * PN + OFF_LX + ch); uu[i] = *(const v2u*)(F.U + (size_t)(m0 + i16 + i) * D + ch); }
#pragma unroll
        for (int i = 0; i < 16; ++i) { const f32x4 a = {1.f - blo(om[i].x), 1.f - bhi(om[i].x), 1.f - blo(om[i].y), 1.f - bhi(om[i].y)}, u = {blo(uu[i].x), bhi(uu[i].x), blo(uu[i].y), bhi(uu[i].y)};
            h = a * h + u; P = P * a; }
    }
    float* ls = (float*)(F.ws + WS_LSUM) + ((size_t)(b * 64 + tb * 8 + wid) * 256 + quad) * 8;
    *(f32x4*)ls = P; *(f32x4*)(ls + 4) = h;
    __syncthreads();
    *(LAS f32x4*)(xs + (wid * 64 + lane) * 8) = P; *(LAS f32x4*)(xs + (wid * 64 + lane) * 8 + 4) = h;
    __syncthreads();
    if (wid == 0) { f32x4 Pt = {1.f, 1.f, 1.f, 1.f}, Ht = {0.f, 0.f, 0.f, 0.f};
#pragma unroll
        for (int w2 = 0; w2 < 8; ++w2) { const f32x4 p = *(const LAS f32x4*)(xs + (w2 * 64 + lane) * 8), hh = *(const LAS f32x4*)(xs + (w2 * 64 + lane) * 8 + 4); Ht = p * Ht + hh; Pt = Pt * p; }
        float* wsm = (float*)(F.ws + WS_WSUM) + ((size_t)(b * 8 + tb) * 256 + quad) * 8;
        *(f32x4*)wsm = Pt; *(f32x4*)(wsm + 4) = Ht; }
}
__device__ __forceinline__ void lru_scan_b(Frame& F, int it) {
    const int tid = opaque_tid(), wid = __builtin_amdgcn_readfirstlane(tid >> 6), lane = tid & 63;
    const int b = it >> 5, cg = (it >> 3) & 3, tb = it & 7, ch = cg * 256 + lane * 4, m0 = b * T + tb * 256 + wid * 32, quad = cg * 64 + lane;
    f32x4 h = {0.f, 0.f, 0.f, 0.f};
    { const float* wsm = (const float*)(F.ws + WS_WSUM) + ((size_t)(b * 8) * 256 + quad) * 8;
      f32x4 pp[7], hh[7];
#pragma unroll
      for (int j = 0; j < 7; ++j) { pp[j] = *(const f32x4*)(wsm + (size_t)j * 2048); hh[j] = *(const f32x4*)(wsm + (size_t)j * 2048 + 4); }
#pragma unroll
      for (int j = 0; j < 7; ++j) if (j < tb) h = pp[j] * h + hh[j]; }
    { const float* ls = (const float*)(F.ws + WS_LSUM) + ((size_t)(b * 64 + tb * 8) * 256 + quad) * 8;
      f32x4 pp[7], hh[7];
#pragma unroll
      for (int j = 0; j < 7; ++j) { pp[j] = *(const f32x4*)(ls + (size_t)j * 2048); hh[j] = *(const f32x4*)(ls + (size_t)j * 2048 + 4); }
#pragma unroll
      for (int j = 0; j < 7; ++j) if (j < wid) h = pp[j] * h + hh[j]; }
#pragma nounroll
    for (int i8 = 0; i8 < 32; i8 += 8) {
        v2u om[8], uu[8], gv[8];
#pragma unroll
        for (int i = 0; i < 8; ++i) { om[i] = *(const v2u*)(F.PROJ + (size_t)(m0 + i8 + i) * PN + OFF_LX + ch); uu[i] = *(const v2u*)(F.U + (size_t)(m0 + i8 + i) * D + ch);
            gv[i] = *(const v2u*)(F.PROJ + (size_t)(m0 + i8 + i) * PN + OFF_LG + ch); }
#pragma unroll
        for (int i = 0; i < 8; ++i) {
            const f32x4 a = {1.f - blo(om[i].x), 1.f - bhi(om[i].x), 1.f - blo(om[i].y), 1.f - bhi(om[i].y)}, u = {blo(uu[i].x), bhi(uu[i].x), blo(uu[i].y), bhi(uu[i].y)};
            const float g[4] = {blo(gv[i].x), bhi(gv[i].x), blo(gv[i].y), bhi(gv[i].y)};
            h = a * h + u;
            v2u w; w.x = pk2(h.x * gelu_tanh(g[0]), h.y * gelu_tanh(g[1])); w.y = pk2(h.z * gelu_tanh(g[2]), h.w * gelu_tanh(g[3]));
            if (!F.dry) *(v2u*)(F.PROJ + (size_t)(m0 + i8 + i) * PN + OFF_LG + ch) = w;
        }
    }
}

namespace sba {
typedef float f32x16 __attribute__((ext_vector_type(16)));
typedef short s16x4 __attribute__((ext_vector_type(4)));
constexpr int SHM_V = 64 * 128 * 2, SHM_K = 64 * 128 * 2;
#define SBA_KSWZ(row, colB) ((row) * 256 + ((colB) ^ (((row) & 7) << 4)))
#define SBA_SBAR() __builtin_amdgcn_sched_barrier(0)
__device__ __forceinline__ int crow(int r, int hi) { return (r & 3) + 8 * (r >> 2) + 4 * hi; }
__device__ __forceinline__ unsigned cvtpk(float lo, float hi) { unsigned r; asm volatile("v_cvt_pk_bf16_f32 %0, %1, %2" : "=v"(r) : "v"(lo), "v"(hi)); return r; }
__device__ __forceinline__ void qkt(f32x16& p0, f32x16& p1, const char* Ks, const bf16x8* qr, int r32, int hi) {
    p0 = f32x16{}; p1 = f32x16{};
#pragma unroll
    for (int d0 = 0; d0 < 8; ++d0) { const int cb = (d0 * 16 + hi * 8) * 2;
        const bf16x8 b0 = *reinterpret_cast<const bf16x8*>(Ks + SBA_KSWZ(r32, cb));
        const bf16x8 b1 = *reinterpret_cast<const bf16x8*>(Ks + SBA_KSWZ(32 + r32, cb));
        p0 = __builtin_amdgcn_mfma_f32_32x32x16_bf16(b0, qr[d0], p0, 0, 0, 0);
        p1 = __builtin_amdgcn_mfma_f32_32x32x16_bf16(b1, qr[d0], p1, 0, 0, 0); }
}
__device__ __forceinline__ void sig_part(f32x16& p0, f32x16& p1, bool partial, int krel, int hi) {
#pragma unroll
    for (int r = 0; r < 16; ++r) { p0[r] = __builtin_amdgcn_rcpf(1.0f + __builtin_amdgcn_exp2f(p0[r])); p1[r] = __builtin_amdgcn_rcpf(1.0f + __builtin_amdgcn_exp2f(p1[r])); }
    if (partial) {
#pragma unroll
        for (int r = 0; r < 16; ++r) { const int kk = krel + crow(r, hi); p0[r] = (kk < 0) ? p0[r] : 1.0f; p1[r] = (kk + 32 < 0) ? p1[r] : 1.0f; }
    }
}
__device__ __forceinline__ void finish(f32x16& p0, f32x16& p1, float& R, int hi, bf16x8& pa0, bf16x8& pa1, bf16x8& pa2, bf16x8& pa3) {
    float lo[8], hv[8];
#pragma unroll
    for (int g = 0; g < 4; ++g) {
        const float ga = (p0[4 * g] * p0[4 * g + 1]) * (p0[4 * g + 2] * p0[4 * g + 3]), gb = (p1[4 * g] * p1[4 * g + 1]) * (p1[4 * g + 2] * p1[4 * g + 3]);
        { auto rr = __builtin_amdgcn_permlane32_swap(__float_as_uint(ga), __float_as_uint(ga), false, false); lo[g] = __uint_as_float(rr[0]); hv[g] = __uint_as_float(rr[1]); }
        { auto rr = __builtin_amdgcn_permlane32_swap(__float_as_uint(gb), __float_as_uint(gb), false, false); lo[4 + g] = __uint_as_float(rr[0]); hv[4 + g] = __uint_as_float(rr[1]); }
    }
    float ps = R;
#pragma unroll
    for (int g = 7; g >= 0; --g) {
        float run = ps * (hi == 0 ? hv[g] : 1.0f);
#pragma unroll
        for (int i = 3; i >= 0; --i) {
            if (g >= 4) { const float k = p1[4 * (g - 4) + i]; p1[4 * (g - 4) + i] = (1.0f - k) * run; run *= k; }
            else        { const float k = p0[4 * g + i];       p0[4 * g + i]       = (1.0f - k) * run; run *= k; }
        }
        ps = ps * (lo[g] * hv[g]);
    }
    R = ps;
#define SBA_PK4(P, BASE, OUT) do { unsigned a0 = cvtpk(P[BASE + 0], P[BASE + 1]), a1 = cvtpk(P[BASE + 2], P[BASE + 3]);   \
    unsigned b0 = cvtpk(P[BASE + 4], P[BASE + 5]), b1 = cvtpk(P[BASE + 6], P[BASE + 7]);                              \
    auto r0 = __builtin_amdgcn_permlane32_swap(a0, b0, false, false); auto r1 = __builtin_amdgcn_permlane32_swap(a1, b1, false, false); \
    v4u w = {r0[0], r1[0], r0[1], r1[1]}; OUT = *reinterpret_cast<bf16x8*>(&w); } while (0)
    SBA_PK4(p0, 0, pa0); SBA_PK4(p0, 8, pa1); SBA_PK4(p1, 0, pa2); SBA_PK4(p1, 8, pa3);
#undef SBA_PK4
}
__device__ __forceinline__ int v_st(int k, int c) { const int kk = (k & ~0xC) | ((k & 4) << 1) | ((k & 8) >> 1); return ((kk >> 3) * 4 + (c >> 5)) * 512 + ((kk & 7) * 32 + (c & 31)) * 2; }
__device__ __forceinline__ int v_rd_base(int lane) { return ((lane & 3) << 3) | (((lane >> 2) & 3) << 6) | (((lane >> 4) & 1) << 5) | (((lane >> 5) & 1) << 8); }
constexpr int v_rd_off(int d0, int ks, int half) { return d0 * 512 + ks * 4096 + half * 2048; }
template <int OFF> __device__ __forceinline__ s16x4 tr_read(int vb) { s16x4 r; asm volatile("ds_read_b64_tr_b16 %0, %1 offset:%2" : "=&v"(r) : "v"(vb), "i"(OFF) : "memory"); return r; }
template <int D0> __device__ __forceinline__ void pv_one(f32x16& od, int vb, bf16x8 pa0, bf16x8 pa1, bf16x8 pa2, bf16x8 pa3) {
    const s16x4 l0 = tr_read<v_rd_off(D0, 0, 0)>(vb), h0 = tr_read<v_rd_off(D0, 0, 1)>(vb), l1 = tr_read<v_rd_off(D0, 1, 0)>(vb), h1 = tr_read<v_rd_off(D0, 1, 1)>(vb);
    const s16x4 l2 = tr_read<v_rd_off(D0, 2, 0)>(vb), h2 = tr_read<v_rd_off(D0, 2, 1)>(vb), l3 = tr_read<v_rd_off(D0, 3, 0)>(vb), h3 = tr_read<v_rd_off(D0, 3, 1)>(vb);
    asm volatile("s_waitcnt lgkmcnt(0)" ::: "memory"); SBA_SBAR();
#define SBA_PK(L, H) (bf16x8){L[0], L[1], L[2], L[3], H[0], H[1], H[2], H[3]}
    od = __builtin_amdgcn_mfma_f32_32x32x16_bf16(pa0, SBA_PK(l0, h0), od, 0, 0, 0);
    od = __builtin_amdgcn_mfma_f32_32x32x16_bf16(pa1, SBA_PK(l1, h1), od, 0, 0, 0);
    od = __builtin_amdgcn_mfma_f32_32x32x16_bf16(pa2, SBA_PK(l2, h2), od, 0, 0, 0);
    od = __builtin_amdgcn_mfma_f32_32x32x16_bf16(pa3, SBA_PK(l3, h3), od, 0, 0, 0);
#undef SBA_PK
}
__device__ __forceinline__ void pv_d0(f32x16* o, int vb, bf16x8 pa0, bf16x8 pa1, bf16x8 pa2, bf16x8 pa3) {
    pv_one<0>(o[0], vb, pa0, pa1, pa2, pa3); pv_one<1>(o[1], vb, pa0, pa1, pa2, pa3); pv_one<2>(o[2], vb, pa0, pa1, pa2, pa3); pv_one<3>(o[3], vb, pa0, pa1, pa2, pa3);
}
__device__ __forceinline__ void unit(const bf16* Qb, const bf16* __restrict__ Kh, const bf16* __restrict__ Vh, bf16* Ob, int qb, char* lds, int tid, bool dry, const float* qg, const float* kg) {
    const int wid = __builtin_amdgcn_readfirstlane(tid >> 6), lane = tid & 63, r32 = lane & 31, hi = lane >> 5;
    char* V_lds = lds; char* K_lds = lds + 2 * SHM_V;
    f32x16 o[4] = {}; bf16x8 qr[8]; float R = 1.0f;
    const bf16* Qw = Qb + (size_t)(wid * 32 + r32) * PN + hi * 8;
#pragma unroll
    for (int d0 = 0; d0 < 8; ++d0) qr[d0] = *reinterpret_cast<const bf16x8*>(Qw + d0 * 16);
    { float ss = 0.f;
#pragma unroll
      for (int d0 = 0; d0 < 8; ++d0) { const v4u w = *reinterpret_cast<const v4u*>(&qr[d0]); const float e[8] = {blo(w.x), bhi(w.x), blo(w.y), bhi(w.y), blo(w.z), bhi(w.z), blo(w.w), bhi(w.w)};
#pragma unroll
          for (int j = 0; j < 8; ++j) ss += e[j] * e[j]; }
      { auto rr = __builtin_amdgcn_permlane32_swap(__float_as_uint(ss), __float_as_uint(ss), false, false); ss = __uint_as_float(rr[0]) + __uint_as_float(rr[1]); }
      const float rs = __builtin_amdgcn_rsqf(ss * (1.f / 128.f) + EPS) * (0.08838834764831845f * 1.4426950408889634f);
#pragma unroll
      for (int d0 = 0; d0 < 8; ++d0) { const v4u w = *reinterpret_cast<const v4u*>(&qr[d0]); const float e[8] = {blo(w.x), bhi(w.x), blo(w.y), bhi(w.y), blo(w.z), bhi(w.z), blo(w.w), bhi(w.w)};
          const f32x4 g0 = *reinterpret_cast<const f32x4*>(qg + 16 * d0 + 8 * hi), g1 = *reinterpret_cast<const f32x4*>(qg + 16 * d0 + 8 * hi + 4);
          v4u o; o.x = cvtpk(e[0] * rs * g0.x, e[1] * rs * g0.y); o.y = cvtpk(e[2] * rs * g0.z, e[3] * rs * g0.w); o.z = cvtpk(e[4] * rs * g1.x, e[5] * rs * g1.y); o.w = cvtpk(e[6] * rs * g1.z, e[7] * rs * g1.w);
          qr[d0] = *reinterpret_cast<bf16x8*>(&o); } }
    const f32x4 kg0 = *reinterpret_cast<const f32x4*>(kg + (tid & 15) * 8), kg1 = *reinterpret_cast<const f32x4*>(kg + (tid & 15) * 8 + 4);
#define SBA_KNORM(X) do { const v4u w_ = *reinterpret_cast<const v4u*>(&(X)); const float e_[8] = {blo(w_.x), bhi(w_.x), blo(w_.y), bhi(w_.y), blo(w_.z), bhi(w_.z), blo(w_.w), bhi(w_.w)}; \
        float s_ = 0.f; _Pragma("unroll") for (int j_ = 0; j_ < 8; ++j_) s_ += e_[j_] * e_[j_]; \
        s_ += shx(s_, 1, lane); s_ += shx(s_, 2, lane); s_ += shx(s_, 4, lane); s_ += shx(s_, 8, lane); \
        const float r_ = __builtin_amdgcn_rsqf(s_ * (1.f / 128.f) + EPS); \
        v4u o_; o_.x = cvtpk(e_[0] * r_ * kg0.x, e_[1] * r_ * kg0.y); o_.y = cvtpk(e_[2] * r_ * kg0.z, e_[3] * r_ * kg0.w); o_.z = cvtpk(e_[4] * r_ * kg1.x, e_[5] * r_ * kg1.y); o_.w = cvtpk(e_[6] * r_ * kg1.z, e_[7] * r_ * kg1.w); \
        (X) = *reinterpret_cast<bf16x8*>(&o_); } while (0)
    const int sr = tid >> 4, sc = (tid & 15) * 8, vst0 = v_st(sr, sc), vst1 = v_st(32 + sr, sc);
    const int vb0 = (int)(uintptr_t)V_lds + v_rd_base(lane);
    bf16x8 vsA0, vsA1, ksA0, ksA1, vsB0, vsB1, ksB0, ksB1;
#define SBA_SLOAD(S, k0) do { vs##S##0 = *reinterpret_cast<const bf16x8*>(&Vh[(size_t)((k0) + sr) * PN + sc]); vs##S##1 = *reinterpret_cast<const bf16x8*>(&Vh[(size_t)((k0) + 32 + sr) * PN + sc]); \
    ks##S##0 = *reinterpret_cast<const bf16x8*>(&Kh[(size_t)((k0) + sr) * PN + sc]); ks##S##1 = *reinterpret_cast<const bf16x8*>(&Kh[(size_t)((k0) + 32 + sr) * PN + sc]); } while (0)
#define SBA_SWRITE(S, bo) do { SBA_KNORM(ks##S##0); SBA_KNORM(ks##S##1); *(bf16x8*)(V_lds + (bo) + vst0) = vs##S##0; *(bf16x8*)(V_lds + (bo) + vst1) = vs##S##1; const int kc = sc * 2; \
    *(bf16x8*)(K_lds + (bo) + SBA_KSWZ(sr, kc)) = ks##S##0; *(bf16x8*)(K_lds + (bo) + SBA_KSWZ(32 + sr, kc)) = ks##S##1; } while (0)
#define SBA_WAIT(more) do { if (more) asm volatile("s_waitcnt vmcnt(4)" ::: "memory"); else asm volatile("s_waitcnt vmcnt(0)" ::: "memory"); } while (0)
    const int NT = 4 * (qb + 1);
    const int qrel = wid * 32 + r32;
#define SBA_TILE(i) ((NT - 1 - (i)) * 64)
#define SBA_STEP(i, bo) do { const bool alive_ = __any(R != 0.0f); \
        if (alive_ && (((i) >= 4) || (64 * (3 - (i)) < 32 * wid + 31))) { f32x16 p0, p1; bf16x8 pa0, pa1, pa2, pa3; \
            qkt(p0, p1, K_lds + (bo), qr, r32, hi); \
            sig_part(p0, p1, ((i) < 4) && (64 * (3 - (i)) + 63 >= 32 * wid), 64 * (3 - (i)) - qrel, hi); \
            finish(p0, p1, R, hi, pa0, pa1, pa2, pa3); SBA_SBAR(); \
            pv_d0(o, vb0 + (bo), pa0, pa1, pa2, pa3); } SBA_SBAR(); } while (0)
    SBA_SLOAD(A, SBA_TILE(0)); SBA_WAIT(false); SBA_SWRITE(A, 0); __syncthreads();
    SBA_SLOAD(B, SBA_TILE(1)); SBA_SLOAD(A, SBA_TILE(2));
    for (int i = 0; i < NT; i += 2) {
        SBA_STEP(i, 0);
        SBA_WAIT(i + 2 < NT); SBA_SWRITE(B, SHM_V);
        if (i + 3 < NT) SBA_SLOAD(B, SBA_TILE(i + 3));
        if (!__syncthreads_or((int)(i < 3 || __any(R != 0.0f)))) break;
        SBA_STEP(i + 1, SHM_V);
        if (i + 2 < NT) { SBA_WAIT(i + 3 < NT); SBA_SWRITE(A, 0); }
        if (i + 4 < NT) SBA_SLOAD(A, SBA_TILE(i + 4));
        if (!__syncthreads_or((int)(i + 1 < 3 || __any(R != 0.0f)))) break;
    }
    asm volatile("s_waitcnt vmcnt(0)" ::: "memory");
#undef SBA_STEP
#undef SBA_TILE
#undef SBA_WAIT
#undef SBA_KNORM
    bf16* Ow = Ob + (size_t)(wid * 32) * PN;
#pragma unroll
    for (int r = 0; r < 16; ++r) { const int orow = crow(r, hi);
#pragma unroll
        for (int d0 = 0; d0 < 4; ++d0) if (!dry) Ow[(size_t)orow * PN + d0 * 32 + r32] = (bf16)f2bf(o[d0][r]); }
    __syncthreads();
#undef SBA_SLOAD
#undef SBA_SWRITE
}
}
__device__ __forceinline__ void sb_attn_pair(Frame& F, const float* qg, const float* kg, int item) {
    const int tid = opaque_tid();
    const int bh = item >> 2, p = item & 3, b = bh >> 3, h = bh & 7;
    const bf16* Kh = F.PROJ + (size_t)(b * T) * PN + OFF_SK + h * 128; const bf16* Vh = F.PROJ + (size_t)(b * T) * PN + OFF_SV + h * 128;
    bf16* Qh = F.PROJ + (size_t)(b * T) * PN + OFF_SQ + h * 128;
#pragma nounroll
    for (int u = 0; u < 2; ++u) { const int qb = u ? p : 7 - p; sba::unit(Qh + (size_t)(qb * 256) * PN, Kh, Vh, Qh + (size_t)(qb * 256) * PN, qb, (char*)F.ldsg, tid, F.dry, qg, kg); }
}

__device__ __forceinline__ Frame make_frame(const Args& args, LAS unsigned char* lds, unsigned char* ldsg) {
    Frame F; unsigned char* ws = args.ws; float* out = args.out;
    { size_t z = 0; asm volatile("" : "+s"(z)); ws += z; out += z; }
    F.lds = lds; F.ldsg = ldsg; F.tid = opaque_tid(); F.lane = F.tid & 63; F.wave = __builtin_amdgcn_readfirstlane(F.tid >> 6);
    F.G = gridDim.x; F.bid = blockIdx.x; F.out = out; F.ws = ws; F.dry = false;
    F.XN = (bf16*)(ws + WS_XN); F.XC = (bf16*)(ws + WS_XC); F.U = (bf16*)(ws + WS_U); F.KE = (bf16*)(ws + WS_KE); F.VT = (bf16*)(ws + WS_VT); F.PROJ = (bf16*)(ws + WS_PROJ);
    F.DECAY = (float*)(ws + WS_DECAY); F.SSQ = (float*)(ws + WS_SSQ);
    return F;
}
__global__ void __launch_bounds__(512, 2) trunk_fwd(Args args) {
    extern __shared__ __attribute__((aligned(16))) unsigned char lds_raw[];
    LAS unsigned char* const lds = (LAS unsigned char*)lds_raw;
    volatile LAS unsigned* MISC = (volatile LAS unsigned*)(lds + MISC_OFF);
    if (threadIdx.x < 32) MISC[threadIdx.x] = 0u;
    __syncthreads();
    const int lo = args.ph_lo, hi = args.ph_hi;
    XcdBarrier bar; bar.bar = (unsigned*)(args.ws + WS_CTL) + CW_BAR; bar.x = 0; bar.st = MISC + 8;
    if (hi - lo > 1) bar = xcd_barrier_post((unsigned*)(args.ws + WS_CTL) + CW_BAR, MISC + 8);
#ifndef PH_MASK
#define PH_MASK 0xfff
#endif
#define IN(k) (lo <= (k) && (k) < hi)
#define EN(k) ((PH_MASK >> (k)) & 1)
#define SEAM(k) do { if (IN(k) && IN((k) + 1)) { xcd_barrier(bar); if ((PROBE_MASK >> 12) & 1) xcd_barrier(bar); } } while (0)
#define PROBE_MASK 0
#ifndef PROBE_MASK
#define PROBE_MASK 0
#endif
#define SUB(n) (!PROBE_BUILD || args.pad == 0 || ((args.pad >> (n)) & 1))
#define FRAME() Frame F = make_frame(args, lds, lds_raw); F.dry = PROBE_BUILD && (((PROBE_MASK != 0) && (rep == 0) && (args.ph_hi < (1 << 30))) || (args.dry != 0))
#define REPS(k) _Pragma("unroll") for (int rep = ((PROBE_MASK >> (k)) & 1) ? 0 : 1; rep < 2; ++rep)
#define WL(F) ((F).ws + WS_W + (size_t)l * WL_STRIDE)
#define ROW_PARTIALS(WSOFF) do { __syncthreads(); pg8::Unit u_; if (S.next(0, u_) && F.tid < 256 && !F.dry) { const LAS float* xs_ = (const LAS float*)(F.lds + 131072); \
    ((float*)(F.ws + (WSOFF)))[(size_t)(u_.pm * 256 + F.tid) * 4 + u_.pn] = (xs_[F.tid] + xs_[256 + F.tid]) + (xs_[512 + F.tid] + xs_[768 + F.tid]); } __syncthreads(); } while (0)

    if (IN(0)) REPS(11) { FRAME(); phase_convert(F, args); phase_input_rows(F, as_global(args.in[0])); }
    SEAM(0);
    for (int l = 0; l < DEPTH; ++l) {
        const int p0 = 1 + l * NP;
        if (EN(1) && IN(p0 + 1)) REPS(1) { FRAME();
            pg8::Gemm g{D, D, D}; SchedProj S; S.base.init(F.XN, WL(F) + WL_IN, D, D, M, PN, F.G, F.bid);
            EpiProj E{F.PROJ, F.VT, (const float*)(F.ws + WS_PARTB), F.dry};
            pg8::gemm_phase<EpiProj, SchedProj, true, true>(F.lds, g, S, E);
        }
        SEAM(p0 + 1);
        if (EN(2) && IN(p0 + 2)) REPS(2) { FRAME(); phase_prep(F, args, l); }
        SEAM(p0 + 2);
        if (EN(3) && IN(p0 + 3)) REPS(3) { FRAME();
            pg8::Gemm g{D, 256, 256}; SchedLru S{(const char*)F.XC, (const char*)(WL(F) + WL_G), F.G, F.bid};
            EpiLru E{F.XC, F.PROJ + OFF_LX, PN, F.U, as_global(args.in[9]) + (size_t)l * D, as_global(args.in[11]) + (size_t)l * D, (const float*)(F.ws + WS_SPL)};
            if (SUB(0)) pg8::gemm_phase<EpiLru, SchedLru, true, true>(F.lds, g, S, E);
            if (SUB(1)) for (int it = F.bid; it < 256; it += F.G) gla::pass1_item(F, it);
        }
        SEAM(p0 + 3);
        if (EN(4) && IN(p0 + 4)) REPS(4) {
            if (SUB(0)) { REPS(13) { FRAME(); for (int it = F.bid; it < 256; it += F.G) gla::prefix_item(F, it); } }
            __syncthreads();
            if (SUB(1)) { REPS(14) { FRAME(); for (int it = F.bid; it < 256; it += F.G) lru_scan_a(F, it); } }
            __syncthreads();
            if (SUB(2)) { REPS(15) { FRAME(); for (int it = F.bid; it < 256; it += F.G) sb_attn_pair(F, as_global(args.in[13]) + (size_t)l * 128, as_global(args.in[14]) + (size_t)l * 128, it); } }
        }
        SEAM(p0 + 4);
        if (EN(5) && IN(p0 + 5)) REPS(5) { FRAME(); for (int it = F.bid; it < 256; it += F.G) lru_scan_b(F, it); __syncthreads(); for (int it = F.bid; it < 256; it += F.G) gla::pass2_item(F, as_global(args.in[5]) + (size_t)l * 256, it); }
        SEAM(p0 + 5);
        if (EN(6) && IN(p0 + 6)) REPS(6) { FRAME();
            pg8::Gemm g{PN, D, D}; SchedBranch S{(const char*)F.PROJ, (const char*)(WL(F) + WL_BR), F.G, F.bid};
            EpiBranch E{F.PROJ, as_global(args.in[18]) + (size_t)l * 3072, F.U};
            pg8::gemm_phase<EpiBranch, SchedBranch, true, true>(F.lds, g, S, E);
        }
        SEAM(p0 + 6);
        if (EN(7) && IN(p0 + 7)) REPS(7) { FRAME();
            pg8::Gemm g{D, D, D}; pg8::SchedStd S; S.init(F.U, WL(F) + WL_OUT, D, D, M, D, F.G, F.bid);
            pg8::EpiResF32 E{(l == 0) ? as_global(args.in[0]) : (const float*)F.out, F.out, D, F.dry, F.XN, (LAS float*)(F.lds + 131072)};
            pg8::gemm_phase<pg8::EpiResF32, pg8::SchedStd, false, true>(F.lds, g, S, E);
            ROW_PARTIALS(WS_PARTA);
        }
        SEAM(p0 + 7);
        if (EN(9) && IN(p0 + 9)) REPS(9) { FRAME();
            pg8::Gemm g{D, D, D}; pg8::SchedStd S; S.init(F.XN, WL(F) + WL_UP, D, D, M, FF, F.G, F.bid);
            pg8::EpiBf16<1> E{F.PROJ, FF, (const float*)(F.ws + WS_PARTA)};
            pg8::gemm_phase<pg8::EpiBf16<1>, pg8::SchedStd, true, true>(F.lds, g, S, E);
        }
        SEAM(p0 + 9);
        if (EN(10) && IN(p0 + 10)) REPS(10) { FRAME();
            pg8::Gemm g{FF, FF, FF}; pg8::SchedStd S; S.init(F.PROJ, WL(F) + WL_DN, FF, FF, M, D, F.G, F.bid);
            pg8::EpiResF32 E{F.out, F.out, D, F.dry, F.XN, (LAS float*)(F.lds + 131072)};
            pg8::gemm_phase<pg8::EpiResF32, pg8::SchedStd, false, true>(F.lds, g, S, E);
            ROW_PARTIALS(WS_PARTB);
        }
        SEAM(p0 + 10);
    }
#undef IN
#undef SEAM
}

extern "C" void kernel_launch(void* const* d_in, const int* in_sizes, int n_in, void* d_out, int out_size, void* d_ws, size_t ws_size, hipStream_t stream) {
    static int grid = 0;
    if (grid == 0) {
        if (n_in != 23 || out_size != M * D || ws_size < WS_END) { fprintf(stderr, "kernel_launch: unexpected shapes / workspace (n_in %d, out %d, ws %zu, need %zu)\n", n_in, out_size, ws_size, (size_t)WS_END); grid = -1; return; }
        int dev = 0, cus = 0, per_cu = 0;
        if (hipGetDevice(&dev) != hipSuccess || hipDeviceGetAttribute(&cus, hipDeviceAttributeMultiprocessorCount, dev) != hipSuccess) { grid = -1; return; }
        if (hipFuncSetAttribute((const void*)trunk_fwd, hipFuncAttributeMaxDynamicSharedMemorySize, LDS_BYTES) != hipSuccess) { grid = -1; return; }
        if (hipOccupancyMaxActiveBlocksPerMultiprocessor(&per_cu, (const void*)trunk_fwd, 512, LDS_BYTES) != hipSuccess || per_cu < 1) fprintf(stderr, "kernel_launch: occupancy query says %d\n", per_cu);
        (void)hipGetLastError();
        grid = cus;
    }
    if (grid < 0) return;
    (void)hipMemsetAsync((char*)d_ws + WS_CTL, 0, CTL_ZERO_BYTES, stream);
    Args a{};
    for (int i = 0; i < 23; ++i) a.in[i] = (const float*)d_in[i];
    a.out = (float*)d_out; a.ws = (unsigned char*)d_ws;
#if MK_ONE_LAUNCH
    a.ph_lo = 0; a.ph_hi = NPH;
    hipLaunchKernelGGL(trunk_fwd, dim3(grid), dim3(512), LDS_BYTES, stream, a);
#else
    for (int p = 0; p < NPH; ++p) { a.ph_lo = p; a.ph_hi = p + 1;
#ifdef PROBE_PHASE
        if (p >= 1 && (p - 1) % NP == PROBE_PHASE) { a.dry = 1; a.pad = PROBE_SUB; hipLaunchKernelGGL(trunk_fwd, dim3(grid), dim3(512), LDS_BYTES, stream, a); a.dry = 0; a.pad = 0; }
#endif
        if (p >= 1 && ((p - 1) % NP == 0 || (p - 1) % NP == 8)) continue;
        hipLaunchKernelGGL(trunk_fwd, dim3(grid), dim3(512), LDS_BYTES, stream, a); }
#endif
}
```
